# Optimizing an MI355X kernel written in HIP

```python
import jax, jax.numpy as jnp
from jax import lax
import numpy as np

D_MODEL = 2048
BATCH = 4
SEQ = 8192
DEPTH = 1

GRID_W = 64
D_ATTN = D_MODEL // 2
HEAD_DIM = 128
N_ATTN_HEADS = D_ATTN // HEAD_DIM
WIN_R = 8
WIN_C = 16
D_REC = D_MODEL - D_ATTN
REC_BLOCKS = 8
REC_BLOCK_W = D_REC // REC_BLOCKS
CONV_W = 4
C_RG = 8.0
D_IN_PROJ = 3 * D_ATTN + 2 * D_REC
D_FF = -(-8 * D_MODEL // (3 * 256)) * 256
D_PLE = 256
EPS = 1e-6
NEG_INF = -1e9

kernel_name = "hymba_natten_rglru_sandwich_encoder"


def rms_norm(x, g):
    x32 = x.astype(jnp.float32)
    y = x32 * lax.rsqrt(jnp.mean(x32 * x32, axis=-1, keepdims=True) + EPS)
    return (y * g.astype(jnp.float32)).astype(x.dtype)


def neighborhood_attention(q, k, v, rpb):
    B, S, H, Dh = q.shape
    rows = S // GRID_W
    kr = min(WIN_R, rows)
    cols = jnp.arange(GRID_W)
    cstart = jnp.clip(cols - WIN_C // 2, 0, GRID_W - WIN_C)
    col_ok = (cols[None, :] >= cstart[:, None]) & (cols[None, :] < cstart[:, None] + WIN_C)
    dc_idx = jnp.clip(cols[None, :] - cols[:, None] + WIN_C - 1, 0, 2 * WIN_C - 2)
    bias_col = jnp.where(col_ok[None, None], rpb.astype(jnp.float32)[:, :, dc_idx], NEG_INF)
    scale = HEAD_DIM ** -0.5
    qg = (q * scale).reshape(B, rows, GRID_W, H, Dh)
    kg = k.reshape(B, rows, GRID_W, H, Dh)
    vg = v.reshape(B, rows, GRID_W, H, Dh)

    def row_block(r):
        rstart = jnp.clip(r - kr // 2, 0, rows - kr)
        q_r = lax.dynamic_index_in_dim(qg, r, axis=1, keepdims=False)
        k_r = lax.dynamic_slice_in_dim(kg, rstart, kr, axis=1)
        v_r = lax.dynamic_slice_in_dim(vg, rstart, kr, axis=1)
        dr_idx = rstart + jnp.arange(kr) - r + WIN_R - 1
        bias = jnp.take(bias_col, dr_idx, axis=1)
        s = jnp.einsum('bqhd,bkwhd->bhkqw', q_r, k_r,
                       preferred_element_type=jnp.float32) + bias
        pr = jax.nn.softmax(s, axis=(2, 4)).astype(v.dtype)
        return jnp.einsum('bhkqw,bkwhd->bqhd', pr, v_r)

    out = lax.map(row_block, jnp.arange(rows))
    return out.transpose(1, 0, 2, 3, 4).reshape(B, S, H * Dh)


def linear_scan(a, b):
    def combine(l, r):
        return (l[0] * r[0], r[0] * l[1] + r[1])
    return lax.associative_scan(combine, (a, b), axis=1)[1]


def rglru_bidirectional(xr, conv_w, conv_b, w_a, b_a, w_i, b_i, lam):
    B, S, _ = xr.shape
    left = CONV_W // 2
    xp = jnp.pad(xr, ((0, 0), (left, CONV_W - 1 - left), (0, 0)))
    xc = conv_b + xp[:, 0:S] * conv_w[0]
    for j in range(1, CONV_W):
        xc = xc + xp[:, j:j + S] * conv_w[j]
    xb = xc.reshape(B, S, REC_BLOCKS, REC_BLOCK_W)
    r_gate = jax.nn.sigmoid(
        jnp.einsum('bsnc,zncd->zbsnd', xb, w_a).reshape(2, B, S, D_REC) + b_a[:, None, None, :])
    i_gate = jax.nn.sigmoid(
        jnp.einsum('bsnc,zncd->zbsnd', xb, w_i).reshape(2, B, S, D_REC) + b_i[:, None, None, :])
    log_a = -C_RG * r_gate.astype(jnp.float32) * jax.nn.softplus(-lam.astype(jnp.float32))[:, None, None, :]
    a = jnp.exp(log_a)
    bterm = jnp.sqrt(-jnp.expm1(2.0 * log_a)) * i_gate.astype(jnp.float32) * xc.astype(jnp.float32)[None]
    h_fwd = linear_scan(a[0], bterm[0])
    h_bwd = jnp.flip(linear_scan(jnp.flip(a[1], axis=1), jnp.flip(bterm[1], axis=1)), axis=1)
    return (h_fwd + h_bwd).astype(xr.dtype)


def setup_inputs(seed: int = 0) -> dict:
    key = jax.random.key(seed)
    ks = jax.random.split(key, 32)
    f32 = jnp.float32

    def nrm(k, shape, scale):
        return jax.random.normal(k, shape, f32) * scale

    def gain(k, n):
        return 1.0 + 0.02 * jax.random.normal(k, (DEPTH, n), f32)

    u = jax.random.uniform(ks[10], (DEPTH, 2, D_REC), f32, minval=0.9, maxval=0.999)
    a0 = u ** (1.0 / C_RG)
    lam = jnp.log(a0) - jnp.log1p(-a0)
    return {
        "x": nrm(ks[0], (BATCH, SEQ, D_MODEL), 1.0),
        "p": nrm(ks[1], (DEPTH, BATCH, SEQ, D_PLE), 1.0),
        "g_mix_pre": gain(ks[2], D_MODEL),
        "w_in": nrm(ks[3], (DEPTH, D_MODEL, D_IN_PROJ), D_MODEL ** -0.5),
        "rpb": nrm(ks[4], (DEPTH, N_ATTN_HEADS, 2 * WIN_R - 1, 2 * WIN_C - 1), 0.02),
        "conv_w": nrm(ks[5], (DEPTH, CONV_W, D_REC), CONV_W ** -0.5),
        "conv_b": nrm(ks[6], (DEPTH, D_REC), 0.01),
        "w_rg_a": nrm(ks[7], (DEPTH, 2, REC_BLOCKS, REC_BLOCK_W, REC_BLOCK_W), REC_BLOCK_W ** -0.5),
        "b_rg_a": nrm(ks[8], (DEPTH, 2, D_REC), 0.01),
        "w_rg_i": nrm(ks[9], (DEPTH, 2, REC_BLOCKS, REC_BLOCK_W, REC_BLOCK_W), REC_BLOCK_W ** -0.5),
        "b_rg_i": nrm(ks[11], (DEPTH, 2, D_REC), 0.01),
        "lam": lam,
        "g_attn_out": gain(ks[12], D_ATTN),
        "g_rec_out": gain(ks[13], D_REC),
        "w_out": nrm(ks[14], (DEPTH, D_ATTN + D_REC, D_MODEL), (D_ATTN + D_REC) ** -0.5),
        "g_mix_post": gain(ks[15], D_MODEL),
        "g_ffn_pre": gain(ks[16], D_MODEL),
        "w_ffn_gate": nrm(ks[17], (DEPTH, D_MODEL, D_FF), D_MODEL ** -0.5),
        "w_ffn_up": nrm(ks[18], (DEPTH, D_MODEL, D_FF), D_MODEL ** -0.5),
        "w_ffn_down": nrm(ks[19], (DEPTH, D_FF, D_MODEL), D_FF ** -0.5),
        "g_ffn_post": gain(ks[20], D_MODEL),
        "g_ple_pre": gain(ks[21], D_MODEL),
        "w_ple_gate": nrm(ks[22], (DEPTH, D_MODEL, D_MODEL), D_MODEL ** -0.5),
        "w_ple_proj": nrm(ks[23], (DEPTH, D_PLE, D_MODEL), D_PLE ** -0.5),
        "g_ple_post": gain(ks[24], D_MODEL),
    }


def reference(x, p, g_mix_pre, w_in, rpb, conv_w, conv_b, w_rg_a, b_rg_a, w_rg_i, b_rg_i,
              lam, g_attn_out, g_rec_out, w_out, g_mix_post, g_ffn_pre, w_ffn_gate,
              w_ffn_up, w_ffn_down, g_ffn_post, g_ple_pre, w_ple_gate, w_ple_proj, g_ple_post):
    B, S, _ = x.shape
    h = x
    for i in range(DEPTH):
        hn = rms_norm(h, g_mix_pre[i])
        u = hn @ w_in[i]
        q, k, v, xr, yg = jnp.split(
            u, [D_ATTN, 2 * D_ATTN, 3 * D_ATTN, 3 * D_ATTN + D_REC], axis=-1)
        attn = neighborhood_attention(
            q.reshape(B, S, N_ATTN_HEADS, HEAD_DIM),
            k.reshape(B, S, N_ATTN_HEADS, HEAD_DIM),
            v.reshape(B, S, N_ATTN_HEADS, HEAD_DIM), rpb[i])
        rec = rglru_bidirectional(xr, conv_w[i], conv_b[i], w_rg_a[i], b_rg_a[i],
                                  w_rg_i[i], b_rg_i[i], lam[i]) * jax.nn.gelu(yg)
        mixed = jnp.concatenate(
            [rms_norm(attn, g_attn_out[i]), rms_norm(rec, g_rec_out[i])], axis=-1) @ w_out[i]
        h = h + rms_norm(mixed, g_mix_post[i])
        fn = rms_norm(h, g_ffn_pre[i])
        ff = (jax.nn.silu(fn @ w_ffn_gate[i]) * (fn @ w_ffn_up[i])) @ w_ffn_down[i]
        h = h + rms_norm(ff, g_ffn_post[i])
        gate = jax.nn.sigmoid(rms_norm(h, g_ple_pre[i]) @ w_ple_gate[i])
        ple = p[i] @ w_ple_proj[i]
        h = h + rms_norm(gate * ple, g_ple_post[i])
    return h
```

```cpp
#include <hip/hip_runtime.h>
#include <hip/hip_cooperative_groups.h>
#include <cstdio>
namespace cg = cooperative_groups;

#ifndef MK_ONE_LAUNCH
#define MK_ONE_LAUNCH 0
#endif
#ifndef PH_MASK
#define PH_MASK 0xFFF
#endif
#define PH_ON(k) ((PH_MASK >> (k)) & 1)
#ifndef NAIVE_ATTN
#define NAIVE_ATTN 0
#endif

#define LAS __attribute__((address_space(3)))
typedef unsigned short bf16_t;
typedef short bf16x8 __attribute__((ext_vector_type(8)));
typedef short s16x4 __attribute__((ext_vector_type(4)));
typedef float f32x4 __attribute__((ext_vector_type(4)));
typedef float f32x2 __attribute__((ext_vector_type(2)));
typedef unsigned u32x4 __attribute__((ext_vector_type(4)));
typedef unsigned u32x2 __attribute__((ext_vector_type(2)));

constexpr int MTOK = 32768, DM = 2048, DIN = 5120, DATT = 1024, DREC = 1024, DFF = 5632, DPLE = 256, SEQ = 8192;
constexpr float EPS = 1e-6f;
constexpr int NPH = 12;
constexpr int LDS_BYTES = 147456;

constexpr size_t MiB = 1u << 20;
constexpr size_t WS_U = 0;
constexpr size_t WS_A2 = 320 * MiB;
constexpr size_t WS_ACT = 0;
constexpr size_t WS_XN = 448 * MiB;
constexpr size_t WS_Y = 576 * MiB;
constexpr size_t WS_PLE = 704 * MiB;
constexpr size_t WS_PB = 832 * MiB;
constexpr size_t WS_WIN = 848 * MiB;
constexpr size_t WS_WOUT = 868 * MiB;
constexpr size_t WS_WGU = 876 * MiB;
constexpr size_t WS_WD = 920 * MiB;
constexpr size_t WS_WPG = 942 * MiB;
constexpr size_t WS_WPP = 950 * MiB;
constexpr size_t WS_WG = 951 * MiB;
constexpr size_t WS_PART = 952 * MiB;
constexpr size_t WS_PATT = 956 * MiB;
constexpr size_t WS_PREC = 957 * MiB;
constexpr size_t WS_SUM = 958 * MiB;

struct Args {
    const float* in[25];
    float* out;
    unsigned char* ws;
    int ph_lo, ph_hi;
};

__device__ __forceinline__ unsigned cvt_pk_bf16(float lo, float hi) { unsigned r; asm volatile("v_cvt_pk_bf16_f32 %0, %1, %2" : "=v"(r) : "v"(lo), "v"(hi)); return r; }
__device__ __forceinline__ float bf_lo(unsigned w) { return __uint_as_float(w << 16); }
__device__ __forceinline__ float bf_hi(unsigned w) { return __uint_as_float(w & 0xffff0000u); }
__device__ __forceinline__ float bf1(unsigned short h) { return __uint_as_float(((unsigned)h) << 16); }
__device__ __forceinline__ float wave_sum(float v) {
#pragma unroll
    for (int o = 1; o < 64; o <<= 1) v += __shfl_xor(v, o);
    return v;
}
__device__ __forceinline__ float fast_sigmoid(float x) { return __builtin_amdgcn_rcpf(1.0f + __expf(-x)); }

namespace pg8 {
constexpr int BM = 256, BK = 64, HALF = 128, HTB = HALF * BK * 2, STAGE_BYTES = 8 * HTB, NXCD = 8, WGM = 8;
__host__ __device__ __forceinline__ int lds_byte(int r, int c) { const int st = (r >> 4) * 2 + (c >> 5), rr = r & 15, cc = c & 31, ob = rr * 64 + cc * 2; return st * 1024 + (ob ^ (((ob >> 9) & 1) << 5)); }
__host__ __device__ __forceinline__ void stage_rc(int b, int& R, int& C) { const int st = b / 1024, sb = b % 1024, swz = sb ^ (((sb >> 9) & 1) << 5); R = (st >> 1) * 16 + swz / 64; C = (st & 1) * 32 + (swz % 64) / 2; }
__host__ __device__ __forceinline__ int perm32(int rho) { const int n = rho >> 4, i = rho & 15; return 8 * (i >> 2) + 4 * n + (i & 3); }
struct Unit { int pm, pn; };
struct Gemm { const bf16_t* A; const bf16_t* Bt; int M, N, K; };
struct StaticOrder {
    int nM, nN, nwg, G, c;
    __device__ void init(int M, int N, int G_, int c_) { nM = M / BM; nN = N / BM; nwg = nM * nN; G = G_; c = c_; }
    __device__ bool next(int i, Unit& u) const {
        const long L = (long)i * G + c; if (L >= nwg) return false;
        int wgid = (int)L; { const int q = nwg / NXCD, r = nwg % NXCD, xcd = wgid % NXCD, off = wgid / NXCD; wgid = (xcd < r ? xcd * (q + 1) : r * (q + 1) + (xcd - r) * q) + off; }
        const int nig = WGM * nN, gid = wgid / nig, fm = gid * WGM, gsz = (nM - fm) < WGM ? (nM - fm) : WGM;
        u.pm = fm + ((wgid % nig) % gsz); u.pn = (wgid % nig) / gsz; return true;
    }
};

struct EpiStore {
    static constexpr bool PERM = true;
    bf16_t* O; int ldc;
    __device__ __forceinline__ void operator()(const f32x4 (&acc)[2][2][4][2], const Unit& u, int wr, int wc, int fr, int fq) const {
        const int row0 = u.pm * BM + wr * 64 + fr, col0 = u.pn * BM + wc * 32 + 8 * fq;
#pragma unroll
        for (int ai = 0; ai < 2; ++ai)
#pragma unroll
            for (int m = 0; m < 4; ++m) { bf16_t* rowp = O + (size_t)(row0 + ai * HALF + m * 16) * ldc + col0;
#pragma unroll
                for (int bj = 0; bj < 2; ++bj) { const f32x4 v0 = acc[ai][bj][m][0], v1 = acc[ai][bj][m][1];
                    u32x4 w; w.x = cvt_pk_bf16(v0[0], v0[1]); w.y = cvt_pk_bf16(v0[2], v0[3]); w.z = cvt_pk_bf16(v1[0], v1[1]); w.w = cvt_pk_bf16(v1[2], v1[3]);
                    *(u32x4*)(rowp + bj * HALF) = w; } }
    }
};
struct EpiStoreSS {
    static constexpr bool PERM = true;
    bf16_t* O; int ldc; float* part;
    __device__ __forceinline__ void operator()(const f32x4 (&acc)[2][2][4][2], const Unit& u, int wr, int wc, int fr, int fq) const {
        const int row0 = u.pm * BM + wr * 64 + fr, col0 = u.pn * BM + wc * 32 + 8 * fq;
#pragma unroll
        for (int ai = 0; ai < 2; ++ai)
#pragma unroll
            for (int m = 0; m < 4; ++m) { const int row = row0 + ai * HALF + m * 16; bf16_t* rowp = O + (size_t)row * ldc + col0; float s = 0.f;
#pragma unroll
                for (int bj = 0; bj < 2; ++bj) { const f32x4 v0 = acc[ai][bj][m][0], v1 = acc[ai][bj][m][1];
                    s += (v0[0] * v0[0] + v0[1] * v0[1]) + (v0[2] * v0[2] + v0[3] * v0[3]) + (v1[0] * v1[0] + v1[1] * v1[1]) + (v1[2] * v1[2] + v1[3] * v1[3]);
                    u32x4 w; w.x = cvt_pk_bf16(v0[0], v0[1]); w.y = cvt_pk_bf16(v0[2], v0[3]); w.z = cvt_pk_bf16(v1[0], v1[1]); w.w = cvt_pk_bf16(v1[2], v1[3]);
                    *(u32x4*)(rowp + bj * HALF) = w; }
                s += __shfl_xor(s, 16); s += __shfl_xor(s, 32);
                if (fq == 0) part[(size_t)row * 32 + u.pn * 4 + wc] = s; }
    }
};
struct EpiSwiglu {
    static constexpr bool PERM = true;
    bf16_t* O; int ldc;
    __device__ __forceinline__ void operator()(const f32x4 (&acc)[2][2][4][2], const Unit& u, int wr, int wc, int fr, int fq) const {
        const int row0 = u.pm * BM + wr * 64 + fr, col0 = u.pn * HALF + wc * 32 + 8 * fq;
#pragma unroll
        for (int ai = 0; ai < 2; ++ai)
#pragma unroll
            for (int m = 0; m < 4; ++m) { bf16_t* rowp = O + (size_t)(row0 + ai * HALF + m * 16) * ldc + col0;
                float v[8];
#pragma unroll
                for (int n = 0; n < 2; ++n)
#pragma unroll
                    for (int j = 0; j < 4; ++j) { const float g = acc[ai][0][m][n][j], up = acc[ai][1][m][n][j]; v[n * 4 + j] = g * fast_sigmoid(g) * up; }
                u32x4 w; w.x = cvt_pk_bf16(v[0], v[1]); w.y = cvt_pk_bf16(v[2], v[3]); w.z = cvt_pk_bf16(v[4], v[5]); w.w = cvt_pk_bf16(v[6], v[7]);
                *(u32x4*)rowp = w; }
    }
};
struct EpiPleGate {
    static constexpr bool PERM = true;
    bf16_t* O; int ldc; const bf16_t* ple; float* part;
    __device__ __forceinline__ void operator()(const f32x4 (&acc)[2][2][4][2], const Unit& u, int wr, int wc, int fr, int fq) const {
        const int row0 = u.pm * BM + wr * 64 + fr, col0 = u.pn * BM + wc * 32 + 8 * fq;
#pragma unroll
        for (int ai = 0; ai < 2; ++ai)
#pragma unroll
            for (int m = 0; m < 4; ++m) { const int row = row0 + ai * HALF + m * 16; const size_t off = (size_t)row * ldc + col0; float s = 0.f;
#pragma unroll
                for (int bj = 0; bj < 2; ++bj) { const u32x4 pl = *(const u32x4*)(ple + off + bj * HALF);
                    const f32x4 a0 = acc[ai][bj][m][0], a1 = acc[ai][bj][m][1]; float v[8];
                    v[0] = fast_sigmoid(a0[0]) * bf_lo(pl.x); v[1] = fast_sigmoid(a0[1]) * bf_hi(pl.x); v[2] = fast_sigmoid(a0[2]) * bf_lo(pl.y); v[3] = fast_sigmoid(a0[3]) * bf_hi(pl.y);
                    v[4] = fast_sigmoid(a1[0]) * bf_lo(pl.z); v[5] = fast_sigmoid(a1[1]) * bf_hi(pl.z); v[6] = fast_sigmoid(a1[2]) * bf_lo(pl.w); v[7] = fast_sigmoid(a1[3]) * bf_hi(pl.w);
#pragma unroll
                    for (int j = 0; j < 8; ++j) s += v[j] * v[j];
                    u32x4 w; w.x = cvt_pk_bf16(v[0], v[1]); w.y = cvt_pk_bf16(v[2], v[3]); w.z = cvt_pk_bf16(v[4], v[5]); w.w = cvt_pk_bf16(v[6], v[7]);
                    *(u32x4*)(O + off + bj * HALF) = w; }
                s += __shfl_xor(s, 16); s += __shfl_xor(s, 32);
                if (fq == 0) part[(size_t)row * 32 + u.pn * 4 + wc] = s; }
    }
};

template <class Epi, class Sched>
__device__ __forceinline__ void gemm_phase(LAS unsigned char* lds, const Gemm g, const Sched& S, const Epi& E) {
    const int tid = threadIdx.x, wid = __builtin_amdgcn_readfirstlane(tid >> 6), lane = tid & 63, wr = wid >> 2, wc = wid & 3, fr = lane & 15, fq = lane >> 4;
    const int K = g.K, nt = K / BK;
    unsigned voffA[2], voffB[2];
#pragma unroll
    for (int i = 0; i < 2; ++i) { int R, C; stage_rc(tid * 16 + i * 8192, R, C); const int Rb = Epi::PERM ? ((R & ~31) + perm32(R & 31)) : R;
        voffA[i] = (unsigned)(R * K + C) * 2u; voffB[i] = (unsigned)(Rb * K + C) * 2u; }
    const size_t kstep = (size_t)(BK * 2);
    const size_t hstep = (size_t)HALF * K * 2;
    const size_t tstep = 2 * hstep;
    const unsigned ldsw = (unsigned)wid * 1024u;
    const int aoff = lds_byte(wr * 64 + fr, fq * 8), boff = lds_byte(wc * 32 + fr, fq * 8);
#define PG8_SA(b, h) (((b) * 2 + (h)) * HTB)
#define PG8_SB(b, h) ((4 + (b) * 2 + (h)) * HTB)
#define PG8_STAGE(bufoff, gbase, voff) do { _Pragma("unroll") for (int _i = 0; _i < 2; ++_i) \
        __builtin_amdgcn_global_load_lds((const unsigned*)((const char*)(gbase) + (voff)[_i]), (LAS unsigned*)(lds + (bufoff) + ldsw + _i * 8192), 16, 0, 0); } while (0)
#define PG8_LDA(dst, b, h) do { _Pragma("unroll") for (int m = 0; m < 4; ++m) _Pragma("unroll") for (int k = 0; k < 2; ++k) dst[m][k] = *(const LAS bf16x8*)(lds + PG8_SA(b, h) + aoff + m * 2048 + k * 1024); } while (0)
#define PG8_LDB(dst, b, h) do { _Pragma("unroll") for (int n = 0; n < 2; ++n) _Pragma("unroll") for (int k = 0; k < 2; ++k) dst[n][k] = *(const LAS bf16x8*)(lds + PG8_SB(b, h) + boff + n * 2048 + k * 1024); } while (0)
#define PG8_MMA(ai, bj, At, Bt) do { __builtin_amdgcn_s_setprio(1); _Pragma("unroll") for (int m = 0; m < 4; ++m) _Pragma("unroll") for (int n = 0; n < 2; ++n) _Pragma("unroll") for (int k = 0; k < 2; ++k) \
        acc[ai][bj][m][n] = __builtin_amdgcn_mfma_f32_16x16x32_bf16(Bt[n][k], At[m][k], acc[ai][bj][m][n], 0, 0, 0); __builtin_amdgcn_s_setprio(0); } while (0)
#define PG8_WAIT_V(n) asm volatile("s_waitcnt vmcnt(" #n ")" ::: "memory")
#define PG8_WAIT_L(n) asm volatile("s_waitcnt lgkmcnt(" #n ")" ::: "memory")
#define PG8_BAR __builtin_amdgcn_s_barrier()
#define PG8_SCHED __builtin_amdgcn_sched_barrier(0)
    Unit cur, nxt; int ui = 0;
    if (!S.next(0, cur)) return;
    f32x4 acc[2][2][4][2];
#pragma unroll
    for (int a = 0; a < 2; ++a)
#pragma unroll
        for (int b = 0; b < 2; ++b)
#pragma unroll
            for (int m = 0; m < 4; ++m)
#pragma unroll
                for (int n = 0; n < 2; ++n) acc[a][b][m][n] = (f32x4){0.f, 0.f, 0.f, 0.f};
    bf16x8 At[4][2], B0[2][2], B1[2][2];
    const char* cA = (const char*)g.A + (size_t)cur.pm * tstep; const char* cB = (const char*)g.Bt + (size_t)cur.pn * tstep;
    PG8_STAGE(PG8_SB(0, 0), cB, voffB); PG8_STAGE(PG8_SA(0, 0), cA, voffA); PG8_STAGE(PG8_SB(0, 1), cB + hstep, voffB); PG8_STAGE(PG8_SA(0, 1), cA + hstep, voffA);
    if (wr == 1) PG8_BAR;
    PG8_WAIT_V(4); PG8_BAR;
    PG8_STAGE(PG8_SB(1, 0), cB + kstep, voffB); PG8_STAGE(PG8_SA(1, 0), cA + kstep, voffA); PG8_STAGE(PG8_SB(1, 1), cB + hstep + kstep, voffB);
    PG8_WAIT_V(6); PG8_BAR;
    for (;;) {
        const bool has_next = S.next(ui + 1, nxt);
        const char* nA = has_next ? (const char*)g.A + (size_t)nxt.pm * tstep : cA; const char* nB = has_next ? (const char*)g.Bt + (size_t)nxt.pn * tstep : cB;
        for (int t = 0; t < nt; t += 2) {
            const bool last = (t == nt - 2);
            const char* a1 = cA + (size_t)(t + 1) * kstep;
            const char* a2 = last ? nA : cA + (size_t)(t + 2) * kstep; const char* b2 = last ? nB : cB + (size_t)(t + 2) * kstep;
            const char* a3 = a2 + kstep; const char* b3 = b2 + kstep;
            PG8_LDB(B0, 0, 0); PG8_SCHED; PG8_LDA(At, 0, 0); PG8_STAGE(PG8_SA(1, 1), a1 + hstep, voffA);
            PG8_WAIT_L(8); PG8_BAR; PG8_WAIT_L(0); PG8_MMA(0, 0, At, B0); PG8_BAR; PG8_SCHED;
            PG8_LDB(B1, 0, 1); PG8_STAGE(PG8_SB(0, 0), b2, voffB);
            PG8_BAR; PG8_WAIT_L(0); PG8_MMA(0, 1, At, B1); PG8_BAR;
            PG8_LDA(At, 0, 1); PG8_STAGE(PG8_SA(0, 0), a2, voffA);
            PG8_BAR; PG8_WAIT_L(0); PG8_MMA(1, 0, At, B0); PG8_BAR; PG8_SCHED;
            PG8_STAGE(PG8_SB(0, 1), b2 + hstep, voffB);
            PG8_WAIT_V(6); PG8_BAR; PG8_MMA(1, 1, At, B1); PG8_BAR;
            PG8_LDB(B0, 1, 0); PG8_SCHED; PG8_LDA(At, 1, 0); PG8_STAGE(PG8_SA(0, 1), a2 + hstep, voffA);
            PG8_WAIT_L(8); PG8_BAR; PG8_WAIT_L(0); PG8_MMA(0, 0, At, B0); PG8_BAR; PG8_SCHED;
            PG8_LDB(B1, 1, 1); PG8_STAGE(PG8_SB(1, 0), b3, voffB);
            PG8_BAR; PG8_WAIT_L(0); PG8_MMA(0, 1, At, B1); PG8_BAR;
            PG8_LDA(At, 1, 1); PG8_STAGE(PG8_SA(1, 0), a3, voffA);
            PG8_BAR; PG8_WAIT_L(0); PG8_MMA(1, 0, At, B0); PG8_BAR; PG8_SCHED;
            PG8_STAGE(PG8_SB(1, 1), b3 + hstep, voffB);
            PG8_WAIT_V(6); PG8_BAR; PG8_MMA(1, 1, At, B1); PG8_BAR;
        }
        E(acc, cur, wr, wc, fr, fq);
        if (!has_next) break;
#pragma unroll
        for (int a = 0; a < 2; ++a)
#pragma unroll
            for (int b = 0; b < 2; ++b)
#pragma unroll
                for (int m = 0; m < 4; ++m)
#pragma unroll
                    for (int n = 0; n < 2; ++n) acc[a][b][m][n] = (f32x4){0.f, 0.f, 0.f, 0.f};
        cur = nxt; cA = nA; cB = nB; ++ui;
    }
    PG8_WAIT_V(0);
    if (wr == 0) PG8_BAR;
    PG8_BAR;
#undef PG8_SA
#undef PG8_SB
#undef PG8_STAGE
#undef PG8_LDA
#undef PG8_LDB
#undef PG8_MMA
#undef PG8_WAIT_V
#undef PG8_WAIT_L
#undef PG8_BAR
#undef PG8_SCHED
}
}

__device__ __forceinline__ void p0_transpose_item(const float* W, int N, bf16_t* WT, int ldk, int k0, int n0, long dst_row0, LAS float* scr, int lane) {
#pragma unroll 8
    for (int i = 0; i < 32; ++i) { const int kk = 2 * i + (lane >> 5); scr[kk * 33 + (lane & 31)] = W[(size_t)(k0 + kk) * N + n0 + (lane & 31)]; }
    asm volatile("s_waitcnt lgkmcnt(0)" ::: "memory");
    const int c = lane & 7;
#pragma unroll
    for (int j = 0; j < 4; ++j) { const int n = (lane >> 3) + 8 * j; const LAS float* s = scr + (8 * c) * 33 + n;
        u32x4 o; o.x = cvt_pk_bf16(s[0 * 33], s[1 * 33]); o.y = cvt_pk_bf16(s[2 * 33], s[3 * 33]); o.z = cvt_pk_bf16(s[4 * 33], s[5 * 33]); o.w = cvt_pk_bf16(s[6 * 33], s[7 * 33]);
        *(u32x4*)(WT + (size_t)(dst_row0 + n) * ldk + k0 + 8 * c) = o; }
    asm volatile("s_waitcnt lgkmcnt(0)" ::: "memory");
}

__device__ __forceinline__ void p0_phase(const Args& a, LAS unsigned char* lds, int tid, int wid, int lane) {
    unsigned char* ws = a.ws;
    LAS float* scr = (LAS float*)(lds + wid * 16384);
    const int gw = blockIdx.x * 8 + wid, NGW = gridDim.x * 8;
    constexpr int I_IN = 32 * 160, I_OUT = 32 * 64, I_G = 32 * 176, I_U = I_G, I_D = 88 * 64, I_PG = 32 * 64, I_PP = 4 * 64, I_RG = 32 * 8;
    constexpr int NITEMS = I_IN + I_OUT + I_G + I_U + I_D + I_PG + I_PP + I_RG;
    for (int it = gw; it < NITEMS; it += NGW) {
        int r = it;
        if (r < I_IN) { const int kb = r / 160, nb = r % 160; p0_transpose_item(a.in[3], DIN, (bf16_t*)(ws + WS_WIN), DM, kb * 64, nb * 32, nb * 32, scr, lane); continue; } r -= I_IN;
        if (r < I_OUT) { const int kb = r / 64, nb = r % 64; p0_transpose_item(a.in[14], DM, (bf16_t*)(ws + WS_WOUT), DM, kb * 64, nb * 32, nb * 32, scr, lane); continue; } r -= I_OUT;
        if (r < I_G) { const int kb = r / 176, nb = r % 176, n0 = nb * 32; p0_transpose_item(a.in[17], DFF, (bf16_t*)(ws + WS_WGU), DM, kb * 64, n0, (n0 >> 7) * 256 + (n0 & 127), scr, lane); continue; } r -= I_G;
        if (r < I_U) { const int kb = r / 176, nb = r % 176, n0 = nb * 32; p0_transpose_item(a.in[18], DFF, (bf16_t*)(ws + WS_WGU), DM, kb * 64, n0, (n0 >> 7) * 256 + 128 + (n0 & 127), scr, lane); continue; } r -= I_U;
        if (r < I_D) { const int kb = r / 64, nb = r % 64; p0_transpose_item(a.in[19], DM, (bf16_t*)(ws + WS_WD), DFF, kb * 64, nb * 32, nb * 32, scr, lane); continue; } r -= I_D;
        if (r < I_PG) { const int kb = r / 64, nb = r % 64; p0_transpose_item(a.in[22], DM, (bf16_t*)(ws + WS_WPG), DM, kb * 64, nb * 32, nb * 32, scr, lane); continue; } r -= I_PG;
        if (r < I_PP) { const int kb = r / 64, nb = r % 64; p0_transpose_item(a.in[23], DM, (bf16_t*)(ws + WS_WPP), DPLE, kb * 64, nb * 32, nb * 32, scr, lane); continue; } r -= I_PP;
        { const int mat = r >> 3, sub = r & 7, kb = sub >> 2, nb = sub & 3; const int zn = mat & 15, z = zn >> 3, n = zn & 7, ty = (mat >> 4) * 2 + z;
          const float* src = (mat < 16 ? a.in[7] : a.in[9]) + (size_t)zn * 16384;
          p0_transpose_item(src, 128, (bf16_t*)(ws + WS_WG), 128, kb * 64, nb * 32, n * 512 + ty * 128 + nb * 32, scr, lane); }
    }
    const float* x = a.in[0]; const float* g = a.in[2]; bf16_t* XN = (bf16_t*)(ws + WS_XN);
    for (int m = gw; m < MTOK; m += NGW) {
        const f32x4* xr = (const f32x4*)(x + (size_t)m * DM);
        f32x4 v[8]; float s = 0.f;
#pragma unroll
        for (int j = 0; j < 8; ++j) { v[j] = xr[j * 64 + lane]; s += (v[j].x * v[j].x + v[j].y * v[j].y) + (v[j].z * v[j].z + v[j].w * v[j].w); }
        const float rs = rsqrtf(wave_sum(s) * (1.f / DM) + EPS);
        u32x2* o = (u32x2*)(XN + (size_t)m * DM);
#pragma unroll
        for (int j = 0; j < 8; ++j) { const f32x4 gv = ((const f32x4*)g)[j * 64 + lane]; u32x2 w; w.x = cvt_pk_bf16(v[j].x * rs * gv.x, v[j].y * rs * gv.y); w.y = cvt_pk_bf16(v[j].z * rs * gv.z, v[j].w * rs * gv.w); o[j * 64 + lane] = w; }
    }
    const f32x4* p4 = (const f32x4*)a.in[1]; u32x2* pb = (u32x2*)(ws + WS_PB);
    for (size_t i = (size_t)blockIdx.x * 512 + tid; i < (size_t)MTOK * DPLE / 4; i += (size_t)gridDim.x * 512) { const f32x4 v = p4[i]; u32x2 w; w.x = cvt_pk_bf16(v.x, v.y); w.y = cvt_pk_bf16(v.z, v.w); pb[i] = w; }
}

__device__ __forceinline__ void attn_phase(const Args& a, LAS unsigned char* lds, int tid, int wid, int lane) {
    const bf16_t* U = (const bf16_t*)(a.ws + WS_U); bf16_t* A2 = (bf16_t*)(a.ws + WS_A2); float* patt = (float*)(a.ws + WS_PATT);
    LAS float* rp = (LAS float*)(lds + 65536);
    for (int i = tid; i < 8 * 15 * 31; i += 512) rp[i] = a.in[4][i];
    __syncthreads();
    const int qb = wid & 3, hh = wid >> 2, l15 = lane & 15, lq = lane >> 4;
    const unsigned vbase = (unsigned)wid * 8192u;
    const unsigned traddr = vbase + (unsigned)((4 * lq + (l15 >> 2)) * 256 + (4 * (lane & 3)) * 2);
    const float LOG2E = 1.4426950408889634f, SC = 0.08838834764831845f * 1.4426950408889634f;
    for (int it = blockIdx.x; it < 512; it += gridDim.x) {
        const int b = it >> 7, r = it & 127;
        const int rstart = min(max(r - 4, 0), 120);
        const int kc0 = min(max(16 * qb - 8, 0), 32);
        const int qcol = 16 * qb + l15, cstart = min(max(qcol - 8, 0), 48);
        const size_t tokq = (size_t)b * SEQ + r * 64 + qcol;
        for (int hi = 0; hi < 4; ++hi) {
            const int h = 2 * hi + hh;
            bf16x8 qf[4]; { const bf16_t* qp = U + tokq * DIN + h * 128 + lq * 32;
#pragma unroll
                for (int ks = 0; ks < 4; ++ks) qf[ks] = *(const bf16x8*)(qp + ks * 8); }
            f32x4 sT[16];
#pragma unroll
            for (int Tg = 0; Tg < 4; ++Tg) {
                bf16x8 kf[4][4];
#pragma unroll
                for (int tt = 0; tt < 4; ++tt) { const int T = Tg * 4 + tt;
                    const bf16_t* kp = U + ((size_t)b * SEQ + (rstart + (T >> 1)) * 64 + kc0 + 16 * (T & 1) + l15) * DIN + 1024 + h * 128 + lq * 32;
#pragma unroll
                    for (int ks = 0; ks < 4; ++ks) kf[tt][ks] = *(const bf16x8*)(kp + ks * 8); }
#pragma unroll
                for (int tt = 0; tt < 4; ++tt) { f32x4 s_ = (f32x4){0.f, 0.f, 0.f, 0.f};
#pragma unroll
                    for (int ks = 0; ks < 4; ++ks) s_ = __builtin_amdgcn_mfma_f32_16x16x32_bf16(kf[tt][ks], qf[ks], s_, 0, 0, 0);
                    sT[Tg * 4 + tt] = s_; }
                __builtin_amdgcn_sched_barrier(0);
            }
            float mx = -1e30f;
#pragma unroll
            for (int T = 0; T < 16; ++T) {
                const int dr = rstart + (T >> 1) - r + 7;
#pragma unroll
                for (int j = 0; j < 4; ++j) {
                    const int kc = kc0 + 16 * (T & 1) + 4 * lq + j; const bool valid = (kc >= cstart) && (kc < cstart + 16);
                    const int dc = min(max(kc - qcol + 15, 0), 30);
                    const float bias = rp[(h * 15 + dr) * 31 + dc];
                    const float t = valid ? (sT[T][j] * SC + bias * LOG2E) : -1e30f;
                    sT[T][j] = t; mx = fmaxf(mx, t);
                }
            }
            mx = fmaxf(mx, __shfl_xor(mx, 16)); mx = fmaxf(mx, __shfl_xor(mx, 32));
            float sum = 0.f;
#pragma unroll
            for (int T = 0; T < 16; ++T)
#pragma unroll
                for (int j = 0; j < 4; ++j) { const float p = __builtin_amdgcn_exp2f(sT[T][j] - mx); sT[T][j] = p; sum += p; }
            sum += __shfl_xor(sum, 16); sum += __shfl_xor(sum, 32);
            union PF { u32x4 u; bf16x8 v; }; PF pf[8];
#pragma unroll
            for (int kr = 0; kr < 8; ++kr) {
                pf[kr].u.x = cvt_pk_bf16(sT[2 * kr][0], sT[2 * kr][1]); pf[kr].u.y = cvt_pk_bf16(sT[2 * kr][2], sT[2 * kr][3]);
                pf[kr].u.z = cvt_pk_bf16(sT[2 * kr + 1][0], sT[2 * kr + 1][1]); pf[kr].u.w = cvt_pk_bf16(sT[2 * kr + 1][2], sT[2 * kr + 1][3]); }
            f32x4 oT[8];
#pragma unroll
            for (int dt = 0; dt < 8; ++dt) oT[dt] = (f32x4){0.f, 0.f, 0.f, 0.f};
            u32x4 vst[8];
            { const bf16_t* vp = U + ((size_t)b * SEQ + rstart * 64 + kc0) * DIN + 2048 + h * 128;
#pragma unroll
              for (int jj = 0; jj < 8; ++jj) { const int c = jj * 64 + lane; vst[jj] = *(const u32x4*)(vp + (size_t)(c >> 4) * DIN + (c & 15) * 8); } }
#pragma unroll
            for (int kr = 0; kr < 8; ++kr) {
#pragma unroll
                for (int jj = 0; jj < 8; ++jj) { const int c = jj * 64 + lane; *(LAS u32x4*)(lds + vbase + (c >> 4) * 256 + (c & 15) * 16) = vst[jj]; }
                if (kr < 7) { const bf16_t* vp = U + ((size_t)b * SEQ + (rstart + kr + 1) * 64 + kc0) * DIN + 2048 + h * 128;
#pragma unroll
                    for (int jj = 0; jj < 8; ++jj) { const int c = jj * 64 + lane; vst[jj] = *(const u32x4*)(vp + (size_t)(c >> 4) * DIN + (c & 15) * 8); } }
                s16x4 t0, t1, t2, t3, t4, t5, t6, t7, t8, t9, t10, t11, t12, t13, t14, t15;
                asm volatile("s_waitcnt lgkmcnt(0)\n\t"
                             "ds_read_b64_tr_b16 %0, %16 offset:0\n\t"   "ds_read_b64_tr_b16 %1, %16 offset:4096\n\t"
                             "ds_read_b64_tr_b16 %2, %16 offset:32\n\t"  "ds_read_b64_tr_b16 %3, %16 offset:4128\n\t"
                             "ds_read_b64_tr_b16 %4, %16 offset:64\n\t"  "ds_read_b64_tr_b16 %5, %16 offset:4160\n\t"
                             "ds_read_b64_tr_b16 %6, %16 offset:96\n\t"  "ds_read_b64_tr_b16 %7, %16 offset:4192\n\t"
                             "ds_read_b64_tr_b16 %8, %16 offset:128\n\t" "ds_read_b64_tr_b16 %9, %16 offset:4224\n\t"
                             "ds_read_b64_tr_b16 %10, %16 offset:160\n\t" "ds_read_b64_tr_b16 %11, %16 offset:4256\n\t"
                             "ds_read_b64_tr_b16 %12, %16 offset:192\n\t" "ds_read_b64_tr_b16 %13, %16 offset:4288\n\t"
                             "ds_read_b64_tr_b16 %14, %16 offset:224\n\t" "ds_read_b64_tr_b16 %15, %16 offset:4320\n\t"
                             "s_waitcnt lgkmcnt(0)"
                             : "=&v"(t0), "=&v"(t1), "=&v"(t2), "=&v"(t3), "=&v"(t4), "=&v"(t5), "=&v"(t6), "=&v"(t7),
                               "=&v"(t8), "=&v"(t9), "=&v"(t10), "=&v"(t11), "=&v"(t12), "=&v"(t13), "=&v"(t14), "=&v"(t15)
                             : "v"(traddr) : "memory");
#define PV_MMA(dt, lo, hi) { bf16x8 vf; vf[0] = lo[0]; vf[1] = lo[1]; vf[2] = lo[2]; vf[3] = lo[3]; vf[4] = hi[0]; vf[5] = hi[1]; vf[6] = hi[2]; vf[7] = hi[3]; \
                    oT[dt] = __builtin_amdgcn_mfma_f32_16x16x32_bf16(vf, pf[kr].v, oT[dt], 0, 0, 0); }
                PV_MMA(0, t0, t1) PV_MMA(1, t2, t3) PV_MMA(2, t4, t5) PV_MMA(3, t6, t7) PV_MMA(4, t8, t9) PV_MMA(5, t10, t11) PV_MMA(6, t12, t13) PV_MMA(7, t14, t15)
#undef PV_MMA
            }
            const float inv = 1.0f / sum; float ss = 0.f;
            bf16_t* op = A2 + tokq * DM + h * 128 + 4 * lq;
#pragma unroll
            for (int dt = 0; dt < 8; ++dt) { const f32x4 o = oT[dt] * inv; ss += (o[0] * o[0] + o[1] * o[1]) + (o[2] * o[2] + o[3] * o[3]);
                u32x2 w; w.x = cvt_pk_bf16(o[0], o[1]); w.y = cvt_pk_bf16(o[2], o[3]); *(u32x2*)(op + 16 * dt) = w; }
            ss += __shfl_xor(ss, 16); ss += __shfl_xor(ss, 32);
            if (lq == 0) patt[tokq * 8 + h] = ss;
        }
    }
    __syncthreads();
}

__device__ __forceinline__ void attn_phase_naive(const Args& a, int wid, int lane) {
    const bf16_t* U = (const bf16_t*)(a.ws + WS_U); bf16_t* A2 = (bf16_t*)(a.ws + WS_A2); float* patt = (float*)(a.ws + WS_PATT);
    const float* rpb = a.in[4];
    const int gw = blockIdx.x * 8 + wid, NGW = gridDim.x * 8;
    for (int wi = gw; wi < MTOK * 8; wi += NGW) {
        const int h = wi & 7, tok = wi >> 3, b = tok >> 13, s = tok & 8191, r = s >> 6, qcol = s & 63;
        const int rstart = min(max(r - 4, 0), 120), cstart = min(max(qcol - 8, 0), 48);
        const unsigned qw = *(const unsigned*)(U + (size_t)tok * DIN + h * 128 + 2 * lane);
        const float q0 = bf_lo(qw) * 0.08838834764831845f, q1 = bf_hi(qw) * 0.08838834764831845f;
        float mx = -1e30f, l = 0.f, o0 = 0.f, o1 = 0.f;
        for (int kr = 0; kr < 8; ++kr)
            for (int kc = 0; kc < 16; ++kc) {
                const size_t kt = (size_t)b * SEQ + (rstart + kr) * 64 + cstart + kc;
                const unsigned kw = *(const unsigned*)(U + kt * DIN + 1024 + h * 128 + 2 * lane);
                const unsigned vw = *(const unsigned*)(U + kt * DIN + 2048 + h * 128 + 2 * lane);
                float d = wave_sum(q0 * bf_lo(kw) + q1 * bf_hi(kw));
                d += rpb[(h * 15 + (rstart + kr - r + 7)) * 31 + (cstart + kc - qcol + 15)];
                const float nm = fmaxf(mx, d), sc = __expf(mx - nm), p = __expf(d - nm);
                l = l * sc + p; o0 = o0 * sc + p * bf_lo(vw); o1 = o1 * sc + p * bf_hi(vw); mx = nm;
            }
        o0 /= l; o1 /= l;
        *(unsigned*)(A2 + (size_t)tok * DM + h * 128 + 2 * lane) = cvt_pk_bf16(o0, o1);
        const float ss = wave_sum(o0 * o0 + o1 * o1);
        if (lane == 0) patt[(size_t)tok * 8 + h] = ss;
    }
}

template <bool FINAL>
__device__ __forceinline__ void rglru_phase(const Args& a, LAS unsigned char* lds, int tid, int wid, int lane) {
    const bf16_t* U = (const bf16_t*)(a.ws + WS_U); bf16_t* A2 = (bf16_t*)(a.ws + WS_A2); float* prec = (float*)(a.ws + WS_PREC);
    float* sumr = (float*)(a.ws + WS_SUM); const bf16_t* WG = (const bf16_t*)(a.ws + WS_WG);
    const float* conv_w = a.in[5]; const float* conv_b = a.in[6]; const float* b_a = a.in[8]; const float* b_i = a.in[10]; const float* lam = a.in[11];
    constexpr int XC_OFF = 0, YG_OFF = 34816, REC_OFF = 69632, RS = 272;
    const int cgp0 = tid & 15, tq0 = tid >> 4, l150 = lane & 15, lq0 = lane >> 4;
    for (int it = blockIdx.x; it < 2048; it += gridDim.x) {
        int cgp = cgp0, tq = tq0, l15 = l150, lq = lq0;
        asm volatile("" : "+v"(cgp), "+v"(tq), "+v"(l15), "+v"(lq));
        const int n = it & 7, c = (it >> 3) & 63, b = it >> 9, t0 = c * 128;
        {
            const int chb = n * 128 + cgp * 8;
            float xin[7][8];
#pragma unroll
            for (int rr = 0; rr < 7; ++rr) { const int ts = t0 + 4 * tq - 2 + rr;
                u32x4 v = (u32x4){0u, 0u, 0u, 0u};
                if (ts >= 0 && ts < SEQ) v = *(const u32x4*)(U + ((size_t)b * SEQ + ts) * DIN + 3072 + chb);
                xin[rr][0] = bf_lo(v.x); xin[rr][1] = bf_hi(v.x); xin[rr][2] = bf_lo(v.y); xin[rr][3] = bf_hi(v.y); xin[rr][4] = bf_lo(v.z); xin[rr][5] = bf_hi(v.z); xin[rr][6] = bf_lo(v.w); xin[rr][7] = bf_hi(v.w); }
            float cw[4][8], cb[8];
#pragma unroll
            for (int j = 0; j < 4; ++j) { const f32x4 w0 = *(const f32x4*)(conv_w + j * DREC + chb), w1 = *(const f32x4*)(conv_w + j * DREC + chb + 4);
                cw[j][0] = w0.x; cw[j][1] = w0.y; cw[j][2] = w0.z; cw[j][3] = w0.w; cw[j][4] = w1.x; cw[j][5] = w1.y; cw[j][6] = w1.z; cw[j][7] = w1.w; }
            { const f32x4 w0 = *(const f32x4*)(conv_b + chb), w1 = *(const f32x4*)(conv_b + chb + 4); cb[0] = w0.x; cb[1] = w0.y; cb[2] = w0.z; cb[3] = w0.w; cb[4] = w1.x; cb[5] = w1.y; cb[6] = w1.z; cb[7] = w1.w; }
#pragma unroll
            for (int i = 0; i < 4; ++i) { float o[8];
#pragma unroll
                for (int e = 0; e < 8; ++e) o[e] = cb[e] + cw[0][e] * xin[i][e] + cw[1][e] * xin[i + 1][e] + cw[2][e] * xin[i + 2][e] + cw[3][e] * xin[i + 3][e];
                u32x4 w; w.x = cvt_pk_bf16(o[0], o[1]); w.y = cvt_pk_bf16(o[2], o[3]); w.z = cvt_pk_bf16(o[4], o[5]); w.w = cvt_pk_bf16(o[6], o[7]);
                *(LAS u32x4*)(lds + XC_OFF + (4 * tq + i) * RS + cgp * 16) = w; }
            if (FINAL) {
#pragma unroll
                for (int i = 0; i < 4; ++i) { const u32x4 v = *(const u32x4*)(U + ((size_t)b * SEQ + t0 + 4 * tq + i) * DIN + 4096 + chb); *(LAS u32x4*)(lds + YG_OFF + (4 * tq + i) * RS + cgp * 16) = v; }
            }
        }
        __syncthreads();
        const int chl = 16 * wid + l15, gch = n * 128 + chl;
        float cend[2], ptot[2];
        f32x4 hs[8];
#pragma unroll
        for (int dir = 0; dir < 2; ++dir) {
            f32x4 acc[2][8];
#pragma unroll
            for (int ty = 0; ty < 2; ++ty)
#pragma unroll
                for (int mt = 0; mt < 8; ++mt) acc[ty][mt] = (f32x4){0.f, 0.f, 0.f, 0.f};
#pragma unroll
            for (int ks = 0; ks < 4; ++ks) {
                bf16x8 af[8];
#pragma unroll
                for (int mt = 0; mt < 8; ++mt) af[mt] = *(const LAS bf16x8*)(lds + XC_OFF + (16 * mt + l15) * RS + (ks * 32 + lq * 8) * 2);
#pragma unroll
                for (int ty = 0; ty < 2; ++ty) { const bf16x8 wf = *(const bf16x8*)(WG + (size_t)(n * 512 + (ty * 2 + dir) * 128 + chl) * 128 + ks * 32 + lq * 8);
#pragma unroll
                    for (int mt = 0; mt < 8; ++mt) acc[ty][mt] = __builtin_amdgcn_mfma_f32_16x16x32_bf16(af[mt], wf, acc[ty][mt], 0, 0, 0); }
            }
            __builtin_amdgcn_sched_barrier(0);
            const float ba = b_a[dir * DREC + gch], bi = b_i[dir * DREC + gch];
            const float kf = 8.0f * log1pf(expf(-lam[dir * DREC + gch]));
#pragma unroll
            for (int mt = 0; mt < 8; ++mt) {
#pragma unroll
                for (int r = 0; r < 4; ++r) {
                    const int tt = 16 * mt + 4 * lq + r;
                    const float xcv = bf1(*(const LAS unsigned short*)(lds + XC_OFF + tt * RS + chl * 2));
                    const float rg = fast_sigmoid(acc[0][mt][r] + ba), ig = fast_sigmoid(acc[1][mt][r] + bi), av = __expf(-kf * rg);
                    acc[0][mt][r] = av; acc[1][mt][r] = sqrtf(fmaxf(1.0f - av * av, 0.f)) * ig * xcv;
                }
                __builtin_amdgcn_sched_barrier(0);
            }
            __builtin_amdgcn_sched_barrier(0);
            float cr = 0.f;
            if (FINAL) {
                float P = 1.f, H = 0.f;
                if (dir == 0) { const int lo = lq * 16, hi = min(lo + 16, c);
                    for (int cc = lo; cc < hi; ++cc) { const float* sp = sumr + ((size_t)((b * 64 + cc) * 2 + 0) * 2) * 1024 + gch; const float A = sp[0], Hc = sp[1024]; H = A * H + Hc; P *= A; }
#pragma unroll
                    for (int g = 0; g < 4; ++g) { const float Pg = __shfl(P, g * 16 + l15), Hg = __shfl(H, g * 16 + l15); cr = Pg * cr + Hg; } }
                else { const int lo = max(lq * 16, c + 1), hi = lq * 16 + 16;
                    for (int cc = hi - 1; cc >= lo; --cc) { const float* sp = sumr + ((size_t)((b * 64 + cc) * 2 + 1) * 2) * 1024 + gch; const float A = sp[0], Hc = sp[1024]; H = A * H + Hc; P *= A; }
#pragma unroll
                    for (int g = 3; g >= 0; --g) { const float Pg = __shfl(P, g * 16 + l15), Hg = __shfl(H, g * 16 + l15); cr = Pg * cr + Hg; } }
            }
            __builtin_amdgcn_sched_barrier(0);
            float pt = 1.f;
            if (dir == 0) {
#pragma unroll
                for (int mt = 0; mt < 8; ++mt) {
                    float H = 0.f, P = 1.f, hl[4], pl[4];
#pragma unroll
                    for (int r = 0; r < 4; ++r) { H = acc[0][mt][r] * H + acc[1][mt][r]; P *= acc[0][mt][r]; hl[r] = H; pl[r] = P; }
                    const float P0 = __shfl(P, l15), H0 = __shfl(H, l15), P1 = __shfl(P, 16 + l15), H1 = __shfl(H, 16 + l15), P2 = __shfl(P, 32 + l15), H2 = __shfl(H, 32 + l15), P3 = __shfl(P, 48 + l15), H3 = __shfl(H, 48 + l15);
                    const float c0 = cr, c1 = P0 * c0 + H0, c2 = P1 * c1 + H1, c3 = P2 * c2 + H2, c4 = P3 * c3 + H3;
                    if (FINAL) { const float mine = lq == 0 ? c0 : (lq == 1 ? c1 : (lq == 2 ? c2 : c3));
#pragma unroll
                        for (int r = 0; r < 4; ++r) hs[mt][r] = hl[r] + pl[r] * mine; }
                    else pt *= (P0 * P1) * (P2 * P3);
                    cr = c4;
                }
            } else {
#pragma unroll
                for (int mt = 7; mt >= 0; --mt) {
                    float H = 0.f, P = 1.f, hl[4], pl[4];
#pragma unroll
                    for (int r = 3; r >= 0; --r) { H = acc[0][mt][r] * H + acc[1][mt][r]; P *= acc[0][mt][r]; hl[r] = H; pl[r] = P; }
                    const float P0 = __shfl(P, l15), H0 = __shfl(H, l15), P1 = __shfl(P, 16 + l15), H1 = __shfl(H, 16 + l15), P2 = __shfl(P, 32 + l15), H2 = __shfl(H, 32 + l15), P3 = __shfl(P, 48 + l15), H3 = __shfl(H, 48 + l15);
                    const float c3 = cr, c2 = P3 * c3 + H3, c1 = P2 * c2 + H2, c0 = P1 * c1 + H1, cn = P0 * c0 + H0;
                    if (FINAL) { const float mine = lq == 0 ? c0 : (lq == 1 ? c1 : (lq == 2 ? c2 : c3));
#pragma unroll
                        for (int r = 0; r < 4; ++r) hs[mt][r] += hl[r] + pl[r] * mine; }
                    else pt *= (P0 * P1) * (P2 * P3);
                    cr = cn;
                }
            }
            cend[dir] = cr; ptot[dir] = pt;
            __builtin_amdgcn_sched_barrier(0);
        }
        if (!FINAL) {
            if (lq == 0) { float* sp = sumr + ((size_t)((b * 64 + c) * 2 + 0) * 2) * 1024 + gch; sp[0] = ptot[0]; sp[1024] = cend[0]; sp[2048] = ptot[1]; sp[3072] = cend[1]; }
            __syncthreads();
        } else {
#pragma unroll
            for (int mt = 0; mt < 8; ++mt) {
#pragma unroll
                for (int r = 0; r < 4; ++r) { const int tt = 16 * mt + 4 * lq + r;
                    const float y = bf1(*(const LAS unsigned short*)(lds + YG_OFF + tt * RS + chl * 2));
                    const float z = 0.7978845608028654f * (y + 0.044715f * y * y * y);
                    const float gl = y * fast_sigmoid(2.0f * z);
                    const float v = hs[mt][r] * gl;
                    *(LAS unsigned short*)(lds + REC_OFF + tt * RS + chl * 2) = (unsigned short)(cvt_pk_bf16(v, 0.f) & 0xffffu); }
                __builtin_amdgcn_sched_barrier(0);
            }
            __syncthreads();
            { const int tok = tid >> 2, qtr = tid & 3; float ss = 0.f;
              bf16_t* dst = A2 + ((size_t)b * SEQ + t0 + tok) * DM + DATT + n * 128 + qtr * 32;
#pragma unroll
              for (int j = 0; j < 4; ++j) { const u32x4 v = *(const LAS u32x4*)(lds + REC_OFF + tok * RS + qtr * 64 + j * 16);
                  const float e0 = bf_lo(v.x), e1 = bf_hi(v.x), e2 = bf_lo(v.y), e3 = bf_hi(v.y), e4 = bf_lo(v.z), e5 = bf_hi(v.z), e6 = bf_lo(v.w), e7 = bf_hi(v.w);
                  ss += (e0 * e0 + e1 * e1) + (e2 * e2 + e3 * e3) + (e4 * e4 + e5 * e5) + (e6 * e6 + e7 * e7);
                  *(u32x4*)(dst + j * 8) = v; }
              ss += __shfl_xor(ss, 1); ss += __shfl_xor(ss, 2);
              if (qtr == 0) prec[((size_t)b * SEQ + t0 + tok) * 8 + n] = ss; }
            __syncthreads();
        }
    }
}

__device__ __forceinline__ void fixup_phase(const Args& a, int wid, int lane) {
    bf16_t* A2 = (bf16_t*)(a.ws + WS_A2); const float* patt = (const float*)(a.ws + WS_PATT); const float* prec = (const float*)(a.ws + WS_PREC);
    const float* ga = a.in[12]; const float* gr = a.in[13];
    const int gw = blockIdx.x * 8 + wid, NGW = gridDim.x * 8;
    for (int m = gw; m < MTOK; m += NGW) {
        float pv = (lane < 8) ? patt[(size_t)m * 8 + lane] : ((lane < 16) ? prec[(size_t)m * 8 + lane - 8] : 0.f);
        pv += __shfl_xor(pv, 1); pv += __shfl_xor(pv, 2); pv += __shfl_xor(pv, 4);
        const float ssa = __shfl(pv, 0), ssr = __shfl(pv, 8);
        const float rsa = rsqrtf(ssa * (1.f / DATT) + EPS), rsr = rsqrtf(ssr * (1.f / DREC) + EPS);
        u32x4* row = (u32x4*)(A2 + (size_t)m * DM);
#pragma unroll
        for (int j = 0; j < 4; ++j) { const int ci = j * 64 + lane; const u32x4 v = row[ci];
            const float rs = (j < 2) ? rsa : rsr; const float* gp = (j < 2) ? (ga + ci * 8) : (gr + (ci - 128) * 8);
            const f32x4 g0 = *(const f32x4*)gp, g1 = *(const f32x4*)(gp + 4);
            u32x4 w; w.x = cvt_pk_bf16(bf_lo(v.x) * rs * g0.x, bf_hi(v.x) * rs * g0.y); w.y = cvt_pk_bf16(bf_lo(v.y) * rs * g0.z, bf_hi(v.y) * rs * g0.w);
            w.z = cvt_pk_bf16(bf_lo(v.z) * rs * g1.x, bf_hi(v.z) * rs * g1.y); w.w = cvt_pk_bf16(bf_lo(v.w) * rs * g1.z, bf_hi(v.w) * rs * g1.w);
            row[ci] = w; }
    }
}

template <int MODE>
__device__ __forceinline__ void epass_phase(const Args& a, const float* hsrc, const float* g_post, const float* g_pre, int wid, int lane) {
    const bf16_t* Y = (const bf16_t*)(a.ws + WS_Y); const float* part = (const float*)(a.ws + WS_PART); bf16_t* XN = (bf16_t*)(a.ws + WS_XN); float* out = a.out;
    const int gw = blockIdx.x * 8 + wid, NGW = gridDim.x * 8;
    for (int m = gw; m < MTOK; m += NGW) {
        float pv = part[(size_t)m * 32 + (lane & 31)];
#pragma unroll
        for (int o = 1; o < 32; o <<= 1) pv += __shfl_xor(pv, o);
        const float rs = rsqrtf(pv * (1.f / DM) + EPS);
        const f32x4* hr = (const f32x4*)(hsrc + (size_t)m * DM); const u32x2* yr = (const u32x2*)(Y + (size_t)m * DM); f32x4* orow = (f32x4*)(out + (size_t)m * DM);
        f32x4 h[8]; float s2 = 0.f;
#pragma unroll
        for (int j = 0; j < 8; ++j) { const f32x4 hv = hr[j * 64 + lane]; const u32x2 yv = yr[j * 64 + lane]; const f32x4 g = ((const f32x4*)g_post)[j * 64 + lane];
            f32x4 o; o.x = hv.x + bf_lo(yv.x) * rs * g.x; o.y = hv.y + bf_hi(yv.x) * rs * g.y; o.z = hv.z + bf_lo(yv.y) * rs * g.z; o.w = hv.w + bf_hi(yv.y) * rs * g.w;
            h[j] = o; orow[j * 64 + lane] = o; s2 += (o.x * o.x + o.y * o.y) + (o.z * o.z + o.w * o.w); }
        if (MODE < 2) {
            const float rs2 = rsqrtf(wave_sum(s2) * (1.f / DM) + EPS);
            u32x2* xo = (u32x2*)(XN + (size_t)m * DM);
#pragma unroll
            for (int j = 0; j < 8; ++j) { const f32x4 g = ((const f32x4*)g_pre)[j * 64 + lane]; u32x2 w; w.x = cvt_pk_bf16(h[j].x * rs2 * g.x, h[j].y * rs2 * g.y); w.y = cvt_pk_bf16(h[j].z * rs2 * g.z, h[j].w * rs2 * g.w); xo[j * 64 + lane] = w; }
        }
    }
}

__global__ void __launch_bounds__(512) fwd_kernel(Args a) {
    extern __shared__ __attribute__((aligned(16))) unsigned char lds_raw[];
    LAS unsigned char* lds = (LAS unsigned char*)lds_raw;
    const int tid = threadIdx.x, wid = __builtin_amdgcn_readfirstlane(tid >> 6), lane = tid & 63;
    unsigned char* ws = a.ws;
    const int lo = a.ph_lo, hi = a.ph_hi;
#define IN(k) (lo <= (k) && (k) < hi && PH_ON(k))
#define SEAM(k) do { if (lo <= (k) && (k) + 1 < hi) cg::this_grid().sync(); } while (0)
    if (IN(0)) p0_phase(a, lds, tid, wid, lane);
    SEAM(0);
    if (IN(1)) {
        for (int gi = 0; gi < 2; ++gi) {
            pg8::Gemm g{(const bf16_t*)(ws + (gi ? WS_PB : WS_XN)), (const bf16_t*)(ws + (gi ? WS_WPP : WS_WIN)), MTOK, gi ? DM : DIN, gi ? DPLE : DM}; pg8::StaticOrder S; S.init(MTOK, gi ? DM : DIN, gridDim.x, blockIdx.x);
            pg8::EpiStore E{(bf16_t*)(ws + (gi ? WS_PLE : WS_U)), gi ? DM : DIN}; pg8::gemm_phase(lds, g, S, E); }
    }
    SEAM(1);
    if (IN(2)) {
#if NAIVE_ATTN
        attn_phase_naive(a, wid, lane);
#else
#ifndef SKIP_ATTN
        attn_phase(a, lds, tid, wid, lane);
#endif
#endif
#ifndef SKIP_R1
        rglru_phase<false>(a, lds, tid, wid, lane);
#endif
    }
    SEAM(2);
    if (IN(3)) rglru_phase<true>(a, lds, tid, wid, lane);
    SEAM(3);
    if (IN(4)) fixup_phase(a, wid, lane);
    SEAM(4);
    if (IN(5)) { pg8::Gemm g{(const bf16_t*)(ws + WS_A2), (const bf16_t*)(ws + WS_WOUT), MTOK, DM, DM}; pg8::StaticOrder S; S.init(MTOK, DM, gridDim.x, blockIdx.x);
        pg8::EpiStoreSS E{(bf16_t*)(ws + WS_Y), DM, (float*)(ws + WS_PART)}; pg8::gemm_phase(lds, g, S, E); }
    SEAM(5);
    if (IN(6)) epass_phase<0>(a, a.in[0], a.in[15], a.in[16], wid, lane);
    SEAM(6);
    if (IN(7)) { pg8::Gemm g{(const bf16_t*)(ws + WS_XN), (const bf16_t*)(ws + WS_WGU), MTOK, 2 * DFF, DM}; pg8::StaticOrder S; S.init(MTOK, 2 * DFF, gridDim.x, blockIdx.x);
        pg8::EpiSwiglu E{(bf16_t*)(ws + WS_ACT), DFF}; pg8::gemm_phase(lds, g, S, E); }
    SEAM(7);
    if (IN(8)) { pg8::Gemm g{(const bf16_t*)(ws + WS_ACT), (const bf16_t*)(ws + WS_WD), MTOK, DM, DFF}; pg8::StaticOrder S; S.init(MTOK, DM, gridDim.x, blockIdx.x);
        pg8::EpiStoreSS E{(bf16_t*)(ws + WS_Y), DM, (float*)(ws + WS_PART)}; pg8::gemm_phase(lds, g, S, E); }
    SEAM(8);
    if (IN(9)) epass_phase<1>(a, a.out, a.in[20], a.in[21], wid, lane);
    SEAM(9);
    if (IN(10)) { pg8::Gemm g{(const bf16_t*)(ws + WS_XN), (const bf16_t*)(ws + WS_WPG), MTOK, DM, DM}; pg8::StaticOrder S; S.init(MTOK, DM, gridDim.x, blockIdx.x);
        pg8::EpiPleGate E{(bf16_t*)(ws + WS_Y), DM, (const bf16_t*)(ws + WS_PLE), (float*)(ws + WS_PART)}; pg8::gemm_phase(lds, g, S, E); }
    SEAM(10);
    if (IN(11)) epass_phase<2>(a, a.out, a.in[24], nullptr, wid, lane);
#undef IN
#undef SEAM
}

extern "C" void kernel_launch(void* const* d_in, const int* in_sizes, int n_in, void* d_out, int out_size, void* d_ws, size_t ws_size, hipStream_t stream) {
    static int grid = 0;
    if (grid == 0) {
        int dev = 0, cus = 0;
        if (hipGetDevice(&dev) != hipSuccess || hipDeviceGetAttribute(&cus, hipDeviceAttributeMultiprocessorCount, dev) != hipSuccess) { fprintf(stderr, "device query failed\n"); grid = -1; return; }
        if (hipFuncSetAttribute((const void*)fwd_kernel, hipFuncAttributeMaxDynamicSharedMemorySize, LDS_BYTES) != hipSuccess) { fprintf(stderr, "hipFuncSetAttribute failed\n"); grid = -1; return; }
        int per_cu = 0;
        if (hipOccupancyMaxActiveBlocksPerMultiprocessor(&per_cu, (const void*)fwd_kernel, 512, LDS_BYTES) != hipSuccess || per_cu < 1) { fprintf(stderr, "occupancy query: %d\n", per_cu); per_cu = 1; }
        (void)hipGetLastError();
        grid = cus;
        if (ws_size < 968 * MiB) fprintf(stderr, "workspace too small: %zu\n", ws_size);
    }
    if (grid < 0) return;
    Args a{};
    for (int i = 0; i < 25; ++i) a.in[i] = (const float*)d_in[i];
    a.out = (float*)d_out; a.ws = (unsigned char*)d_ws;
#if MK_ONE_LAUNCH
    a.ph_lo = 0; a.ph_hi = NPH;
    void* args[] = {&a};
    hipError_t e = hipLaunchCooperativeKernel((const void*)fwd_kernel, dim3(grid), dim3(512), args, LDS_BYTES, stream);
    if (e != hipSuccess) fprintf(stderr, "cooperative launch failed: %s (grid %d)\n", hipGetErrorString(e), grid);
#else
    for (int ph = 0; ph < NPH; ++ph) { a.ph_lo = ph; a.ph_hi = ph + 1; hipLaunchKernelGGL(fwd_kernel, dim3(grid), dim3(512), LDS_BYTES, stream, a); }
#endif
}
```

```cpp
#include <hip/hip_runtime.h>
#include <hip/hip_cooperative_groups.h>
#include <cstdio>
namespace cg = cooperative_groups;

#ifndef MK_ONE_LAUNCH
#define MK_ONE_LAUNCH 1
#endif
#ifndef PH_MASK
#define PH_MASK 0xFFF
#endif
#define PH_ON(k) ((PH_MASK >> (k)) & 1)
#ifndef NAIVE_ATTN
#define NAIVE_ATTN 0
#endif

#define LAS __attribute__((address_space(3)))
typedef unsigned short bf16_t;
typedef short bf16x8 __attribute__((ext_vector_type(8)));
typedef short s16x4 __attribute__((ext_vector_type(4)));
typedef float f32x4 __attribute__((ext_vector_type(4)));
typedef float f32x2 __attribute__((ext_vector_type(2)));
typedef unsigned u32x4 __attribute__((ext_vector_type(4)));
typedef unsigned u32x2 __attribute__((ext_vector_type(2)));

constexpr int MTOK = 32768, DM = 2048, DIN = 5120, DATT = 1024, DREC = 1024, DFF = 5632, DPLE = 256, SEQ = 8192;
constexpr float EPS = 1e-6f;
constexpr int NPH = 12;
constexpr int LDS_BYTES = 147456;

constexpr size_t MiB = 1u << 20;
constexpr size_t WS_U = 0;
constexpr size_t WS_A2 = 320 * MiB;
constexpr size_t WS_ACT = 0;
constexpr size_t WS_XN = 448 * MiB;
constexpr size_t WS_Y = 576 * MiB;
constexpr size_t WS_PLE = 704 * MiB;
constexpr size_t WS_PB = 832 * MiB;
constexpr size_t WS_WIN = 848 * MiB;
constexpr size_t WS_WOUT = 868 * MiB;
constexpr size_t WS_WGU = 876 * MiB;
constexpr size_t WS_WD = 920 * MiB;
constexpr size_t WS_WPG = 942 * MiB;
constexpr size_t WS_WPP = 950 * MiB;
constexpr size_t WS_WG = 951 * MiB;
constexpr size_t WS_PART = 952 * MiB;
constexpr size_t WS_PATT = 956 * MiB;
constexpr size_t WS_PREC = 957 * MiB;
constexpr size_t WS_SUM = 958 * MiB;

struct Args {
    const float* in[25];
    float* out;
    unsigned char* ws;
    int ph_lo, ph_hi;
};

__device__ __forceinline__ unsigned cvt_pk_bf16(float lo, float hi) { unsigned r; asm volatile("v_cvt_pk_bf16_f32 %0, %1, %2" : "=v"(r) : "v"(lo), "v"(hi)); return r; }
__device__ __forceinline__ float bf_lo(unsigned w) { return __uint_as_float(w << 16); }
__device__ __forceinline__ float bf_hi(unsigned w) { return __uint_as_float(w & 0xffff0000u); }
__device__ __forceinline__ float bf1(unsigned short h) { return __uint_as_float(((unsigned)h) << 16); }
__device__ __forceinline__ float wave_sum(float v) {
#pragma unroll
    for (int o = 1; o < 64; o <<= 1) v += __shfl_xor(v, o);
    return v;
}
__device__ __forceinline__ float fast_sigmoid(float x) { return __builtin_amdgcn_rcpf(1.0f + __expf(-x)); }

namespace pg8 {
constexpr int BM = 256, BK = 64, HALF = 128, HTB = HALF * BK * 2, STAGE_BYTES = 8 * HTB, NXCD = 8, WGM = 8;
__host__ __device__ __forceinline__ int lds_byte(int r, int c) { const int st = (r >> 4) * 2 + (c >> 5), rr = r & 15, cc = c & 31, ob = rr * 64 + cc * 2; return st * 1024 + (ob ^ (((ob >> 9) & 1) << 5)); }
__host__ __device__ __forceinline__ void stage_rc(int b, int& R, int& C) { const int st = b / 1024, sb = b % 1024, swz = sb ^ (((sb >> 9) & 1) << 5); R = (st >> 1) * 16 + swz / 64; C = (st & 1) * 32 + (swz % 64) / 2; }
__host__ __device__ __forceinline__ int perm32(int rho) { const int n = rho >> 4, i = rho & 15; return 8 * (i >> 2) + 4 * n + (i & 3); }
struct Unit { int pm, pn; };
struct Gemm { const bf16_t* A; const bf16_t* Bt; int M, N, K; };
struct StaticOrder {
    int nM, nN, nwg, G, c;
    __device__ void init(int M, int N, int G_, int c_) { nM = M / BM; nN = N / BM; nwg = nM * nN; G = G_; c = c_; }
    __device__ bool next(int i, Unit& u) const {
        const long L = (long)i * G + c; if (L >= nwg) return false;
        int wgid = (int)L; { const int q = nwg / NXCD, r = nwg % NXCD, xcd = wgid % NXCD, off = wgid / NXCD; wgid = (xcd < r ? xcd * (q + 1) : r * (q + 1) + (xcd - r) * q) + off; }
        const int nig = WGM * nN, gid = wgid / nig, fm = gid * WGM, gsz = (nM - fm) < WGM ? (nM - fm) : WGM;
        u.pm = fm + ((wgid % nig) % gsz); u.pn = (wgid % nig) / gsz; return true;
    }
};

struct EpiStore {
    static constexpr bool PERM = true;
    bf16_t* O; int ldc;
    __device__ __forceinline__ void operator()(const f32x4 (&acc)[2][2][4][2], const Unit& u, int wr, int wc, int fr, int fq) const {
        const int row0 = u.pm * BM + wr * 64 + fr, col0 = u.pn * BM + wc * 32 + 8 * fq;
#pragma unroll
        for (int ai = 0; ai < 2; ++ai)
#pragma unroll
            for (int m = 0; m < 4; ++m) { bf16_t* rowp = O + (size_t)(row0 + ai * HALF + m * 16) * ldc + col0;
#pragma unroll
                for (int bj = 0; bj < 2; ++bj) { const f32x4 v0 = acc[ai][bj][m][0], v1 = acc[ai][bj][m][1];
                    u32x4 w; w.x = cvt_pk_bf16(v0[0], v0[1]); w.y = cvt_pk_bf16(v0[2], v0[3]); w.z = cvt_pk_bf16(v1[0], v1[1]); w.w = cvt_pk_bf16(v1[2], v1[3]);
                    *(u32x4*)(rowp + bj * HALF) = w; } }
    }
};
struct EpiStoreSS {
    static constexpr bool PERM = true;
    bf16_t* O; int ldc; float* part;
    __device__ __forceinline__ void operator()(const f32x4 (&acc)[2][2][4][2], const Unit& u, int wr, int wc, int fr, int fq) const {
        const int row0 = u.pm * BM + wr * 64 + fr, col0 = u.pn * BM + wc * 32 + 8 * fq;
#pragma unroll
        for (int ai = 0; ai < 2; ++ai)
#pragma unroll
            for (int m = 0; m < 4; ++m) { const int row = row0 + ai * HALF + m * 16; bf16_t* rowp = O + (size_t)row * ldc + col0; float s = 0.f;
#pragma unroll
                for (int bj = 0; bj < 2; ++bj) { const f32x4 v0 = acc[ai][bj][m][0], v1 = acc[ai][bj][m][1];
                    s += (v0[0] * v0[0] + v0[1] * v0[1]) + (v0[2] * v0[2] + v0[3] * v0[3]) + (v1[0] * v1[0] + v1[1] * v1[1]) + (v1[2] * v1[2] + v1[3] * v1[3]);
                    u32x4 w; w.x = cvt_pk_bf16(v0[0], v0[1]); w.y = cvt_pk_bf16(v0[2], v0[3]); w.z = cvt_pk_bf16(v1[0], v1[1]); w.w = cvt_pk_bf16(v1[2], v1[3]);
                    *(u32x4*)(rowp + bj * HALF) = w; }
                s += __shfl_xor(s, 16); s += __shfl_xor(s, 32);
                if (fq == 0) part[(size_t)row * 32 + u.pn * 4 + wc] = s; }
    }
};
struct EpiSwiglu {
    static constexpr bool PERM = true;
    bf16_t* O; int ldc;
    __device__ __forceinline__ void operator()(const f32x4 (&acc)[2][2][4][2], const Unit& u, int wr, int wc, int fr, int fq) const {
        const int row0 = u.pm * BM + wr * 64 + fr, col0 = u.pn * HALF + wc * 32 + 8 * fq;
#pragma unroll
        for (int ai = 0; ai < 2; ++ai)
#pragma unroll
            for (int m = 0; m < 4; ++m) { bf16_t* rowp = O + (size_t)(row0 + ai * HALF + m * 16) * ldc + col0;
                float v[8];
#pragma unroll
                for (int n = 0; n < 2; ++n)
#pragma unroll
                    for (int j = 0; j < 4; ++j) { const float g = acc[ai][0][m][n][j], up = acc[ai][1][m][n][j]; v[n * 4 + j] = g * fast_sigmoid(g) * up; }
                u32x4 w; w.x = cvt_pk_bf16(v[0], v[1]); w.y = cvt_pk_bf16(v[2], v[3]); w.z = cvt_pk_bf16(v[4], v[5]); w.w = cvt_pk_bf16(v[6], v[7]);
                *(u32x4*)rowp = w; }
    }
};
struct EpiPleGate {
    static constexpr bool PERM = true;
    bf16_t* O; int ldc; const bf16_t* ple; float* part;
    __device__ __forceinline__ void operator()(const f32x4 (&acc)[2][2][4][2], const Unit& u, int wr, int wc, int fr, int fq) const {
        const int row0 = u.pm * BM + wr * 64 + fr, col0 = u.pn * BM + wc * 32 + 8 * fq;
#pragma unroll
        for (int ai = 0; ai < 2; ++ai)
#pragma unroll
            for (int m = 0; m < 4; ++m) { const int row = row0 + ai * HALF + m * 16; const size_t off = (size_t)row * ldc + col0; float s = 0.f;
#pragma unroll
                for (int bj = 0; bj < 2; ++bj) { const u32x4 pl = *(const u32x4*)(ple + off + bj * HALF);
                    const f32x4 a0 = acc[ai][bj][m][0], a1 = acc[ai][bj][m][1]; float v[8];
                    v[0] = fast_sigmoid(a0[0]) * bf_lo(pl.x); v[1] = fast_sigmoid(a0[1]) * bf_hi(pl.x); v[2] = fast_sigmoid(a0[2]) * bf_lo(pl.y); v[3] = fast_sigmoid(a0[3]) * bf_hi(pl.y);
                    v[4] = fast_sigmoid(a1[0]) * bf_lo(pl.z); v[5] = fast_sigmoid(a1[1]) * bf_hi(pl.z); v[6] = fast_sigmoid(a1[2]) * bf_lo(pl.w); v[7] = fast_sigmoid(a1[3]) * bf_hi(pl.w);
#pragma unroll
                    for (int j = 0; j < 8; ++j) s += v[j] * v[j];
                    u32x4 w; w.x = cvt_pk_bf16(v[0], v[1]); w.y = cvt_pk_bf16(v[2], v[3]); w.z = cvt_pk_bf16(v[4], v[5]); w.w = cvt_pk_bf16(v[6], v[7]);
                    *(u32x4*)(O + off + bj * HALF) = w; }
                s += __shfl_xor(s, 16); s += __shfl_xor(s, 32);
                if (fq == 0) part[(size_t)row * 32 + u.pn * 4 + wc] = s; }
    }
};

template <class Epi, class Sched>
__device__ __forceinline__ void gemm_phase(LAS unsigned char* lds, const Gemm g, const Sched& S, const Epi& E) {
    const int tid = threadIdx.x, wid = __builtin_amdgcn_readfirstlane(tid >> 6), lane = tid & 63, wr = wid >> 2, wc = wid & 3, fr = lane & 15, fq = lane >> 4;
    const int K = g.K, nt = K / BK;
    unsigned voffA[2], voffB[2];
#pragma unroll
    for (int i = 0; i < 2; ++i) { int R, C; stage_rc(tid * 16 + i * 8192, R, C); const int Rb = Epi::PERM ? ((R & ~31) + perm32(R & 31)) : R;
        voffA[i] = (unsigned)(R * K + C) * 2u; voffB[i] = (unsigned)(Rb * K + C) * 2u; }
    const size_t kstep = (size_t)(BK * 2);
    const size_t hstep = (size_t)HALF * K * 2;
    const size_t tstep = 2 * hstep;
    const unsigned ldsw = (unsigned)wid * 1024u;
    const int aoff = lds_byte(wr * 64 + fr, fq * 8), boff = lds_byte(wc * 32 + fr, fq * 8);
#define PG8_SA(b, h) (((b) * 2 + (h)) * HTB)
#define PG8_SB(b, h) ((4 + (b) * 2 + (h)) * HTB)
#define PG8_STAGE(bufoff, gbase, voff) do { _Pragma("unroll") for (int _i = 0; _i < 2; ++_i) \
        __builtin_amdgcn_global_load_lds((const unsigned*)((const char*)(gbase) + (voff)[_i]), (LAS unsigned*)(lds + (bufoff) + ldsw + _i * 8192), 16, 0, 0); } while (0)
#define PG8_LDA(dst, b, h) do { _Pragma("unroll") for (int m = 0; m < 4; ++m) _Pragma("unroll") for (int k = 0; k < 2; ++k) dst[m][k] = *(const LAS bf16x8*)(lds + PG8_SA(b, h) + aoff + m * 2048 + k * 1024); } while (0)
#define PG8_LDB(dst, b, h) do { _Pragma("unroll") for (int n = 0; n < 2; ++n) _Pragma("unroll") for (int k = 0; k < 2; ++k) dst[n][k] = *(const LAS bf16x8*)(lds + PG8_SB(b, h) + boff + n * 2048 + k * 1024); } while (0)
#define PG8_MMA(ai, bj, At, Bt) do { __builtin_amdgcn_s_setprio(1); _Pragma("unroll") for (int m = 0; m < 4; ++m) _Pragma("unroll") for (int n = 0; n < 2; ++n) _Pragma("unroll") for (int k = 0; k < 2; ++k) \
        acc[ai][bj][m][n] = __builtin_amdgcn_mfma_f32_16x16x32_bf16(Bt[n][k], At[m][k], acc[ai][bj][m][n], 0, 0, 0); __builtin_amdgcn_s_setprio(0); } while (0)
#define PG8_WAIT_V(n) asm volatile("s_waitcnt vmcnt(" #n ")" ::: "memory")
#define PG8_WAIT_L(n) asm volatile("s_waitcnt lgkmcnt(" #n ")" ::: "memory")
#define PG8_BAR __builtin_amdgcn_s_barrier()
#define PG8_SCHED __builtin_amdgcn_sched_barrier(0)
    Unit cur, nxt; int ui = 0;
    if (!S.next(0, cur)) return;
    f32x4 acc[2][2][4][2];
#pragma unroll
    for (int a = 0; a < 2; ++a)
#pragma unroll
        for (int b = 0; b < 2; ++b)
#pragma unroll
            for (int m = 0; m < 4; ++m)
#pragma unroll
                for (int n = 0; n < 2; ++n) acc[a][b][m][n] = (f32x4){0.f, 0.f, 0.f, 0.f};
    bf16x8 At[4][2], B0[2][2], B1[2][2];
    const char* cA = (const char*)g.A + (size_t)cur.pm * tstep; const char* cB = (const char*)g.Bt + (size_t)cur.pn * tstep;
    PG8_STAGE(PG8_SB(0, 0), cB, voffB); PG8_STAGE(PG8_SA(0, 0), cA, voffA); PG8_STAGE(PG8_SB(0, 1), cB + hstep, voffB); PG8_STAGE(PG8_SA(0, 1), cA + hstep, voffA);
    if (wr == 1) PG8_BAR;
    PG8_WAIT_V(4); PG8_BAR;
    PG8_STAGE(PG8_SB(1, 0), cB + kstep, voffB); PG8_STAGE(PG8_SA(1, 0), cA + kstep, voffA); PG8_STAGE(PG8_SB(1, 1), cB + hstep + kstep, voffB);
    PG8_WAIT_V(6); PG8_BAR;
    for (;;) {
        const bool has_next = S.next(ui + 1, nxt);
        const char* nA = has_next ? (const char*)g.A + (size_t)nxt.pm * tstep : cA; const char* nB = has_next ? (const char*)g.Bt + (size_t)nxt.pn * tstep : cB;
        for (int t = 0; t < nt; t += 2) {
            const bool last = (t == nt - 2);
            const char* a1 = cA + (size_t)(t + 1) * kstep;
            const char* a2 = last ? nA : cA + (size_t)(t + 2) * kstep; const char* b2 = last ? nB : cB + (size_t)(t + 2) * kstep;
            const char* a3 = a2 + kstep; const char* b3 = b2 + kstep;
            PG8_LDB(B0, 0, 0); PG8_SCHED; PG8_LDA(At, 0, 0); PG8_STAGE(PG8_SA(1, 1), a1 + hstep, voffA);
            PG8_WAIT_L(8); PG8_BAR; PG8_WAIT_L(0); PG8_MMA(0, 0, At, B0); PG8_BAR; PG8_SCHED;
            PG8_LDB(B1, 0, 1); PG8_STAGE(PG8_SB(0, 0), b2, voffB);
            PG8_BAR; PG8_WAIT_L(0); PG8_MMA(0, 1, At, B1); PG8_BAR;
            PG8_LDA(At, 0, 1); PG8_STAGE(PG8_SA(0, 0), a2, voffA);
            PG8_BAR; PG8_WAIT_L(0); PG8_MMA(1, 0, At, B0); PG8_BAR; PG8_SCHED;
            PG8_STAGE(PG8_SB(0, 1), b2 + hstep, voffB);
            PG8_WAIT_V(6); PG8_BAR; PG8_MMA(1, 1, At, B1); PG8_BAR;
            PG8_LDB(B0, 1, 0); PG8_SCHED; PG8_LDA(At, 1, 0); PG8_STAGE(PG8_SA(0, 1), a2 + hstep, voffA);
            PG8_WAIT_L(8); PG8_BAR; PG8_WAIT_L(0); PG8_MMA(0, 0, At, B0); PG8_BAR; PG8_SCHED;
            PG8_LDB(B1, 1, 1); PG8_STAGE(PG8_SB(1, 0), b3, voffB);
            PG8_BAR; PG8_WAIT_L(0); PG8_MMA(0, 1, At, B1); PG8_BAR;
            PG8_LDA(At, 1, 1); PG8_STAGE(PG8_SA(1, 0), a3, voffA);
            PG8_BAR; PG8_WAIT_L(0); PG8_MMA(1, 0, At, B0); PG8_BAR; PG8_SCHED;
            PG8_STAGE(PG8_SB(1, 1), b3 + hstep, voffB);
            PG8_WAIT_V(6); PG8_BAR; PG8_MMA(1, 1, At, B1); PG8_BAR;
        }
        E(acc, cur, wr, wc, fr, fq);
        if (!has_next) break;
#pragma unroll
        for (int a = 0; a < 2; ++a)
#pragma unroll
            for (int b = 0; b < 2; ++b)
#pragma unroll
                for (int m = 0; m < 4; ++m)
#pragma unroll
                    for (int n = 0; n < 2; ++n) acc[a][b][m][n] = (f32x4){0.f, 0.f, 0.f, 0.f};
        cur = nxt; cA = nA; cB = nB; ++ui;
    }
    PG8_WAIT_V(0);
    if (wr == 0) PG8_BAR;
    PG8_BAR;
#undef PG8_SA
#undef PG8_SB
#undef PG8_STAGE
#undef PG8_LDA
#undef PG8_LDB
#undef PG8_MMA
#undef PG8_WAIT_V
#undef PG8_WAIT_L
#undef PG8_BAR
#undef PG8_SCHED
}
}

__device__ __forceinline__ void p0_transpose_item(const float* W, int N, bf16_t* WT, int ldk, int k0, int n0, long dst_row0, LAS float* scr, int lane) {
#pragma unroll 8
    for (int i = 0; i < 32; ++i) { const int kk = 2 * i + (lane >> 5); scr[kk * 33 + (lane & 31)] = W[(size_t)(k0 + kk) * N + n0 + (lane & 31)]; }
    asm volatile("s_waitcnt lgkmcnt(0)" ::: "memory");
    const int c = lane & 7;
#pragma unroll
    for (int j = 0; j < 4; ++j) { const int n = (lane >> 3) + 8 * j; const LAS float* s = scr + (8 * c) * 33 + n;
        u32x4 o; o.x = cvt_pk_bf16(s[0 * 33], s[1 * 33]); o.y = cvt_pk_bf16(s[2 * 33], s[3 * 33]); o.z = cvt_pk_bf16(s[4 * 33], s[5 * 33]); o.w = cvt_pk_bf16(s[6 * 33], s[7 * 33]);
        *(u32x4*)(WT + (size_t)(dst_row0 + n) * ldk + k0 + 8 * c) = o; }
    asm volatile("s_waitcnt lgkmcnt(0)" ::: "memory");
}

__device__ __forceinline__ void p0_phase(const Args& a, LAS unsigned char* lds, int tid, int wid, int lane) {
    unsigned char* ws = a.ws;
    LAS float* scr = (LAS float*)(lds + wid * 16384);
    const int gw = blockIdx.x * 8 + wid, NGW = gridDim.x * 8;
    constexpr int I_IN = 32 * 160, I_OUT = 32 * 64, I_G = 32 * 176, I_U = I_G, I_D = 88 * 64, I_PG = 32 * 64, I_PP = 4 * 64, I_RG = 32 * 8;
    constexpr int NITEMS = I_IN + I_OUT + I_G + I_U + I_D + I_PG + I_PP + I_RG;
    for (int it = gw; it < NITEMS; it += NGW) {
        int r = it;
        if (r < I_IN) { const int kb = r / 160, nb = r % 160; p0_transpose_item(a.in[3], DIN, (bf16_t*)(ws + WS_WIN), DM, kb * 64, nb * 32, nb * 32, scr, lane); continue; } r -= I_IN;
        if (r < I_OUT) { const int kb = r / 64, nb = r % 64; p0_transpose_item(a.in[14], DM, (bf16_t*)(ws + WS_WOUT), DM, kb * 64, nb * 32, nb * 32, scr, lane); continue; } r -= I_OUT;
        if (r < I_G) { const int kb = r / 176, nb = r % 176, n0 = nb * 32; p0_transpose_item(a.in[17], DFF, (bf16_t*)(ws + WS_WGU), DM, kb * 64, n0, (n0 >> 7) * 256 + (n0 & 127), scr, lane); continue; } r -= I_G;
        if (r < I_U) { const int kb = r / 176, nb = r % 176, n0 = nb * 32; p0_transpose_item(a.in[18], DFF, (bf16_t*)(ws + WS_WGU), DM, kb * 64, n0, (n0 >> 7) * 256 + 128 + (n0 & 127), scr, lane); continue; } r -= I_U;
        if (r < I_D) { const int kb = r / 64, nb = r % 64; p0_transpose_item(a.in[19], DM, (bf16_t*)(ws + WS_WD), DFF, kb * 64, nb * 32, nb * 32, scr, lane); continue; } r -= I_D;
        if (r < I_PG) { const int kb = r / 64, nb = r % 64; p0_transpose_item(a.in[22], DM, (bf16_t*)(ws + WS_WPG), DM, kb * 64, nb * 32, nb * 32, scr, lane); continue; } r -= I_PG;
        if (r < I_PP) { const int kb = r / 64, nb = r % 64; p0_transpose_item(a.in[23], DM, (bf16_t*)(ws + WS_WPP), DPLE, kb * 64, nb * 32, nb * 32, scr, lane); continue; } r -= I_PP;
        { const int mat = r >> 3, sub = r & 7, kb = sub >> 2, nb = sub & 3; const int zn = mat & 15, z = zn >> 3, n = zn & 7, ty = (mat >> 4) * 2 + z;
          const float* src = (mat < 16 ? a.in[7] : a.in[9]) + (size_t)zn * 16384;
          p0_transpose_item(src, 128, (bf16_t*)(ws + WS_WG), 128, kb * 64, nb * 32, n * 512 + ty * 128 + nb * 32, scr, lane); }
    }
    const float* x = a.in[0]; const float* g = a.in[2]; bf16_t* XN = (bf16_t*)(ws + WS_XN);
    for (int m = gw; m < MTOK; m += NGW) {
        const f32x4* xr = (const f32x4*)(x + (size_t)m * DM);
        f32x4 v[8]; float s = 0.f;
#pragma unroll
        for (int j = 0; j < 8; ++j) { v[j] = xr[j * 64 + lane]; s += (v[j].x * v[j].x + v[j].y * v[j].y) + (v[j].z * v[j].z + v[j].w * v[j].w); }
        const float rs = rsqrtf(wave_sum(s) * (1.f / DM) + EPS);
        u32x2* o = (u32x2*)(XN + (size_t)m * DM);
#pragma unroll
        for (int j = 0; j < 8; ++j) { const f32x4 gv = ((const f32x4*)g)[j * 64 + lane]; u32x2 w; w.x = cvt_pk_bf16(v[j].x * rs * gv.x, v[j].y * rs * gv.y); w.y = cvt_pk_bf16(v[j].z * rs * gv.z, v[j].w * rs * gv.w); o[j * 64 + lane] = w; }
    }
    const f32x4* p4 = (const f32x4*)a.in[1]; u32x2* pb = (u32x2*)(ws + WS_PB);
    for (size_t i = (size_t)blockIdx.x * 512 + tid; i < (size_t)MTOK * DPLE / 4; i += (size_t)gridDim.x * 512) { const f32x4 v = p4[i]; u32x2 w; w.x = cvt_pk_bf16(v.x, v.y); w.y = cvt_pk_bf16(v.z, v.w); pb[i] = w; }
}

__device__ __forceinline__ void attn_phase(const Args& a, LAS unsigned char* lds, int tid, int wid, int lane) {
    const bf16_t* U = (const bf16_t*)(a.ws + WS_U); bf16_t* A2 = (bf16_t*)(a.ws + WS_A2); float* patt = (float*)(a.ws + WS_PATT);
    LAS float* rp = (LAS float*)(lds + 65536);
    for (int i = tid; i < 8 * 15 * 31; i += 512) rp[i] = a.in[4][i];
    __syncthreads();
    const int qb = wid & 3, hh = wid >> 2, l15 = lane & 15, lq = lane >> 4;
    const unsigned vbase = (unsigned)wid * 8192u;
    const unsigned traddr = vbase + (unsigned)((4 * lq + (l15 >> 2)) * 256 + (4 * (lane & 3)) * 2);
    const float LOG2E = 1.4426950408889634f, SC = 0.08838834764831845f * 1.4426950408889634f;
    for (int it = blockIdx.x; it < 512; it += gridDim.x) {
        const int b = it >> 7, r = it & 127;
        const int rstart = min(max(r - 4, 0), 120);
        const int kc0 = min(max(16 * qb - 8, 0), 32);
        const int qcol = 16 * qb + l15, cstart = min(max(qcol - 8, 0), 48);
        const size_t tokq = (size_t)b * SEQ + r * 64 + qcol;
        for (int hi = 0; hi < 4; ++hi) {
            const int h = 2 * hi + hh;
            bf16x8 qf[4]; { const bf16_t* qp = U + tokq * DIN + h * 128 + lq * 32;
#pragma unroll
                for (int ks = 0; ks < 4; ++ks) qf[ks] = *(const bf16x8*)(qp + ks * 8); }
            f32x4 sT[16];
#pragma unroll
            for (int Tg = 0; Tg < 4; ++Tg) {
                bf16x8 kf[4][4];
#pragma unroll
                for (int tt = 0; tt < 4; ++tt) { const int T = Tg * 4 + tt;
                    const bf16_t* kp = U + ((size_t)b * SEQ + (rstart + (T >> 1)) * 64 + kc0 + 16 * (T & 1) + l15) * DIN + 1024 + h * 128 + lq * 32;
#pragma unroll
                    for (int ks = 0; ks < 4; ++ks) kf[tt][ks] = *(const bf16x8*)(kp + ks * 8); }
#pragma unroll
                for (int tt = 0; tt < 4; ++tt) { f32x4 s_ = (f32x4){0.f, 0.f, 0.f, 0.f};
#pragma unroll
                    for (int ks = 0; ks < 4; ++ks) s_ = __builtin_amdgcn_mfma_f32_16x16x32_bf16(kf[tt][ks], qf[ks], s_, 0, 0, 0);
                    sT[Tg * 4 + tt] = s_; }
                __builtin_amdgcn_sched_barrier(0);
            }
            float mx = -1e30f;
#pragma unroll
            for (int T = 0; T < 16; ++T) {
                const int dr = rstart + (T >> 1) - r + 7;
#pragma unroll
                for (int j = 0; j < 4; ++j) {
                    const int kc = kc0 + 16 * (T & 1) + 4 * lq + j; const bool valid = (kc >= cstart) && (kc < cstart + 16);
                    const int dc = min(max(kc - qcol + 15, 0), 30);
                    const float bias = rp[(h * 15 + dr) * 31 + dc];
                    const float t = valid ? (sT[T][j] * SC + bias * LOG2E) : -1e30f;
                    sT[T][j] = t; mx = fmaxf(mx, t);
                }
            }
            mx = fmaxf(mx, __shfl_xor(mx, 16)); mx = fmaxf(mx, __shfl_xor(mx, 32));
            float sum = 0.f;
#pragma unroll
            for (int T = 0; T < 16; ++T)
#pragma unroll
                for (int j = 0; j < 4; ++j) { const float p = __builtin_amdgcn_exp2f(sT[T][j] - mx); sT[T][j] = p; sum += p; }
            sum += __shfl_xor(sum, 16); sum += __shfl_xor(sum, 32);
            union PF { u32x4 u; bf16x8 v; }; PF pf[8];
#pragma unroll
            for (int kr = 0; kr < 8; ++kr) {
                pf[kr].u.x = cvt_pk_bf16(sT[2 * kr][0], sT[2 * kr][1]); pf[kr].u.y = cvt_pk_bf16(sT[2 * kr][2], sT[2 * kr][3]);
                pf[kr].u.z = cvt_pk_bf16(sT[2 * kr + 1][0], sT[2 * kr + 1][1]); pf[kr].u.w = cvt_pk_bf16(sT[2 * kr + 1][2], sT[2 * kr + 1][3]); }
            f32x4 oT[8];
#pragma unroll
            for (int dt = 0; dt < 8; ++dt) oT[dt] = (f32x4){0.f, 0.f, 0.f, 0.f};
            u32x4 vst[8];
            { const bf16_t* vp = U + ((size_t)b * SEQ + rstart * 64 + kc0) * DIN + 2048 + h * 128;
#pragma unroll
              for (int jj = 0; jj < 8; ++jj) { const int c = jj * 64 + lane; vst[jj] = *(const u32x4*)(vp + (size_t)(c >> 4) * DIN + (c & 15) * 8); } }
#pragma unroll
            for (int kr = 0; kr < 8; ++kr) {
#pragma unroll
                for (int jj = 0; jj < 8; ++jj) { const int c = jj * 64 + lane; *(LAS u32x4*)(lds + vbase + (c >> 4) * 256 + (c & 15) * 16) = vst[jj]; }
                if (kr < 7) { const bf16_t* vp = U + ((size_t)b * SEQ + (rstart + kr + 1) * 64 + kc0) * DIN + 2048 + h * 128;
#pragma unroll
                    for (int jj = 0; jj < 8; ++jj) { const int c = jj * 64 + lane; vst[jj] = *(const u32x4*)(vp + (size_t)(c >> 4) * DIN + (c & 15) * 8); } }
                s16x4 t0, t1, t2, t3, t4, t5, t6, t7, t8, t9, t10, t11, t12, t13, t14, t15;
                asm volatile("s_waitcnt lgkmcnt(0)\n\t"
                             "ds_read_b64_tr_b16 %0, %16 offset:0\n\t"   "ds_read_b64_tr_b16 %1, %16 offset:4096\n\t"
                             "ds_read_b64_tr_b16 %2, %16 offset:32\n\t"  "ds_read_b64_tr_b16 %3, %16 offset:4128\n\t"
                             "ds_read_b64_tr_b16 %4, %16 offset:64\n\t"  "ds_read_b64_tr_b16 %5, %16 offset:4160\n\t"
                             "ds_read_b64_tr_b16 %6, %16 offset:96\n\t"  "ds_read_b64_tr_b16 %7, %16 offset:4192\n\t"
                             "ds_read_b64_tr_b16 %8, %16 offset:128\n\t" "ds_read_b64_tr_b16 %9, %16 offset:4224\n\t"
                             "ds_read_b64_tr_b16 %10, %16 offset:160\n\t" "ds_read_b64_tr_b16 %11, %16 offset:4256\n\t"
                             "ds_read_b64_tr_b16 %12, %16 offset:192\n\t" "ds_read_b64_tr_b16 %13, %16 offset:4288\n\t"
                             "ds_read_b64_tr_b16 %14, %16 offset:224\n\t" "ds_read_b64_tr_b16 %15, %16 offset:4320\n\t"
                             "s_waitcnt lgkmcnt(0)"
                             : "=&v"(t0), "=&v"(t1), "=&v"(t2), "=&v"(t3), "=&v"(t4), "=&v"(t5), "=&v"(t6), "=&v"(t7),
                               "=&v"(t8), "=&v"(t9), "=&v"(t10), "=&v"(t11), "=&v"(t12), "=&v"(t13), "=&v"(t14), "=&v"(t15)
                             : "v"(traddr) : "memory");
#define PV_MMA(dt, lo, hi) { bf16x8 vf; vf[0] = lo[0]; vf[1] = lo[1]; vf[2] = lo[2]; vf[3] = lo[3]; vf[4] = hi[0]; vf[5] = hi[1]; vf[6] = hi[2]; vf[7] = hi[3]; \
                    oT[dt] = __builtin_amdgcn_mfma_f32_16x16x32_bf16(vf, pf[kr].v, oT[dt], 0, 0, 0); }
                PV_MMA(0, t0, t1) PV_MMA(1, t2, t3) PV_MMA(2, t4, t5) PV_MMA(3, t6, t7) PV_MMA(4, t8, t9) PV_MMA(5, t10, t11) PV_MMA(6, t12, t13) PV_MMA(7, t14, t15)
#undef PV_MMA
            }
            const float inv = 1.0f / sum; float ss = 0.f;
            bf16_t* op = A2 + tokq * DM + h * 128 + 4 * lq;
#pragma unroll
            for (int dt = 0; dt < 8; ++dt) { const f32x4 o = oT[dt] * inv; ss += (o[0] * o[0] + o[1] * o[1]) + (o[2] * o[2] + o[3] * o[3]);
                u32x2 w; w.x = cvt_pk_bf16(o[0], o[1]); w.y = cvt_pk_bf16(o[2], o[3]); *(u32x2*)(op + 16 * dt) = w; }
            ss += __shfl_xor(ss, 16); ss += __shfl_xor(ss, 32);
            if (lq == 0) patt[tokq * 8 + h] = ss;
        }
    }
    __syncthreads();
}

__device__ __forceinline__ void attn_phase_naive(const Args& a, int wid, int lane) {
    const bf16_t* U = (const bf16_t*)(a.ws + WS_U); bf16_t* A2 = (bf16_t*)(a.ws + WS_A2); float* patt = (float*)(a.ws + WS_PATT);
    const float* rpb = a.in[4];
    const int gw = blockIdx.x * 8 + wid, NGW = gridDim.x * 8;
    for (int wi = gw; wi < MTOK * 8; wi += NGW) {
        const int h = wi & 7, tok = wi >> 3, b = tok >> 13, s = tok & 8191, r = s >> 6, qcol = s & 63;
        const int rstart = min(max(r - 4, 0), 120), cstart = min(max(qcol - 8, 0), 48);
        const unsigned qw = *(const unsigned*)(U + (size_t)tok * DIN + h * 128 + 2 * lane);
        const float q0 = bf_lo(qw) * 0.08838834764831845f, q1 = bf_hi(qw) * 0.08838834764831845f;
        float mx = -1e30f, l = 0.f, o0 = 0.f, o1 = 0.f;
        for (int kr = 0; kr < 8; ++kr)
            for (int kc = 0; kc < 16; ++kc) {
                const size_t kt = (size_t)b * SEQ + (rstart + kr) * 64 + cstart + kc;
                const unsigned kw = *(const unsigned*)(U + kt * DIN + 1024 + h * 128 + 2 * lane);
                const unsigned vw = *(const unsigned*)(U + kt * DIN + 2048 + h * 128 + 2 * lane);
                float d = wave_sum(q0 * bf_lo(kw) + q1 * bf_hi(kw));
                d += rpb[(h * 15 + (rstart + kr - r + 7)) * 31 + (cstart + kc - qcol + 15)];
                const float nm = fmaxf(mx, d), sc = __expf(mx - nm), p = __expf(d - nm);
                l = l * sc + p; o0 = o0 * sc + p * bf_lo(vw); o1 = o1 * sc + p * bf_hi(vw); mx = nm;
            }
        o0 /= l; o1 /= l;
        *(unsigned*)(A2 + (size_t)tok * DM + h * 128 + 2 * lane) = cvt_pk_bf16(o0, o1);
        const float ss = wave_sum(o0 * o0 + o1 * o1);
        if (lane == 0) patt[(size_t)tok * 8 + h] = ss;
    }
}

template <bool FINAL>
__device__ __forceinline__ void rglru_phase(const Args& a, LAS unsigned char* lds, int tid, int wid, int lane) {
    const bf16_t* U = (const bf16_t*)(a.ws + WS_U); bf16_t* A2 = (bf16_t*)(a.ws + WS_A2); float* prec = (float*)(a.ws + WS_PREC);
    float* sumr = (float*)(a.ws + WS_SUM); const bf16_t* WG = (const bf16_t*)(a.ws + WS_WG);
    const float* conv_w = a.in[5]; const float* conv_b = a.in[6]; const float* b_a = a.in[8]; const float* b_i = a.in[10]; const float* lam = a.in[11];
    constexpr int XC_OFF = 0, YG_OFF = 34816, REC_OFF = 69632, RS = 272;
    const int cgp0 = tid & 15, tq0 = tid >> 4, l150 = lane & 15, lq0 = lane >> 4;
    for (int it = blockIdx.x; it < 2048; it += gridDim.x) {
        int cgp = cgp0, tq = tq0, l15 = l150, lq = lq0;
        asm volatile("" : "+v"(cgp), "+v"(tq), "+v"(l15), "+v"(lq));
        const int n = it & 7, c = (it >> 3) & 63, b = it >> 9, t0 = c * 128;
        {
            const int chb = n * 128 + cgp * 8;
            float xin[7][8];
#pragma unroll
            for (int rr = 0; rr < 7; ++rr) { const int ts = t0 + 4 * tq - 2 + rr;
                u32x4 v = (u32x4){0u, 0u, 0u, 0u};
                if (ts >= 0 && ts < SEQ) v = *(const u32x4*)(U + ((size_t)b * SEQ + ts) * DIN + 3072 + chb);
                xin[rr][0] = bf_lo(v.x); xin[rr][1] = bf_hi(v.x); xin[rr][2] = bf_lo(v.y); xin[rr][3] = bf_hi(v.y); xin[rr][4] = bf_lo(v.z); xin[rr][5] = bf_hi(v.z); xin[rr][6] = bf_lo(v.w); xin[rr][7] = bf_hi(v.w); }
            float cw[4][8], cb[8];
#pragma unroll
            for (int j = 0; j < 4; ++j) { const f32x4 w0 = *(const f32x4*)(conv_w + j * DREC + chb), w1 = *(const f32x4*)(conv_w + j * DREC + chb + 4);
                cw[j][0] = w0.x; cw[j][1] = w0.y; cw[j][2] = w0.z; cw[j][3] = w0.w; cw[j][4] = w1.x; cw[j][5] = w1.y; cw[j][6] = w1.z; cw[j][7] = w1.w; }
            { const f32x4 w0 = *(const f32x4*)(conv_b + chb), w1 = *(const f32x4*)(conv_b + chb + 4); cb[0] = w0.x; cb[1] = w0.y; cb[2] = w0.z; cb[3] = w0.w; cb[4] = w1.x; cb[5] = w1.y; cb[6] = w1.z; cb[7] = w1.w; }
#pragma unroll
            for (int i = 0; i < 4; ++i) { float o[8];
#pragma unroll
                for (int e = 0; e < 8; ++e) o[e] = cb[e] + cw[0][e] * xin[i][e] + cw[1][e] * xin[i + 1][e] + cw[2][e] * xin[i + 2][e] + cw[3][e] * xin[i + 3][e];
                u32x4 w; w.x = cvt_pk_bf16(o[0], o[1]); w.y = cvt_pk_bf16(o[2], o[3]); w.z = cvt_pk_bf16(o[4], o[5]); w.w = cvt_pk_bf16(o[6], o[7]);
                *(LAS u32x4*)(lds + XC_OFF + (4 * tq + i) * RS + cgp * 16) = w; }
            if (FINAL) {
#pragma unroll
                for (int i = 0; i < 4; ++i) { const u32x4 v = *(const u32x4*)(U + ((size_t)b * SEQ + t0 + 4 * tq + i) * DIN + 4096 + chb); *(LAS u32x4*)(lds + YG_OFF + (4 * tq + i) * RS + cgp * 16) = v; }
            }
        }
        __syncthreads();
        const int chl = 16 * wid + l15, gch = n * 128 + chl;
        float cend[2], ptot[2];
        f32x4 hs[8];
#pragma unroll
        for (int dir = 0; dir < 2; ++dir) {
            f32x4 acc[2][8];
#pragma unroll
            for (int ty = 0; ty < 2; ++ty)
#pragma unroll
                for (int mt = 0; mt < 8; ++mt) acc[ty][mt] = (f32x4){0.f, 0.f, 0.f, 0.f};
#pragma unroll
            for (int ks = 0; ks < 4; ++ks) {
                bf16x8 af[8];
#pragma unroll
                for (int mt = 0; mt < 8; ++mt) af[mt] = *(const LAS bf16x8*)(lds + XC_OFF + (16 * mt + l15) * RS + (ks * 32 + lq * 8) * 2);
#pragma unroll
                for (int ty = 0; ty < 2; ++ty) { const bf16x8 wf = *(const bf16x8*)(WG + (size_t)(n * 512 + (ty * 2 + dir) * 128 + chl) * 128 + ks * 32 + lq * 8);
#pragma unroll
                    for (int mt = 0; mt < 8; ++mt) acc[ty][mt] = __builtin_amdgcn_mfma_f32_16x16x32_bf16(af[mt], wf, acc[ty][mt], 0, 0, 0); }
            }
            __builtin_amdgcn_sched_barrier(0);
            const float ba = b_a[dir * DREC + gch], bi = b_i[dir * DREC + gch];
            const float kf = 8.0f * log1pf(expf(-lam[dir * DREC + gch]));
#pragma unroll
            for (int mt = 0; mt < 8; ++mt) {
#pragma unroll
                for (int r = 0; r < 4; ++r) {
                    const int tt = 16 * mt + 4 * lq + r;
                    const float xcv = bf1(*(const LAS unsigned short*)(lds + XC_OFF + tt * RS + chl * 2));
                    const float rg = fast_sigmoid(acc[0][mt][r] + ba), ig = fast_sigmoid(acc[1][mt][r] + bi), av = __expf(-kf * rg);
                    acc[0][mt][r] = av; acc[1][mt][r] = sqrtf(fmaxf(1.0f - av * av, 0.f)) * ig * xcv;
                }
                __builtin_amdgcn_sched_barrier(0);
            }
            __builtin_amdgcn_sched_barrier(0);
            float cr = 0.f;
            if (FINAL) {
                float P = 1.f, H = 0.f;
                if (dir == 0) { const int lo = lq * 16, hi = min(lo + 16, c);
                    for (int cc = lo; cc < hi; ++cc) { const float* sp = sumr + ((size_t)((b * 64 + cc) * 2 + 0) * 2) * 1024 + gch; const float A = sp[0], Hc = sp[1024]; H = A * H + Hc; P *= A; }
#pragma unroll
                    for (int g = 0; g < 4; ++g) { const float Pg = __shfl(P, g * 16 + l15), Hg = __shfl(H, g * 16 + l15); cr = Pg * cr + Hg; } }
                else { const int lo = max(lq * 16, c + 1), hi = lq * 16 + 16;
                    for (int cc = hi - 1; cc >= lo; --cc) { const float* sp = sumr + ((size_t)((b * 64 + cc) * 2 + 1) * 2) * 1024 + gch; const float A = sp[0], Hc = sp[1024]; H = A * H + Hc; P *= A; }
#pragma unroll
                    for (int g = 3; g >= 0; --g) { const float Pg = __shfl(P, g * 16 + l15), Hg = __shfl(H, g * 16 + l15); cr = Pg * cr + Hg; } }
            }
            __builtin_amdgcn_sched_barrier(0);
            float pt = 1.f;
            if (dir == 0) {
#pragma unroll
                for (int mt = 0; mt < 8; ++mt) {
                    float H = 0.f, P = 1.f, hl[4], pl[4];
#pragma unroll
                    for (int r = 0; r < 4; ++r) { H = acc[0][mt][r] * H + acc[1][mt][r]; P *= acc[0][mt][r]; hl[r] = H; pl[r] = P; }
                    const float P0 = __shfl(P, l15), H0 = __shfl(H, l15), P1 = __shfl(P, 16 + l15), H1 = __shfl(H, 16 + l15), P2 = __shfl(P, 32 + l15), H2 = __shfl(H, 32 + l15), P3 = __shfl(P, 48 + l15), H3 = __shfl(H, 48 + l15);
                    const float c0 = cr, c1 = P0 * c0 + H0, c2 = P1 * c1 + H1, c3 = P2 * c2 + H2, c4 = P3 * c3 + H3;
                    if (FINAL) { const float mine = lq == 0 ? c0 : (lq == 1 ? c1 : (lq == 2 ? c2 : c3));
#pragma unroll
                        for (int r = 0; r < 4; ++r) hs[mt][r] = hl[r] + pl[r] * mine; }
                    else pt *= (P0 * P1) * (P2 * P3);
                    cr = c4;
                }
            } else {
#pragma unroll
                for (int mt = 7; mt >= 0; --mt) {
                    float H = 0.f, P = 1.f, hl[4], pl[4];
#pragma unroll
                    for (int r = 3; r >= 0; --r) { H = acc[0][mt][r] * H + acc[1][mt][r]; P *= acc[0][mt][r]; hl[r] = H; pl[r] = P; }
                    const float P0 = __shfl(P, l15), H0 = __shfl(H, l15), P1 = __shfl(P, 16 + l15), H1 = __shfl(H, 16 + l15), P2 = __shfl(P, 32 + l15), H2 = __shfl(H, 32 + l15), P3 = __shfl(P, 48 + l15), H3 = __shfl(H, 48 + l15);
                    const float c3 = cr, c2 = P3 * c3 + H3, c1 = P2 * c2 + H2, c0 = P1 * c1 + H1, cn = P0 * c0 + H0;
                    if (FINAL) { const float mine = lq == 0 ? c0 : (lq == 1 ? c1 : (lq == 2 ? c2 : c3));
#pragma unroll
                        for (int r = 0; r < 4; ++r) hs[mt][r] += hl[r] + pl[r] * mine; }
                    else pt *= (P0 * P1) * (P2 * P3);
                    cr = cn;
                }
            }
            cend[dir] = cr; ptot[dir] = pt;
            __builtin_amdgcn_sched_barrier(0);
        }
        if (!FINAL) {
            if (lq == 0) { float* sp = sumr + ((size_t)((b * 64 + c) * 2 + 0) * 2) * 1024 + gch; sp[0] = ptot[0]; sp[1024] = cend[0]; sp[2048] = ptot[1]; sp[3072] = cend[1]; }
            __syncthreads();
        } else {
#pragma unroll
            for (int mt = 0; mt < 8; ++mt) {
#pragma unroll
                for (int r = 0; r < 4; ++r) { const int tt = 16 * mt + 4 * lq + r;
                    const float y = bf1(*(const LAS unsigned short*)(lds + YG_OFF + tt * RS + chl * 2));
                    const float z = 0.7978845608028654f * (y + 0.044715f * y * y * y);
                    const float gl = y * fast_sigmoid(2.0f * z);
                    const float v = hs[mt][r] * gl;
                    *(LAS unsigned short*)(lds + REC_OFF + tt * RS + chl * 2) = (unsigned short)(cvt_pk_bf16(v, 0.f) & 0xffffu); }
                __builtin_amdgcn_sched_barrier(0);
            }
            __syncthreads();
            { const int tok = tid >> 2, qtr = tid & 3; float ss = 0.f;
              bf16_t* dst = A2 + ((size_t)b * SEQ + t0 + tok) * DM + DATT + n * 128 + qtr * 32;
#pragma unroll
              for (int j = 0; j < 4; ++j) { const u32x4 v = *(const LAS u32x4*)(lds + REC_OFF + tok * RS + qtr * 64 + j * 16);
                  const float e0 = bf_lo(v.x), e1 = bf_hi(v.x), e2 = bf_lo(v.y), e3 = bf_hi(v.y), e4 = bf_lo(v.z), e5 = bf_hi(v.z), e6 = bf_lo(v.w), e7 = bf_hi(v.w);
                  ss += (e0 * e0 + e1 * e1) + (e2 * e2 + e3 * e3) + (e4 * e4 + e5 * e5) + (e6 * e6 + e7 * e7);
                  *(u32x4*)(dst + j * 8) = v; }
              ss += __shfl_xor(ss, 1); ss += __shfl_xor(ss, 2);
              if (qtr == 0) prec[((size_t)b * SEQ + t0 + tok) * 8 + n] = ss; }
            __syncthreads();
        }
    }
}

__device__ __forceinline__ void fixup_phase(const Args& a, int wid, int lane) {
    bf16_t* A2 = (bf16_t*)(a.ws + WS_A2); const float* patt = (const float*)(a.ws + WS_PATT); const float* prec = (const float*)(a.ws + WS_PREC);
    const float* ga = a.in[12]; const float* gr = a.in[13];
    const int gw = blockIdx.x * 8 + wid, NGW = gridDim.x * 8;
    for (int m = gw; m < MTOK; m += NGW) {
        float pv = (lane < 8) ? patt[(size_t)m * 8 + lane] : ((lane < 16) ? prec[(size_t)m * 8 + lane - 8] : 0.f);
        pv += __shfl_xor(pv, 1); pv += __shfl_xor(pv, 2); pv += __shfl_xor(pv, 4);
        const float ssa = __shfl(pv, 0), ssr = __shfl(pv, 8);
        const float rsa = rsqrtf(ssa * (1.f / DATT) + EPS), rsr = rsqrtf(ssr * (1.f / DREC) + EPS);
        u32x4* row = (u32x4*)(A2 + (size_t)m * DM);
#pragma unroll
        for (int j = 0; j < 4; ++j) { const int ci = j * 64 + lane; const u32x4 v = row[ci];
            const float rs = (j < 2) ? rsa : rsr; const float* gp = (j < 2) ? (ga + ci * 8) : (gr + (ci - 128) * 8);
            const f32x4 g0 = *(const f32x4*)gp, g1 = *(const f32x4*)(gp + 4);
            u32x4 w; w.x = cvt_pk_bf16(bf_lo(v.x) * rs * g0.x, bf_hi(v.x) * rs * g0.y); w.y = cvt_pk_bf16(bf_lo(v.y) * rs * g0.z, bf_hi(v.y) * rs * g0.w);
            w.z = cvt_pk_bf16(bf_lo(v.z) * rs * g1.x, bf_hi(v.z) * rs * g1.y); w.w = cvt_pk_bf16(bf_lo(v.w) * rs * g1.z, bf_hi(v.w) * rs * g1.w);
            row[ci] = w; }
    }
}

template <int MODE>
__device__ __forceinline__ void epass_phase(const Args& a, const float* hsrc, const float* g_post, const float* g_pre, int wid, int lane) {
    const bf16_t* Y = (const bf16_t*)(a.ws + WS_Y); const float* part = (const float*)(a.ws + WS_PART); bf16_t* XN = (bf16_t*)(a.ws + WS_XN); float* out = a.out;
    const int gw = blockIdx.x * 8 + wid, NGW = gridDim.x * 8;
    for (int m = gw; m < MTOK; m += NGW) {
        float pv = part[(size_t)m * 32 + (lane & 31)];
#pragma unroll
        for (int o = 1; o < 32; o <<= 1) pv += __shfl_xor(pv, o);
        const float rs = rsqrtf(pv * (1.f / DM) + EPS);
        const f32x4* hr = (const f32x4*)(hsrc + (size_t)m * DM); const u32x2* yr = (const u32x2*)(Y + (size_t)m * DM); f32x4* orow = (f32x4*)(out + (size_t)m * DM);
        f32x4 h[8]; float s2 = 0.f;
#pragma unroll
        for (int j = 0; j < 8; ++j) { const f32x4 hv = hr[j * 64 + lane]; const u32x2 yv = yr[j * 64 + lane]; const f32x4 g = ((const f32x4*)g_post)[j * 64 + lane];
            f32x4 o; o.x = hv.x + bf_lo(yv.x) * rs * g.x; o.y = hv.y + bf_hi(yv.x) * rs * g.y; o.z = hv.z + bf_lo(yv.y) * rs * g.z; o.w = hv.w + bf_hi(yv.y) * rs * g.w;
            h[j] = o; orow[j * 64 + lane] = o; s2 += (o.x * o.x + o.y * o.y) + (o.z * o.z + o.w * o.w); }
        if (MODE < 2) {
            const float rs2 = rsqrtf(wave_sum(s2) * (1.f / DM) + EPS);
            u32x2* xo = (u32x2*)(XN + (size_t)m * DM);
#pragma unroll
            for (int j = 0; j < 8; ++j) { const f32x4 g = ((const f32x4*)g_pre)[j * 64 + lane]; u32x2 w; w.x = cvt_pk_bf16(h[j].x * rs2 * g.x, h[j].y * rs2 * g.y); w.y = cvt_pk_bf16(h[j].z * rs2 * g.z, h[j].w * rs2 * g.w); xo[j * 64 + lane] = w; }
        }
    }
}

__global__ void __launch_bounds__(512) fwd_kernel(Args a) {
    extern __shared__ __attribute__((aligned(16))) unsigned char lds_raw[];
    LAS unsigned char* lds = (LAS unsigned char*)lds_raw;
    const int tid = threadIdx.x, wid = __builtin_amdgcn_readfirstlane(tid >> 6), lane = tid & 63;
    unsigned char* ws = a.ws;
    const int lo = a.ph_lo, hi = a.ph_hi;
#define IN(k) (lo <= (k) && (k) < hi && PH_ON(k))
#define SEAM(k) do { if (lo <= (k) && (k) + 1 < hi) cg::this_grid().sync(); } while (0)
    if (IN(0)) p0_phase(a, lds, tid, wid, lane);
    SEAM(0);
    if (IN(1)) {
        for (int gi = 0; gi < 2; ++gi) {
            pg8::Gemm g{(const bf16_t*)(ws + (gi ? WS_PB : WS_XN)), (const bf16_t*)(ws + (gi ? WS_WPP : WS_WIN)), MTOK, gi ? DM : DIN, gi ? DPLE : DM}; pg8::StaticOrder S; S.init(MTOK, gi ? DM : DIN, gridDim.x, blockIdx.x);
            pg8::EpiStore E{(bf16_t*)(ws + (gi ? WS_PLE : WS_U)), gi ? DM : DIN}; pg8::gemm_phase(lds, g, S, E); }
    }
    SEAM(1);
    if (IN(2)) {
#if NAIVE_ATTN
        attn_phase_naive(a, wid, lane);
#else
#ifndef SKIP_ATTN
        attn_phase(a, lds, tid, wid, lane);
#endif
#endif
#ifndef SKIP_R1
        rglru_phase<false>(a, lds, tid, wid, lane);
#endif
    }
    SEAM(2);
    if (IN(3)) rglru_phase<true>(a, lds, tid, wid, lane);
    SEAM(3);
    if (IN(4)) fixup_phase(a, wid, lane);
    SEAM(4);
    if (IN(5)) { pg8::Gemm g{(const bf16_t*)(ws + WS_A2), (const bf16_t*)(ws + WS_WOUT), MTOK, DM, DM}; pg8::StaticOrder S; S.init(MTOK, DM, gridDim.x, blockIdx.x);
        pg8::EpiStoreSS E{(bf16_t*)(ws + WS_Y), DM, (float*)(ws + WS_PART)}; pg8::gemm_phase(lds, g, S, E); }
    SEAM(5);
    if (IN(6)) epass_phase<0>(a, a.in[0], a.in[15], a.in[16], wid, lane);
    SEAM(6);
    if (IN(7)) { pg8::Gemm g{(const bf16_t*)(ws + WS_XN), (const bf16_t*)(ws + WS_WGU), MTOK, 2 * DFF, DM}; pg8::StaticOrder S; S.init(MTOK, 2 * DFF, gridDim.x, blockIdx.x);
        pg8::EpiSwiglu E{(bf16_t*)(ws + WS_ACT), DFF}; pg8::gemm_phase(lds, g, S, E); }
    SEAM(7);
    if (IN(8)) { pg8::Gemm g{(const bf16_t*)(ws + WS_ACT), (const bf16_t*)(ws + WS_WD), MTOK, DM, DFF}; pg8::StaticOrder S; S.init(MTOK, DM, gridDim.x, blockIdx.x);
        pg8::EpiStoreSS E{(bf16_t*)(ws + WS_Y), DM, (float*)(ws + WS_PART)}; pg8::gemm_phase(lds, g, S, E); }
    SEAM(8);
    if (IN(9)) epass_phase<1>(a, a.out, a.in[20], a.in[21], wid, lane);
    SEAM(9);
    if (IN(10)) { pg8::Gemm g{(const bf16_t*)(ws + WS_XN), (const bf16_t*)(ws + WS_WPG), MTOK, DM, DM}; pg8::StaticOrder S; S.init(MTOK, DM, gridDim.x, blockIdx.x);
        pg8::EpiPleGate E{(bf16_t*)(ws + WS_Y), DM, (const bf16_t*)(ws + WS_PLE), (float*)(ws + WS_PART)}; pg8::gemm_phase(lds, g, S, E); }
    SEAM(10);
    if (IN(11)) epass_phase<2>(a, a.out, a.in[24], nullptr, wid, lane);
#undef IN
#undef SEAM
}

extern "C" void kernel_launch(void* const* d_in, const int* in_sizes, int n_in, void* d_out, int out_size, void* d_ws, size_t ws_size, hipStream_t stream) {
    static int grid = 0;
    if (grid == 0) {
        int dev = 0, cus = 0;
        if (hipGetDevice(&dev) != hipSuccess || hipDeviceGetAttribute(&cus, hipDeviceAttributeMultiprocessorCount, dev) != hipSuccess) { fprintf(stderr, "device query failed\n"); grid = -1; return; }
        if (hipFuncSetAttribute((const void*)fwd_kernel, hipFuncAttributeMaxDynamicSharedMemorySize, LDS_BYTES) != hipSuccess) { fprintf(stderr, "hipFuncSetAttribute failed\n"); grid = -1; return; }
        int per_cu = 0;
        if (hipOccupancyMaxActiveBlocksPerMultiprocessor(&per_cu, (const void*)fwd_kernel, 512, LDS_BYTES) != hipSuccess || per_cu < 1) { fprintf(stderr, "occupancy query: %d\n", per_cu); per_cu = 1; }
        (void)hipGetLastError();
        grid = cus;
        if (ws_size < 968 * MiB) fprintf(stderr, "workspace too small: %zu\n", ws_size);
    }
    if (grid < 0) return;
    Args a{};
    for (int i = 0; i < 25; ++i) a.in[i] = (const float*)d_in[i];
    a.out = (float*)d_out; a.ws = (unsigned char*)d_ws;
#if MK_ONE_LAUNCH
    a.ph_lo = 0; a.ph_hi = NPH;
    void* args[] = {&a};
    hipError_t e = hipLaunchCooperativeKernel((const void*)fwd_kernel, dim3(grid), dim3(512), args, LDS_BYTES, stream);
    if (e != hipSuccess) fprintf(stderr, "cooperative launch failed: %s (grid %d)\n", hipGetErrorString(e), grid);
#else
    for (int ph = 0; ph < NPH; ++ph) { a.ph_lo = ph; a.ph_hi = ph + 1; hipLaunchKernelGGL(fwd_kernel, dim3(grid), dim3(512), LDS_BYTES, stream, a); }
#endif
}
```

```cpp
#include <hip/hip_runtime.h>
#include <hip/hip_cooperative_groups.h>
#include <cstdio>
namespace cg = cooperative_groups;

#ifndef MK_ONE_LAUNCH
#define MK_ONE_LAUNCH 1
#endif
#ifndef PH_MASK
#define PH_MASK 0xFFF
#endif
#define PH_ON(k) ((PH_MASK >> (k)) & 1)
#ifndef DUP_MASK
#define DUP_MASK 0x0
#endif
#define NREP(k) (1 + ((DUP_MASK >> (k)) & 1))
#ifndef NAIVE_ATTN
#define NAIVE_ATTN 0
#endif

#define LAS __attribute__((address_space(3)))
typedef unsigned short bf16_t;
typedef short bf16x8 __attribute__((ext_vector_type(8)));
typedef short s16x4 __attribute__((ext_vector_type(4)));
typedef float f32x4 __attribute__((ext_vector_type(4)));
typedef float f32x2 __attribute__((ext_vector_type(2)));
typedef unsigned u32x4 __attribute__((ext_vector_type(4)));
typedef unsigned u32x2 __attribute__((ext_vector_type(2)));

constexpr int MTOK = 32768, DM = 2048, DIN = 5120, DATT = 1024, DREC = 1024, DFF = 5632, DPLE = 256, SEQ = 8192;
constexpr float EPS = 1e-6f;
constexpr int NPH = 12;
constexpr int LDS_BYTES = 147456;

constexpr size_t MiB = 1u << 20;
constexpr size_t WS_U = 0;
constexpr size_t WS_A2 = 320 * MiB;
constexpr size_t WS_ACT = 0;
constexpr size_t WS_XN = 448 * MiB;
constexpr size_t WS_Y = 576 * MiB;
constexpr size_t WS_PLE = 704 * MiB;
constexpr size_t WS_PB = 832 * MiB;
constexpr size_t WS_WIN = 848 * MiB;
constexpr size_t WS_WOUT = 868 * MiB;
constexpr size_t WS_WGU = 876 * MiB;
constexpr size_t WS_WD = 920 * MiB;
constexpr size_t WS_WPG = 942 * MiB;
constexpr size_t WS_WPP = 950 * MiB;
constexpr size_t WS_WG = 951 * MiB;
constexpr size_t WS_PART = 952 * MiB;
constexpr size_t WS_PATT = 956 * MiB;
constexpr size_t WS_PREC = 957 * MiB;
constexpr size_t WS_SUM = 958 * MiB;
constexpr size_t WS_RSQ = 966 * MiB;

struct Args {
    const float* in[25];
    float* out;
    unsigned char* ws;
    int ph_lo, ph_hi;
};

__device__ __forceinline__ unsigned cvt_pk_bf16(float lo, float hi) { unsigned r; asm volatile("v_cvt_pk_bf16_f32 %0, %1, %2" : "=v"(r) : "v"(lo), "v"(hi)); return r; }
__device__ __forceinline__ float bf_lo(unsigned w) { return __uint_as_float(w << 16); }
__device__ __forceinline__ float bf_hi(unsigned w) { return __uint_as_float(w & 0xffff0000u); }
__device__ __forceinline__ float bf1(unsigned short h) { return __uint_as_float(((unsigned)h) << 16); }
__device__ __forceinline__ float wave_sum(float v) {
#pragma unroll
    for (int o = 1; o < 64; o <<= 1) v += __shfl_xor(v, o);
    return v;
}
__device__ __forceinline__ float fast_sigmoid(float x) { return __builtin_amdgcn_rcpf(1.0f + __expf(-x)); }

namespace pg8 {
constexpr int BM = 256, BK = 64, HALF = 128, HTB = HALF * BK * 2, STAGE_BYTES = 8 * HTB, NXCD = 8, WGM = 8;
__host__ __device__ __forceinline__ int lds_byte(int r, int c) { const int st = (r >> 4) * 2 + (c >> 5), rr = r & 15, cc = c & 31, ob = rr * 64 + cc * 2; return st * 1024 + (ob ^ (((ob >> 9) & 1) << 5)); }
__host__ __device__ __forceinline__ void stage_rc(int b, int& R, int& C) { const int st = b / 1024, sb = b % 1024, swz = sb ^ (((sb >> 9) & 1) << 5); R = (st >> 1) * 16 + swz / 64; C = (st & 1) * 32 + (swz % 64) / 2; }
__host__ __device__ __forceinline__ int perm32(int rho) { const int n = rho >> 4, i = rho & 15; return 8 * (i >> 2) + 4 * n + (i & 3); }
struct Unit { int pm, pn; };
struct Gemm { const bf16_t* A; const bf16_t* Bt; int M, N, K; };
struct StaticOrder {
    int nM, nN, nwg, G, c;
    __device__ void init(int M, int N, int G_, int c_) { nM = M / BM; nN = N / BM; nwg = nM * nN; G = G_; c = c_; }
    __device__ bool next(int i, Unit& u) const {
        const long L = (long)i * G + c; if (L >= nwg) return false;
        int wgid = (int)L; { const int q = nwg / NXCD, r = nwg % NXCD, xcd = wgid % NXCD, off = wgid / NXCD; wgid = (xcd < r ? xcd * (q + 1) : r * (q + 1) + (xcd - r) * q) + off; }
        const int nig = WGM * nN, gid = wgid / nig, fm = gid * WGM, gsz = (nM - fm) < WGM ? (nM - fm) : WGM;
        u.pm = fm + ((wgid % nig) % gsz); u.pn = (wgid % nig) / gsz; return true;
    }
};

struct EpiStore {
    static constexpr bool PERM = true;
    bf16_t* O; int ldc;
    __device__ __forceinline__ void operator()(const f32x4 (&acc)[2][2][4][2], const Unit& u, int wr, int wc, int fr, int fq) const {
        const int row0 = u.pm * BM + wr * 64 + fr, col0 = u.pn * BM + wc * 32 + 8 * fq;
#pragma unroll
        for (int ai = 0; ai < 2; ++ai)
#pragma unroll
            for (int m = 0; m < 4; ++m) { bf16_t* rowp = O + (size_t)(row0 + ai * HALF + m * 16) * ldc + col0;
#pragma unroll
                for (int bj = 0; bj < 2; ++bj) { const f32x4 v0 = acc[ai][bj][m][0], v1 = acc[ai][bj][m][1];
                    u32x4 w; w.x = cvt_pk_bf16(v0[0], v0[1]); w.y = cvt_pk_bf16(v0[2], v0[3]); w.z = cvt_pk_bf16(v1[0], v1[1]); w.w = cvt_pk_bf16(v1[2], v1[3]);
                    *(u32x4*)(rowp + bj * HALF) = w; } }
    }
};
struct EpiStoreSS {
    static constexpr bool PERM = true;
    bf16_t* O; int ldc; float* part;
    __device__ __forceinline__ void operator()(const f32x4 (&acc)[2][2][4][2], const Unit& u, int wr, int wc, int fr, int fq) const {
        const int row0 = u.pm * BM + wr * 64 + fr, col0 = u.pn * BM + wc * 32 + 8 * fq;
#pragma unroll
        for (int ai = 0; ai < 2; ++ai)
#pragma unroll
            for (int m = 0; m < 4; ++m) { const int row = row0 + ai * HALF + m * 16; bf16_t* rowp = O + (size_t)row * ldc + col0; float s = 0.f;
#pragma unroll
                for (int bj = 0; bj < 2; ++bj) { const f32x4 v0 = acc[ai][bj][m][0], v1 = acc[ai][bj][m][1];
                    s += (v0[0] * v0[0] + v0[1] * v0[1]) + (v0[2] * v0[2] + v0[3] * v0[3]) + (v1[0] * v1[0] + v1[1] * v1[1]) + (v1[2] * v1[2] + v1[3] * v1[3]);
                    u32x4 w; w.x = cvt_pk_bf16(v0[0], v0[1]); w.y = cvt_pk_bf16(v0[2], v0[3]); w.z = cvt_pk_bf16(v1[0], v1[1]); w.w = cvt_pk_bf16(v1[2], v1[3]);
                    *(u32x4*)(rowp + bj * HALF) = w; }
                s += __shfl_xor(s, 16); s += __shfl_xor(s, 32);
                if (fq == 0) part[(size_t)row * 32 + u.pn * 4 + wc] = s; }
    }
};
struct EpiSwiglu {
    static constexpr bool PERM = true;
    bf16_t* O; int ldc; const float* rsq;
    __device__ __forceinline__ void operator()(const f32x4 (&acc)[2][2][4][2], const Unit& u, int wr, int wc, int fr, int fq) const {
        const int row0 = u.pm * BM + wr * 64 + fr, col0 = u.pn * HALF + wc * 32 + 8 * fq;
#pragma unroll
        for (int ai = 0; ai < 2; ++ai)
#pragma unroll
            for (int m = 0; m < 4; ++m) { const int row = row0 + ai * HALF + m * 16; bf16_t* rowp = O + (size_t)row * ldc + col0; const float rr = rsq[row];
                float v[8];
#pragma unroll
                for (int n = 0; n < 2; ++n)
#pragma unroll
                    for (int j = 0; j < 4; ++j) { const float g = acc[ai][0][m][n][j] * rr, up = acc[ai][1][m][n][j] * rr; v[n * 4 + j] = g * fast_sigmoid(g) * up; }
                u32x4 w; w.x = cvt_pk_bf16(v[0], v[1]); w.y = cvt_pk_bf16(v[2], v[3]); w.z = cvt_pk_bf16(v[4], v[5]); w.w = cvt_pk_bf16(v[6], v[7]);
                *(u32x4*)rowp = w; }
    }
};
struct EpiPleGate {
    static constexpr bool PERM = true;
    bf16_t* O; int ldc; const bf16_t* ple; float* part; const float* rsq;
    __device__ __forceinline__ void operator()(const f32x4 (&acc)[2][2][4][2], const Unit& u, int wr, int wc, int fr, int fq) const {
        const int row0 = u.pm * BM + wr * 64 + fr, col0 = u.pn * BM + wc * 32 + 8 * fq;
#pragma unroll
        for (int ai = 0; ai < 2; ++ai)
#pragma unroll
            for (int m = 0; m < 4; ++m) { const int row = row0 + ai * HALF + m * 16; const size_t off = (size_t)row * ldc + col0; float s = 0.f; const float rr = rsq[row];
#pragma unroll
                for (int bj = 0; bj < 2; ++bj) { const u32x4 pl = *(const u32x4*)(ple + off + bj * HALF);
                    const f32x4 a0 = acc[ai][bj][m][0] * rr, a1 = acc[ai][bj][m][1] * rr; float v[8];
                    v[0] = fast_sigmoid(a0[0]) * bf_lo(pl.x); v[1] = fast_sigmoid(a0[1]) * bf_hi(pl.x); v[2] = fast_sigmoid(a0[2]) * bf_lo(pl.y); v[3] = fast_sigmoid(a0[3]) * bf_hi(pl.y);
                    v[4] = fast_sigmoid(a1[0]) * bf_lo(pl.z); v[5] = fast_sigmoid(a1[1]) * bf_hi(pl.z); v[6] = fast_sigmoid(a1[2]) * bf_lo(pl.w); v[7] = fast_sigmoid(a1[3]) * bf_hi(pl.w);
#pragma unroll
                    for (int j = 0; j < 8; ++j) s += v[j] * v[j];
                    u32x4 w; w.x = cvt_pk_bf16(v[0], v[1]); w.y = cvt_pk_bf16(v[2], v[3]); w.z = cvt_pk_bf16(v[4], v[5]); w.w = cvt_pk_bf16(v[6], v[7]);
                    *(u32x4*)(O + off + bj * HALF) = w; }
                s += __shfl_xor(s, 16); s += __shfl_xor(s, 32);
                if (fq == 0) part[(size_t)row * 32 + u.pn * 4 + wc] = s; }
    }
};

template <class Epi, class Sched>
__device__ __forceinline__ void gemm_phase(LAS unsigned char* lds, const Gemm g, const Sched& S, const Epi& E) {
    const int tid = threadIdx.x, wid = __builtin_amdgcn_readfirstlane(tid >> 6), lane = tid & 63, wr = wid >> 2, wc = wid & 3, fr = lane & 15, fq = lane >> 4;
    const int K = g.K, nt = K / BK;
    unsigned voffA[2], voffB[2];
#pragma unroll
    for (int i = 0; i < 2; ++i) { int R, C; stage_rc(tid * 16 + i * 8192, R, C); const int Rb = Epi::PERM ? ((R & ~31) + perm32(R & 31)) : R;
        voffA[i] = (unsigned)(R * K + C) * 2u; voffB[i] = (unsigned)(Rb * K + C) * 2u; }
    const size_t kstep = (size_t)(BK * 2);
    const size_t hstep = (size_t)HALF * K * 2;
    const size_t tstep = 2 * hstep;
    const unsigned ldsw = (unsigned)wid * 1024u;
    const int aoff = lds_byte(wr * 64 + fr, fq * 8), boff = lds_byte(wc * 32 + fr, fq * 8);
#define PG8_SA(b, h) (((b) * 2 + (h)) * HTB)
#define PG8_SB(b, h) ((4 + (b) * 2 + (h)) * HTB)
#define PG8_STAGE(bufoff, gbase, voff) do { _Pragma("unroll") for (int _i = 0; _i < 2; ++_i) \
        __builtin_amdgcn_global_load_lds((const unsigned*)((const char*)(gbase) + (voff)[_i]), (LAS unsigned*)(lds + (bufoff) + ldsw + _i * 8192), 16, 0, 0); } while (0)
#define PG8_LDA(dst, b, h) do { _Pragma("unroll") for (int m = 0; m < 4; ++m) _Pragma("unroll") for (int k = 0; k < 2; ++k) dst[m][k] = *(const LAS bf16x8*)(lds + PG8_SA(b, h) + aoff + m * 2048 + k * 1024); } while (0)
#define PG8_LDB(dst, b, h) do { _Pragma("unroll") for (int n = 0; n < 2; ++n) _Pragma("unroll") for (int k = 0; k < 2; ++k) dst[n][k] = *(const LAS bf16x8*)(lds + PG8_SB(b, h) + boff + n * 2048 + k * 1024); } while (0)
#define PG8_MMA(ai, bj, At, Bt) do { __builtin_amdgcn_s_setprio(1); _Pragma("unroll") for (int m = 0; m < 4; ++m) _Pragma("unroll") for (int n = 0; n < 2; ++n) _Pragma("unroll") for (int k = 0; k < 2; ++k) \
        acc[ai][bj][m][n] = __builtin_amdgcn_mfma_f32_16x16x32_bf16(Bt[n][k], At[m][k], acc[ai][bj][m][n], 0, 0, 0); __builtin_amdgcn_s_setprio(0); } while (0)
#define PG8_WAIT_V(n) asm volatile("s_waitcnt vmcnt(" #n ")" ::: "memory")
#define PG8_WAIT_L(n) asm volatile("s_waitcnt lgkmcnt(" #n ")" ::: "memory")
#define PG8_BAR __builtin_amdgcn_s_barrier()
#define PG8_SCHED __builtin_amdgcn_sched_barrier(0)
    Unit cur, nxt; int ui = 0;
    if (!S.next(0, cur)) return;
    f32x4 acc[2][2][4][2];
#pragma unroll
    for (int a = 0; a < 2; ++a)
#pragma unroll
        for (int b = 0; b < 2; ++b)
#pragma unroll
            for (int m = 0; m < 4; ++m)
#pragma unroll
                for (int n = 0; n < 2; ++n) acc[a][b][m][n] = (f32x4){0.f, 0.f, 0.f, 0.f};
    bf16x8 At[4][2], B0[2][2], B1[2][2];
    const char* cA = (const char*)g.A + (size_t)cur.pm * tstep; const char* cB = (const char*)g.Bt + (size_t)cur.pn * tstep;
    PG8_STAGE(PG8_SB(0, 0), cB, voffB); PG8_STAGE(PG8_SA(0, 0), cA, voffA); PG8_STAGE(PG8_SB(0, 1), cB + hstep, voffB); PG8_STAGE(PG8_SA(0, 1), cA + hstep, voffA);
    if (wr == 1) PG8_BAR;
    PG8_WAIT_V(4); PG8_BAR;
    PG8_STAGE(PG8_SB(1, 0), cB + kstep, voffB); PG8_STAGE(PG8_SA(1, 0), cA + kstep, voffA); PG8_STAGE(PG8_SB(1, 1), cB + hstep + kstep, voffB);
    PG8_WAIT_V(6); PG8_BAR;
    for (;;) {
        const bool has_next = S.next(ui + 1, nxt);
        const char* nA = has_next ? (const char*)g.A + (size_t)nxt.pm * tstep : cA; const char* nB = has_next ? (const char*)g.Bt + (size_t)nxt.pn * tstep : cB;
        for (int t = 0; t < nt; t += 2) {
            const bool last = (t == nt - 2);
            const char* a1 = cA + (size_t)(t + 1) * kstep;
            const char* a2 = last ? nA : cA + (size_t)(t + 2) * kstep; const char* b2 = last ? nB : cB + (size_t)(t + 2) * kstep;
            const char* a3 = a2 + kstep; const char* b3 = b2 + kstep;
            PG8_LDB(B0, 0, 0); PG8_SCHED; PG8_LDA(At, 0, 0); PG8_STAGE(PG8_SA(1, 1), a1 + hstep, voffA);
            PG8_WAIT_L(8); PG8_BAR; PG8_WAIT_L(0); PG8_MMA(0, 0, At, B0); PG8_BAR; PG8_SCHED;
            PG8_LDB(B1, 0, 1); PG8_STAGE(PG8_SB(0, 0), b2, voffB);
            PG8_BAR; PG8_WAIT_L(0); PG8_MMA(0, 1, At, B1); PG8_BAR;
            PG8_LDA(At, 0, 1); PG8_STAGE(PG8_SA(0, 0), a2, voffA);
            PG8_BAR; PG8_WAIT_L(0); PG8_MMA(1, 0, At, B0); PG8_BAR; PG8_SCHED;
            PG8_STAGE(PG8_SB(0, 1), b2 + hstep, voffB);
            PG8_WAIT_V(6); PG8_BAR; PG8_MMA(1, 1, At, B1); PG8_BAR;
            PG8_LDB(B0, 1, 0); PG8_SCHED; PG8_LDA(At, 1, 0); PG8_STAGE(PG8_SA(0, 1), a2 + hstep, voffA);
            PG8_WAIT_L(8); PG8_BAR; PG8_WAIT_L(0); PG8_MMA(0, 0, At, B0); PG8_BAR; PG8_SCHED;
            PG8_LDB(B1, 1, 1); PG8_STAGE(PG8_SB(1, 0), b3, voffB);
            PG8_BAR; PG8_WAIT_L(0); PG8_MMA(0, 1, At, B1); PG8_BAR;
            PG8_LDA(At, 1, 1); PG8_STAGE(PG8_SA(1, 0), a3, voffA);
            PG8_BAR; PG8_WAIT_L(0); PG8_MMA(1, 0, At, B0); PG8_BAR; PG8_SCHED;
            PG8_STAGE(PG8_SB(1, 1), b3 + hstep, voffB);
            PG8_WAIT_V(6); PG8_BAR; PG8_MMA(1, 1, At, B1); PG8_BAR;
        }
        E(acc, cur, wr, wc, fr, fq);
        if (!has_next) break;
#pragma unroll
        for (int a = 0; a < 2; ++a)
#pragma unroll
            for (int b = 0; b < 2; ++b)
#pragma unroll
                for (int m = 0; m < 4; ++m)
#pragma unroll
                    for (int n = 0; n < 2; ++n) acc[a][b][m][n] = (f32x4){0.f, 0.f, 0.f, 0.f};
        cur = nxt; cA = nA; cB = nB; ++ui;
    }
    PG8_WAIT_V(0);
    if (wr == 0) PG8_BAR;
    PG8_BAR;
#undef PG8_SA
#undef PG8_SB
#undef PG8_STAGE
#undef PG8_LDA
#undef PG8_LDB
#undef PG8_MMA
#undef PG8_WAIT_V
#undef PG8_WAIT_L
#undef PG8_BAR
#undef PG8_SCHED
}
}

__device__ __forceinline__ void p0_transpose_item(const float* W, int N, bf16_t* WT, int ldk, int k0, int n0, long dst_row0, LAS float* scr, int lane, const float* gk = nullptr) {
#pragma unroll 8
    for (int i = 0; i < 32; ++i) { const int kk = 2 * i + (lane >> 5); scr[kk * 33 + (lane & 31)] = W[(size_t)(k0 + kk) * N + n0 + (lane & 31)] * (gk ? gk[k0 + kk] : 1.0f); }
    asm volatile("s_waitcnt lgkmcnt(0)" ::: "memory");
    const int c = lane & 7;
#pragma unroll
    for (int j = 0; j < 4; ++j) { const int n = (lane >> 3) + 8 * j; const LAS float* s = scr + (8 * c) * 33 + n;
        u32x4 o; o.x = cvt_pk_bf16(s[0 * 33], s[1 * 33]); o.y = cvt_pk_bf16(s[2 * 33], s[3 * 33]); o.z = cvt_pk_bf16(s[4 * 33], s[5 * 33]); o.w = cvt_pk_bf16(s[6 * 33], s[7 * 33]);
        *(u32x4*)(WT + (size_t)(dst_row0 + n) * ldk + k0 + 8 * c) = o; }
    asm volatile("s_waitcnt lgkmcnt(0)" ::: "memory");
}

__device__ __forceinline__ void p0_phase(const Args& a, LAS unsigned char* lds, int tid, int wid, int lane) {
    unsigned char* ws = a.ws;
    LAS float* scr = (LAS float*)(lds + wid * 16384);
    const int gw = blockIdx.x * 8 + wid, NGW = gridDim.x * 8;
    constexpr int I_IN = 32 * 160, I_OUT = 32 * 64, I_G = 32 * 176, I_U = I_G, I_D = 88 * 64, I_PG = 32 * 64, I_PP = 4 * 64, I_RG = 32 * 8;
    constexpr int NITEMS = I_IN + I_OUT + I_G + I_U + I_D + I_PG + I_PP + I_RG;
    for (int it = gw; it < NITEMS; it += NGW) {
        int r = it;
        if (r < I_IN) { const int kb = r / 160, nb = r % 160; p0_transpose_item(a.in[3], DIN, (bf16_t*)(ws + WS_WIN), DM, kb * 64, nb * 32, nb * 32, scr, lane); continue; } r -= I_IN;
        if (r < I_OUT) { const int kb = r / 64, nb = r % 64; p0_transpose_item(a.in[14], DM, (bf16_t*)(ws + WS_WOUT), DM, kb * 64, nb * 32, nb * 32, scr, lane); continue; } r -= I_OUT;
        if (r < I_G) { const int kb = r / 176, nb = r % 176, n0 = nb * 32; p0_transpose_item(a.in[17], DFF, (bf16_t*)(ws + WS_WGU), DM, kb * 64, n0, (n0 >> 7) * 256 + (n0 & 127), scr, lane, a.in[16]); continue; } r -= I_G;
        if (r < I_U) { const int kb = r / 176, nb = r % 176, n0 = nb * 32; p0_transpose_item(a.in[18], DFF, (bf16_t*)(ws + WS_WGU), DM, kb * 64, n0, (n0 >> 7) * 256 + 128 + (n0 & 127), scr, lane, a.in[16]); continue; } r -= I_U;
        if (r < I_D) { const int kb = r / 64, nb = r % 64; p0_transpose_item(a.in[19], DM, (bf16_t*)(ws + WS_WD), DFF, kb * 64, nb * 32, nb * 32, scr, lane); continue; } r -= I_D;
        if (r < I_PG) { const int kb = r / 64, nb = r % 64; p0_transpose_item(a.in[22], DM, (bf16_t*)(ws + WS_WPG), DM, kb * 64, nb * 32, nb * 32, scr, lane, a.in[21]); continue; } r -= I_PG;
        if (r < I_PP) { const int kb = r / 64, nb = r % 64; p0_transpose_item(a.in[23], DM, (bf16_t*)(ws + WS_WPP), DPLE, kb * 64, nb * 32, nb * 32, scr, lane); continue; } r -= I_PP;
        { const int mat = r >> 3, sub = r & 7, kb = sub >> 2, nb = sub & 3; const int zn = mat & 15, z = zn >> 3, n = zn & 7, ty = (mat >> 4) * 2 + z;
          const float* src = (mat < 16 ? a.in[7] : a.in[9]) + (size_t)zn * 16384;
          p0_transpose_item(src, 128, (bf16_t*)(ws + WS_WG), 128, kb * 64, nb * 32, n * 512 + ty * 128 + nb * 32, scr, lane); }
    }
    const float* x = a.in[0]; const float* g = a.in[2]; bf16_t* XN = (bf16_t*)(ws + WS_XN);
    for (int m = gw; m < MTOK; m += NGW) {
        const f32x4* xr = (const f32x4*)(x + (size_t)m * DM);
        f32x4 v[8]; float s = 0.f;
#pragma unroll
        for (int j = 0; j < 8; ++j) { v[j] = xr[j * 64 + lane]; s += (v[j].x * v[j].x + v[j].y * v[j].y) + (v[j].z * v[j].z + v[j].w * v[j].w); }
        const float rs = rsqrtf(wave_sum(s) * (1.f / DM) + EPS);
        u32x2* o = (u32x2*)(XN + (size_t)m * DM);
#pragma unroll
        for (int j = 0; j < 8; ++j) { const f32x4 gv = ((const f32x4*)g)[j * 64 + lane]; u32x2 w; w.x = cvt_pk_bf16(v[j].x * rs * gv.x, v[j].y * rs * gv.y); w.y = cvt_pk_bf16(v[j].z * rs * gv.z, v[j].w * rs * gv.w); o[j * 64 + lane] = w; }
    }
    const f32x4* p4 = (const f32x4*)a.in[1]; u32x2* pb = (u32x2*)(ws + WS_PB);
    for (size_t i = (size_t)blockIdx.x * 512 + tid; i < (size_t)MTOK * DPLE / 4; i += (size_t)gridDim.x * 512) { const f32x4 v = p4[i]; u32x2 w; w.x = cvt_pk_bf16(v.x, v.y); w.y = cvt_pk_bf16(v.z, v.w); pb[i] = w; }
}

__device__ __forceinline__ void attn_phase(const Args& a, LAS unsigned char* lds, int tid, int wid, int lane) {
    const bf16_t* U = (const bf16_t*)(a.ws + WS_U); bf16_t* A2 = (bf16_t*)(a.ws + WS_A2); float* patt = (float*)(a.ws + WS_PATT);
    LAS float* rp = (LAS float*)(lds + 65536);
    for (int i = tid; i < 8 * 15 * 31; i += 512) rp[i] = a.in[4][i];
    __syncthreads();
    const int qb = wid & 3, hh = wid >> 2, l15 = lane & 15, lq = lane >> 4;
    const unsigned vbase = (unsigned)wid * 8192u;
    const unsigned traddr = vbase + (unsigned)((4 * lq + (l15 >> 2)) * 256 + (4 * (lane & 3)) * 2);
    const float LOG2E = 1.4426950408889634f, SC = 0.08838834764831845f * 1.4426950408889634f;
    for (int it = blockIdx.x; it < 512; it += gridDim.x) {
        const int b = it >> 7, r = it & 127;
        const int rstart = min(max(r - 4, 0), 120);
        const int kc0 = min(max(16 * qb - 8, 0), 32);
        const int qcol = 16 * qb + l15, cstart = min(max(qcol - 8, 0), 48);
        const size_t tokq = (size_t)b * SEQ + r * 64 + qcol;
        for (int hi = 0; hi < 4; ++hi) {
            const int h = 2 * hi + hh;
            bf16x8 qf[4]; { const bf16_t* qp = U + tokq * DIN + h * 128 + lq * 32;
#pragma unroll
                for (int ks = 0; ks < 4; ++ks) qf[ks] = *(const bf16x8*)(qp + ks * 8); }
            f32x4 sT[16];
#pragma unroll
            for (int Tg = 0; Tg < 4; ++Tg) {
                bf16x8 kf[4][4];
#pragma unroll
                for (int tt = 0; tt < 4; ++tt) { const int T = Tg * 4 + tt;
                    const bf16_t* kp = U + ((size_t)b * SEQ + (rstart + (T >> 1)) * 64 + kc0 + 16 * (T & 1) + l15) * DIN + 1024 + h * 128 + lq * 32;
#pragma unroll
                    for (int ks = 0; ks < 4; ++ks) kf[tt][ks] = *(const bf16x8*)(kp + ks * 8); }
#pragma unroll
                for (int tt = 0; tt < 4; ++tt) { f32x4 s_ = (f32x4){0.f, 0.f, 0.f, 0.f};
#pragma unroll
                    for (int ks = 0; ks < 4; ++ks) s_ = __builtin_amdgcn_mfma_f32_16x16x32_bf16(kf[tt][ks], qf[ks], s_, 0, 0, 0);
                    sT[Tg * 4 + tt] = s_; }
                __builtin_amdgcn_sched_barrier(0);
            }
            float mx = -1e30f;
#pragma unroll
            for (int T = 0; T < 16; ++T) {
                const int dr = rstart + (T >> 1) - r + 7;
#pragma unroll
                for (int j = 0; j < 4; ++j) {
                    const int kc = kc0 + 16 * (T & 1) + 4 * lq + j; const bool valid = (kc >= cstart) && (kc < cstart + 16);
                    const int dc = min(max(kc - qcol + 15, 0), 30);
                    const float bias = rp[(h * 15 + dr) * 31 + dc];
                    const float t = valid ? (sT[T][j] * SC + bias * LOG2E) : -1e30f;
                    sT[T][j] = t; mx = fmaxf(mx, t);
                }
            }
            mx = fmaxf(mx, __shfl_xor(mx, 16)); mx = fmaxf(mx, __shfl_xor(mx, 32));
            float sum = 0.f;
#pragma unroll
            for (int T = 0; T < 16; ++T)
#pragma unroll
                for (int j = 0; j < 4; ++j) { const float p = __builtin_amdgcn_exp2f(sT[T][j] - mx); sT[T][j] = p; sum += p; }
            sum += __shfl_xor(sum, 16); sum += __shfl_xor(sum, 32);
            union PF { u32x4 u; bf16x8 v; }; PF pf[8];
#pragma unroll
            for (int kr = 0; kr < 8; ++kr) {
                pf[kr].u.x = cvt_pk_bf16(sT[2 * kr][0], sT[2 * kr][1]); pf[kr].u.y = cvt_pk_bf16(sT[2 * kr][2], sT[2 * kr][3]);
                pf[kr].u.z = cvt_pk_bf16(sT[2 * kr + 1][0], sT[2 * kr + 1][1]); pf[kr].u.w = cvt_pk_bf16(sT[2 * kr + 1][2], sT[2 * kr + 1][3]); }
            f32x4 oT[8];
#pragma unroll
            for (int dt = 0; dt < 8; ++dt) oT[dt] = (f32x4){0.f, 0.f, 0.f, 0.f};
            u32x4 vst[8];
            { const bf16_t* vp = U + ((size_t)b * SEQ + rstart * 64 + kc0) * DIN + 2048 + h * 128;
#pragma unroll
              for (int jj = 0; jj < 8; ++jj) { const int c = jj * 64 + lane; vst[jj] = *(const u32x4*)(vp + (size_t)(c >> 4) * DIN + (c & 15) * 8); } }
#pragma unroll
            for (int kr = 0; kr < 8; ++kr) {
#pragma unroll
                for (int jj = 0; jj < 8; ++jj) { const int c = jj * 64 + lane; *(LAS u32x4*)(lds + vbase + (c >> 4) * 256 + (c & 15) * 16) = vst[jj]; }
                if (kr < 7) { const bf16_t* vp = U + ((size_t)b * SEQ + (rstart + kr + 1) * 64 + kc0) * DIN + 2048 + h * 128;
#pragma unroll
                    for (int jj = 0; jj < 8; ++jj) { const int c = jj * 64 + lane; vst[jj] = *(const u32x4*)(vp + (size_t)(c >> 4) * DIN + (c & 15) * 8); } }
                s16x4 t0, t1, t2, t3, t4, t5, t6, t7, t8, t9, t10, t11, t12, t13, t14, t15;
                asm volatile("s_waitcnt lgkmcnt(0)\n\t"
                             "ds_read_b64_tr_b16 %0, %16 offset:0\n\t"   "ds_read_b64_tr_b16 %1, %16 offset:4096\n\t"
                             "ds_read_b64_tr_b16 %2, %16 offset:32\n\t"  "ds_read_b64_tr_b16 %3, %16 offset:4128\n\t"
                             "ds_read_b64_tr_b16 %4, %16 offset:64\n\t"  "ds_read_b64_tr_b16 %5, %16 offset:4160\n\t"
                             "ds_read_b64_tr_b16 %6, %16 offset:96\n\t"  "ds_read_b64_tr_b16 %7, %16 offset:4192\n\t"
                             "ds_read_b64_tr_b16 %8, %16 offset:128\n\t" "ds_read_b64_tr_b16 %9, %16 offset:4224\n\t"
                             "ds_read_b64_tr_b16 %10, %16 offset:160\n\t" "ds_read_b64_tr_b16 %11, %16 offset:4256\n\t"
                             "ds_read_b64_tr_b16 %12, %16 offset:192\n\t" "ds_read_b64_tr_b16 %13, %16 offset:4288\n\t"
                             "ds_read_b64_tr_b16 %14, %16 offset:224\n\t" "ds_read_b64_tr_b16 %15, %16 offset:4320\n\t"
                             "s_waitcnt lgkmcnt(0)"
                             : "=&v"(t0), "=&v"(t1), "=&v"(t2), "=&v"(t3), "=&v"(t4), "=&v"(t5), "=&v"(t6), "=&v"(t7),
                               "=&v"(t8), "=&v"(t9), "=&v"(t10), "=&v"(t11), "=&v"(t12), "=&v"(t13), "=&v"(t14), "=&v"(t15)
                             : "v"(traddr) : "memory");
#define PV_MMA(dt, lo, hi) { bf16x8 vf; vf[0] = lo[0]; vf[1] = lo[1]; vf[2] = lo[2]; vf[3] = lo[3]; vf[4] = hi[0]; vf[5] = hi[1]; vf[6] = hi[2]; vf[7] = hi[3]; \
                    oT[dt] = __builtin_amdgcn_mfma_f32_16x16x32_bf16(vf, pf[kr].v, oT[dt], 0, 0, 0); }
                PV_MMA(0, t0, t1) PV_MMA(1, t2, t3) PV_MMA(2, t4, t5) PV_MMA(3, t6, t7) PV_MMA(4, t8, t9) PV_MMA(5, t10, t11) PV_MMA(6, t12, t13) PV_MMA(7, t14, t15)
#undef PV_MMA
            }
            const float inv = 1.0f / sum; float ss = 0.f;
            bf16_t* op = A2 + tokq * DM + h * 128 + 4 * lq;
#pragma unroll
            for (int dt = 0; dt < 8; ++dt) { const f32x4 o = oT[dt] * inv; ss += (o[0] * o[0] + o[1] * o[1]) + (o[2] * o[2] + o[3] * o[3]);
                u32x2 w; w.x = cvt_pk_bf16(o[0], o[1]); w.y = cvt_pk_bf16(o[2], o[3]); *(u32x2*)(op + 16 * dt) = w; }
            ss += __shfl_xor(ss, 16); ss += __shfl_xor(ss, 32);
            if (lq == 0) patt[tokq * 8 + h] = ss;
        }
    }
    __syncthreads();
}

__device__ __forceinline__ void attn_phase_naive(const Args& a, int wid, int lane) {
    const bf16_t* U = (const bf16_t*)(a.ws + WS_U); bf16_t* A2 = (bf16_t*)(a.ws + WS_A2); float* patt = (float*)(a.ws + WS_PATT);
    const float* rpb = a.in[4];
    const int gw = blockIdx.x * 8 + wid, NGW = gridDim.x * 8;
    for (int wi = gw; wi < MTOK * 8; wi += NGW) {
        const int h = wi & 7, tok = wi >> 3, b = tok >> 13, s = tok & 8191, r = s >> 6, qcol = s & 63;
        const int rstart = min(max(r - 4, 0), 120), cstart = min(max(qcol - 8, 0), 48);
        const unsigned qw = *(const unsigned*)(U + (size_t)tok * DIN + h * 128 + 2 * lane);
        const float q0 = bf_lo(qw) * 0.08838834764831845f, q1 = bf_hi(qw) * 0.08838834764831845f;
        float mx = -1e30f, l = 0.f, o0 = 0.f, o1 = 0.f;
        for (int kr = 0; kr < 8; ++kr)
            for (int kc = 0; kc < 16; ++kc) {
                const size_t kt = (size_t)b * SEQ + (rstart + kr) * 64 + cstart + kc;
                const unsigned kw = *(const unsigned*)(U + kt * DIN + 1024 + h * 128 + 2 * lane);
                const unsigned vw = *(const unsigned*)(U + kt * DIN + 2048 + h * 128 + 2 * lane);
                float d = wave_sum(q0 * bf_lo(kw) + q1 * bf_hi(kw));
                d += rpb[(h * 15 + (rstart + kr - r + 7)) * 31 + (cstart + kc - qcol + 15)];
                const float nm = fmaxf(mx, d), sc = __expf(mx - nm), p = __expf(d - nm);
                l = l * sc + p; o0 = o0 * sc + p * bf_lo(vw); o1 = o1 * sc + p * bf_hi(vw); mx = nm;
            }
        o0 /= l; o1 /= l;
        *(unsigned*)(A2 + (size_t)tok * DM + h * 128 + 2 * lane) = cvt_pk_bf16(o0, o1);
        const float ss = wave_sum(o0 * o0 + o1 * o1);
        if (lane == 0) patt[(size_t)tok * 8 + h] = ss;
    }
}

template <bool FINAL>
__device__ __forceinline__ void rglru_phase(const Args& a, LAS unsigned char* lds, int tid, int wid, int lane) {
    const bf16_t* U = (const bf16_t*)(a.ws + WS_U); bf16_t* A2 = (bf16_t*)(a.ws + WS_A2); float* prec = (float*)(a.ws + WS_PREC);
    float* sumr = (float*)(a.ws + WS_SUM); const bf16_t* WG = (const bf16_t*)(a.ws + WS_WG);
    const float* conv_w = a.in[5]; const float* conv_b = a.in[6]; const float* b_a = a.in[8]; const float* b_i = a.in[10]; const float* lam = a.in[11];
    constexpr int XC_OFF = 0, YG_OFF = 34816, REC_OFF = 69632, RS = 272;
    const int cgp0 = tid & 15, tq0 = tid >> 4, l150 = lane & 15, lq0 = lane >> 4;
    for (int it = blockIdx.x; it < 2048; it += gridDim.x) {
        int cgp = cgp0, tq = tq0, l15 = l150, lq = lq0;
        asm volatile("" : "+v"(cgp), "+v"(tq), "+v"(l15), "+v"(lq));
        const int n = it & 7, c = (it >> 3) & 63, b = it >> 9, t0 = c * 128;
        {
            const int chb = n * 128 + cgp * 8;
            float xin[7][8];
#pragma unroll
            for (int rr = 0; rr < 7; ++rr) { const int ts = t0 + 4 * tq - 2 + rr;
                u32x4 v = (u32x4){0u, 0u, 0u, 0u};
                if (ts >= 0 && ts < SEQ) v = *(const u32x4*)(U + ((size_t)b * SEQ + ts) * DIN + 3072 + chb);
                xin[rr][0] = bf_lo(v.x); xin[rr][1] = bf_hi(v.x); xin[rr][2] = bf_lo(v.y); xin[rr][3] = bf_hi(v.y); xin[rr][4] = bf_lo(v.z); xin[rr][5] = bf_hi(v.z); xin[rr][6] = bf_lo(v.w); xin[rr][7] = bf_hi(v.w); }
            float cw[4][8], cb[8];
#pragma unroll
            for (int j = 0; j < 4; ++j) { const f32x4 w0 = *(const f32x4*)(conv_w + j * DREC + chb), w1 = *(const f32x4*)(conv_w + j * DREC + chb + 4);
                cw[j][0] = w0.x; cw[j][1] = w0.y; cw[j][2] = w0.z; cw[j][3] = w0.w; cw[j][4] = w1.x; cw[j][5] = w1.y; cw[j][6] = w1.z; cw[j][7] = w1.w; }
            { const f32x4 w0 = *(const f32x4*)(conv_b + chb), w1 = *(const f32x4*)(conv_b + chb + 4); cb[0] = w0.x; cb[1] = w0.y; cb[2] = w0.z; cb[3] = w0.w; cb[4] = w1.x; cb[5] = w1.y; cb[6] = w1.z; cb[7] = w1.w; }
#pragma unroll
            for (int i = 0; i < 4; ++i) { float o[8];
#pragma unroll
                for (int e = 0; e < 8; ++e) o[e] = cb[e] + cw[0][e] * xin[i][e] + cw[1][e] * xin[i + 1][e] + cw[2][e] * xin[i + 2][e] + cw[3][e] * xin[i + 3][e];
                u32x4 w; w.x = cvt_pk_bf16(o[0], o[1]); w.y = cvt_pk_bf16(o[2], o[3]); w.z = cvt_pk_bf16(o[4], o[5]); w.w = cvt_pk_bf16(o[6], o[7]);
                *(LAS u32x4*)(lds + XC_OFF + (4 * tq + i) * RS + cgp * 16) = w; }
            if (FINAL) {
#pragma unroll
                for (int i = 0; i < 4; ++i) { const u32x4 v = *(const u32x4*)(U + ((size_t)b * SEQ + t0 + 4 * tq + i) * DIN + 4096 + chb); *(LAS u32x4*)(lds + YG_OFF + (4 * tq + i) * RS + cgp * 16) = v; }
            }
        }
        __syncthreads();
        const int chl = 16 * wid + l15, gch = n * 128 + chl;
        float cend[2], ptot[2];
        f32x4 hs[8];
#pragma unroll
        for (int dir = 0; dir < 2; ++dir) {
            f32x4 acc[2][8];
#pragma unroll
            for (int ty = 0; ty < 2; ++ty)
#pragma unroll
                for (int mt = 0; mt < 8; ++mt) acc[ty][mt] = (f32x4){0.f, 0.f, 0.f, 0.f};
#pragma unroll
            for (int ks = 0; ks < 4; ++ks) {
                bf16x8 af[8];
#pragma unroll
                for (int mt = 0; mt < 8; ++mt) af[mt] = *(const LAS bf16x8*)(lds + XC_OFF + (16 * mt + l15) * RS + (ks * 32 + lq * 8) * 2);
#pragma unroll
                for (int ty = 0; ty < 2; ++ty) { const bf16x8 wf = *(const bf16x8*)(WG + (size_t)(n * 512 + (ty * 2 + dir) * 128 + chl) * 128 + ks * 32 + lq * 8);
#pragma unroll
                    for (int mt = 0; mt < 8; ++mt) acc[ty][mt] = __builtin_amdgcn_mfma_f32_16x16x32_bf16(af[mt], wf, acc[ty][mt], 0, 0, 0); }
            }
            __builtin_amdgcn_sched_barrier(0);
            const float ba = b_a[dir * DREC + gch], bi = b_i[dir * DREC + gch];
            const float kf = 8.0f * log1pf(expf(-lam[dir * DREC + gch]));
#pragma unroll
            for (int mt = 0; mt < 8; ++mt) {
#pragma unroll
                for (int r = 0; r < 4; ++r) {
                    const int tt = 16 * mt + 4 * lq + r;
                    const float xcv = bf1(*(const LAS unsigned short*)(lds + XC_OFF + tt * RS + chl * 2));
                    const float rg = fast_sigmoid(acc[0][mt][r] + ba), ig = fast_sigmoid(acc[1][mt][r] + bi), av = __expf(-kf * rg);
                    acc[0][mt][r] = av; acc[1][mt][r] = sqrtf(fmaxf(1.0f - av * av, 0.f)) * ig * xcv;
                }
                __builtin_amdgcn_sched_barrier(0);
            }
            __builtin_amdgcn_sched_barrier(0);
            float cr = 0.f;
            if (FINAL) {
                float P = 1.f, H = 0.f;
                if (dir == 0) { const int lo = lq * 16, hi = min(lo + 16, c);
                    for (int cc = lo; cc < hi; ++cc) { const float* sp = sumr + ((size_t)((b * 64 + cc) * 2 + 0) * 2) * 1024 + gch; const float A = sp[0], Hc = sp[1024]; H = A * H + Hc; P *= A; }
#pragma unroll
                    for (int g = 0; g < 4; ++g) { const float Pg = __shfl(P, g * 16 + l15), Hg = __shfl(H, g * 16 + l15); cr = Pg * cr + Hg; } }
                else { const int lo = max(lq * 16, c + 1), hi = lq * 16 + 16;
                    for (int cc = hi - 1; cc >= lo; --cc) { const float* sp = sumr + ((size_t)((b * 64 + cc) * 2 + 1) * 2) * 1024 + gch; const float A = sp[0], Hc = sp[1024]; H = A * H + Hc; P *= A; }
#pragma unroll
                    for (int g = 3; g >= 0; --g) { const float Pg = __shfl(P, g * 16 + l15), Hg = __shfl(H, g * 16 + l15); cr = Pg * cr + Hg; } }
            }
            __builtin_amdgcn_sched_barrier(0);
            float pt = 1.f;
            if (dir == 0) {
#pragma unroll
                for (int mt = 0; mt < 8; ++mt) {
                    float H = 0.f, P = 1.f, hl[4], pl[4];
#pragma unroll
                    for (int r = 0; r < 4; ++r) { H = acc[0][mt][r] * H + acc[1][mt][r]; P *= acc[0][mt][r]; hl[r] = H; pl[r] = P; }
                    const float P0 = __shfl(P, l15), H0 = __shfl(H, l15), P1 = __shfl(P, 16 + l15), H1 = __shfl(H, 16 + l15), P2 = __shfl(P, 32 + l15), H2 = __shfl(H, 32 + l15), P3 = __shfl(P, 48 + l15), H3 = __shfl(H, 48 + l15);
                    const float c0 = cr, c1 = P0 * c0 + H0, c2 = P1 * c1 + H1, c3 = P2 * c2 + H2, c4 = P3 * c3 + H3;
                    if (FINAL) { const float mine = lq == 0 ? c0 : (lq == 1 ? c1 : (lq == 2 ? c2 : c3));
#pragma unroll
                        for (int r = 0; r < 4; ++r) hs[mt][r] = hl[r] + pl[r] * mine; }
                    else pt *= (P0 * P1) * (P2 * P3);
                    cr = c4;
                }
            } else {
#pragma unroll
                for (int mt = 7; mt >= 0; --mt) {
                    float H = 0.f, P = 1.f, hl[4], pl[4];
#pragma unroll
                    for (int r = 3; r >= 0; --r) { H = acc[0][mt][r] * H + acc[1][mt][r]; P *= acc[0][mt][r]; hl[r] = H; pl[r] = P; }
                    const float P0 = __shfl(P, l15), H0 = __shfl(H, l15), P1 = __shfl(P, 16 + l15), H1 = __shfl(H, 16 + l15), P2 = __shfl(P, 32 + l15), H2 = __shfl(H, 32 + l15), P3 = __shfl(P, 48 + l15), H3 = __shfl(H, 48 + l15);
                    const float c3 = cr, c2 = P3 * c3 + H3, c1 = P2 * c2 + H2, c0 = P1 * c1 + H1, cn = P0 * c0 + H0;
                    if (FINAL) { const float mine = lq == 0 ? c0 : (lq == 1 ? c1 : (lq == 2 ? c2 : c3));
#pragma unroll
                        for (int r = 0; r < 4; ++r) hs[mt][r] += hl[r] + pl[r] * mine; }
                    else pt *= (P0 * P1) * (P2 * P3);
                    cr = cn;
                }
            }
            cend[dir] = cr; ptot[dir] = pt;
            __builtin_amdgcn_sched_barrier(0);
        }
        if (!FINAL) {
            if (lq == 0) { float* sp = sumr + ((size_t)((b * 64 + c) * 2 + 0) * 2) * 1024 + gch; sp[0] = ptot[0]; sp[1024] = cend[0]; sp[2048] = ptot[1]; sp[3072] = cend[1]; }
            __syncthreads();
        } else {
#pragma unroll
            for (int mt = 0; mt < 8; ++mt) {
#pragma unroll
                for (int r = 0; r < 4; ++r) { const int tt = 16 * mt + 4 * lq + r;
                    const float y = bf1(*(const LAS unsigned short*)(lds + YG_OFF + tt * RS + chl * 2));
                    const float z = 0.7978845608028654f * (y + 0.044715f * y * y * y);
                    const float gl = y * fast_sigmoid(2.0f * z);
                    const float v = hs[mt][r] * gl;
                    *(LAS unsigned short*)(lds + REC_OFF + tt * RS + chl * 2) = (unsigned short)(cvt_pk_bf16(v, 0.f) & 0xffffu); }
                __builtin_amdgcn_sched_barrier(0);
            }
            __syncthreads();
            { const int tok = tid >> 2, qtr = tid & 3; float ss = 0.f;
              bf16_t* dst = A2 + ((size_t)b * SEQ + t0 + tok) * DM + DATT + n * 128 + qtr * 32;
#pragma unroll
              for (int j = 0; j < 4; ++j) { const u32x4 v = *(const LAS u32x4*)(lds + REC_OFF + tok * RS + qtr * 64 + j * 16);
                  const float e0 = bf_lo(v.x), e1 = bf_hi(v.x), e2 = bf_lo(v.y), e3 = bf_hi(v.y), e4 = bf_lo(v.z), e5 = bf_hi(v.z), e6 = bf_lo(v.w), e7 = bf_hi(v.w);
                  ss += (e0 * e0 + e1 * e1) + (e2 * e2 + e3 * e3) + (e4 * e4 + e5 * e5) + (e6 * e6 + e7 * e7);
                  *(u32x4*)(dst + j * 8) = v; }
              ss += __shfl_xor(ss, 1); ss += __shfl_xor(ss, 2);
              if (qtr == 0) prec[((size_t)b * SEQ + t0 + tok) * 8 + n] = ss; }
            __syncthreads();
        }
    }
}

__device__ __forceinline__ void fixup_phase(const Args& a, int wid, int lane) {
    bf16_t* A2 = (bf16_t*)(a.ws + WS_A2); const float* patt = (const float*)(a.ws + WS_PATT); const float* prec = (const float*)(a.ws + WS_PREC);
    const float* ga = a.in[12]; const float* gr = a.in[13];
    const int gw = blockIdx.x * 8 + wid, NGW = gridDim.x * 8;
    for (int m = gw; m < MTOK; m += NGW) {
        float pv = (lane < 8) ? patt[(size_t)m * 8 + lane] : ((lane < 16) ? prec[(size_t)m * 8 + lane - 8] : 0.f);
        pv += __shfl_xor(pv, 1); pv += __shfl_xor(pv, 2); pv += __shfl_xor(pv, 4);
        const float ssa = __shfl(pv, 0), ssr = __shfl(pv, 8);
        const float rsa = rsqrtf(ssa * (1.f / DATT) + EPS), rsr = rsqrtf(ssr * (1.f / DREC) + EPS);
        u32x4* row = (u32x4*)(A2 + (size_t)m * DM);
#pragma unroll
        for (int j = 0; j < 4; ++j) { const int ci = j * 64 + lane; const u32x4 v = row[ci];
            const float rs = (j < 2) ? rsa : rsr; const float* gp = (j < 2) ? (ga + ci * 8) : (gr + (ci - 128) * 8);
            const f32x4 g0 = *(const f32x4*)gp, g1 = *(const f32x4*)(gp + 4);
            u32x4 w; w.x = cvt_pk_bf16(bf_lo(v.x) * rs * g0.x, bf_hi(v.x) * rs * g0.y); w.y = cvt_pk_bf16(bf_lo(v.y) * rs * g0.z, bf_hi(v.y) * rs * g0.w);
            w.z = cvt_pk_bf16(bf_lo(v.z) * rs * g1.x, bf_hi(v.z) * rs * g1.y); w.w = cvt_pk_bf16(bf_lo(v.w) * rs * g1.z, bf_hi(v.w) * rs * g1.w);
            row[ci] = w; }
    }
}

template <int MODE>
__device__ __forceinline__ void epass_phase(const Args& a, const float* g_post, float* rsq, int wid, int lane) {
    const bf16_t* Y = (const bf16_t*)(a.ws + WS_Y); const float* part = (const float*)(a.ws + WS_PART); bf16_t* HB = (bf16_t*)(a.ws + WS_XN); float* out = a.out; const float* x = a.in[0];
    const int gw = blockIdx.x * 8 + wid, NGW = gridDim.x * 8;
    for (int m = gw; m < MTOK; m += NGW) {
        float pv = part[(size_t)m * 32 + (lane & 31)];
#pragma unroll
        for (int o = 1; o < 32; o <<= 1) pv += __shfl_xor(pv, o);
        const float rs = rsqrtf(pv * (1.f / DM) + EPS);
        const u32x2* yr = (const u32x2*)(Y + (size_t)m * DM); u32x2* hb = (u32x2*)(HB + (size_t)m * DM);
        f32x4 h[8]; float s2 = 0.f;
#pragma unroll
        for (int j = 0; j < 8; ++j) { f32x4 hv;
            if (MODE == 0) hv = ((const f32x4*)(x + (size_t)m * DM))[j * 64 + lane];
            else { const u32x2 hw = hb[j * 64 + lane]; hv.x = bf_lo(hw.x); hv.y = bf_hi(hw.x); hv.z = bf_lo(hw.y); hv.w = bf_hi(hw.y); }
            const u32x2 yv = yr[j * 64 + lane]; const f32x4 g = ((const f32x4*)g_post)[j * 64 + lane];
            f32x4 o; o.x = hv.x + bf_lo(yv.x) * rs * g.x; o.y = hv.y + bf_hi(yv.x) * rs * g.y; o.z = hv.z + bf_lo(yv.y) * rs * g.z; o.w = hv.w + bf_hi(yv.y) * rs * g.w;
            h[j] = o; s2 += (o.x * o.x + o.y * o.y) + (o.z * o.z + o.w * o.w); }
        if (MODE == 2) { f32x4* orow = (f32x4*)(out + (size_t)m * DM);
#pragma unroll
            for (int j = 0; j < 8; ++j) orow[j * 64 + lane] = h[j]; }
        else {
#pragma unroll
            for (int j = 0; j < 8; ++j) { u32x2 w; w.x = cvt_pk_bf16(h[j].x, h[j].y); w.y = cvt_pk_bf16(h[j].z, h[j].w); hb[j * 64 + lane] = w; }
            const float rs2 = rsqrtf(wave_sum(s2) * (1.f / DM) + EPS);
            if (lane == 0) rsq[m] = rs2; }
    }
}

__global__ void __launch_bounds__(512) fwd_kernel(Args a) {
    extern __shared__ __attribute__((aligned(16))) unsigned char lds_raw[];
    LAS unsigned char* lds = (LAS unsigned char*)lds_raw;
    const int tid = threadIdx.x, wid = __builtin_amdgcn_readfirstlane(tid >> 6), lane = tid & 63;
    unsigned char* ws = a.ws;
    const int lo = a.ph_lo, hi = a.ph_hi;
#define IN(k) (lo <= (k) && (k) < hi && PH_ON(k))
#define SEAM(k) do { if (lo <= (k) && (k) + 1 < hi) cg::this_grid().sync(); } while (0)
#define PHASE(k, ...) do { if (IN(k)) { __VA_ARGS__ } if (NREP(k) > 1) { if (IN(k)) { __VA_ARGS__ } } } while (0)
    PHASE(0, p0_phase(a, lds, tid, wid, lane););
    SEAM(0);
    PHASE(1,
        for (int gi = 0; gi < 2; ++gi) {
            pg8::Gemm g{(const bf16_t*)(ws + (gi ? WS_PB : WS_XN)), (const bf16_t*)(ws + (gi ? WS_WPP : WS_WIN)), MTOK, gi ? DM : DIN, gi ? DPLE : DM}; pg8::StaticOrder S; S.init(MTOK, gi ? DM : DIN, gridDim.x, blockIdx.x);
            pg8::EpiStore E{(bf16_t*)(ws + (gi ? WS_PLE : WS_U)), gi ? DM : DIN}; pg8::gemm_phase(lds, g, S, E); }
    );
    SEAM(1);
    PHASE(2,
        if (NAIVE_ATTN) attn_phase_naive(a, wid, lane); else attn_phase(a, lds, tid, wid, lane);
        rglru_phase<false>(a, lds, tid, wid, lane);
    );
    SEAM(2);
    PHASE(3, rglru_phase<true>(a, lds, tid, wid, lane););
    SEAM(3);
    PHASE(4, fixup_phase(a, wid, lane););
    SEAM(4);
    PHASE(5, pg8::Gemm g{(const bf16_t*)(ws + WS_A2), (const bf16_t*)(ws + WS_WOUT), MTOK, DM, DM}; pg8::StaticOrder S; S.init(MTOK, DM, gridDim.x, blockIdx.x);
        pg8::EpiStoreSS E{(bf16_t*)(ws + WS_Y), DM, (float*)(ws + WS_PART)}; pg8::gemm_phase(lds, g, S, E););
    SEAM(5);
    PHASE(6, epass_phase<0>(a, a.in[15], (float*)(ws + WS_RSQ), wid, lane););
    SEAM(6);
    PHASE(7, pg8::Gemm g{(const bf16_t*)(ws + WS_XN), (const bf16_t*)(ws + WS_WGU), MTOK, 2 * DFF, DM}; pg8::StaticOrder S; S.init(MTOK, 2 * DFF, gridDim.x, blockIdx.x);
        pg8::EpiSwiglu E{(bf16_t*)(ws + WS_ACT), DFF, (const float*)(ws + WS_RSQ)}; pg8::gemm_phase(lds, g, S, E););
    SEAM(7);
    PHASE(8, pg8::Gemm g{(const bf16_t*)(ws + WS_ACT), (const bf16_t*)(ws + WS_WD), MTOK, DM, DFF}; pg8::StaticOrder S; S.init(MTOK, DM, gridDim.x, blockIdx.x);
        pg8::EpiStoreSS E{(bf16_t*)(ws + WS_Y), DM, (float*)(ws + WS_PART)}; pg8::gemm_phase(lds, g, S, E););
    SEAM(8);
    PHASE(9, epass_phase<1>(a, a.in[20], (float*)(ws + WS_RSQ) + MTOK, wid, lane););
    SEAM(9);
    PHASE(10, pg8::Gemm g{(const bf16_t*)(ws + WS_XN), (const bf16_t*)(ws + WS_WPG), MTOK, DM, DM}; pg8::StaticOrder S; S.init(MTOK, DM, gridDim.x, blockIdx.x);
        pg8::EpiPleGate E{(bf16_t*)(ws + WS_Y), DM, (const bf16_t*)(ws + WS_PLE), (float*)(ws + WS_PART), (const float*)(ws + WS_RSQ) + MTOK}; pg8::gemm_phase(lds, g, S, E););
    SEAM(10);
    PHASE(11, epass_phase<2>(a, a.in[24], nullptr, wid, lane););
#undef IN
#undef SEAM
#undef PHASE
}

extern "C" void kernel_launch(void* const* d_in, const int* in_sizes, int n_in, void* d_out, int out_size, void* d_ws, size_t ws_size, hipStream_t stream) {
    static int grid = 0;
    if (grid == 0) {
        int dev = 0, cus = 0;
        if (hipGetDevice(&dev) != hipSuccess || hipDeviceGetAttribute(&cus, hipDeviceAttributeMultiprocessorCount, dev) != hipSuccess) { fprintf(stderr, "device query failed\n"); grid = -1; return; }
        if (hipFuncSetAttribute((const void*)fwd_kernel, hipFuncAttributeMaxDynamicSharedMemorySize, LDS_BYTES) != hipSuccess) { fprintf(stderr, "hipFuncSetAttribute failed\n"); grid = -1; return; }
        int per_cu = 0;
        if (hipOccupancyMaxActiveBlocksPerMultiprocessor(&per_cu, (const void*)fwd_kernel, 512, LDS_BYTES) != hipSuccess || per_cu < 1) { fprintf(stderr, "occupancy query: %d\n", per_cu); per_cu = 1; }
        (void)hipGetLastError();
        grid = cus;
        if (ws_size < 968 * MiB) fprintf(stderr, "workspace too small: %zu\n", ws_size);
    }
    if (grid < 0) return;
    Args a{};
    for (int i = 0; i < 25; ++i) a.in[i] = (const float*)d_in[i];
    a.out = (float*)d_out; a.ws = (unsigned char*)d_ws;
#if MK_ONE_LAUNCH
    a.ph_lo = 0; a.ph_hi = NPH;
    void* args[] = {&a};
    hipError_t e = hipLaunchCooperativeKernel((const void*)fwd_kernel, dim3(grid), dim3(512), args, LDS_BYTES, stream);
    if (e != hipSuccess) fprintf(stderr, "cooperative launch failed: %s (grid %d)\n", hipGetErrorString(e), grid);
#else
    for (int ph = 0; ph < NPH; ++ph) { a.ph_lo = ph; a.ph_hi = ph + 1; hipLaunchKernelGGL(fwd_kernel, dim3(grid), dim3(512), LDS_BYTES, stream, a); }
#endif
}
```

```cpp
#include <hip/hip_runtime.h>
#include <hip/hip_cooperative_groups.h>
#include <cstdio>
namespace cg = cooperative_groups;

#ifndef MK_ONE_LAUNCH
#define MK_ONE_LAUNCH 1
#endif
#ifndef PH_MASK
#define PH_MASK 0xFFF
#endif
#define PH_ON(k) ((PH_MASK >> (k)) & 1)
#ifndef DUP_MASK
#define DUP_MASK 0x0
#endif
#define NREP(k) (1 + ((DUP_MASK >> (k)) & 1))
#ifndef NAIVE_ATTN
#define NAIVE_ATTN 0
#endif

#define LAS __attribute__((address_space(3)))
typedef unsigned short bf16_t;
typedef short bf16x8 __attribute__((ext_vector_type(8)));
typedef short s16x4 __attribute__((ext_vector_type(4)));
typedef float f32x4 __attribute__((ext_vector_type(4)));
typedef float f32x2 __attribute__((ext_vector_type(2)));
typedef unsigned u32x4 __attribute__((ext_vector_type(4)));
typedef unsigned u32x2 __attribute__((ext_vector_type(2)));

constexpr int MTOK = 32768, DM = 2048, DIN = 5120, DATT = 1024, DREC = 1024, DFF = 5632, DPLE = 256, SEQ = 8192;
constexpr float EPS = 1e-6f;
constexpr int NPH = 12;
constexpr int LDS_BYTES = 147456;

constexpr size_t MiB = 1u << 20;
constexpr size_t WS_U = 0;
constexpr size_t WS_A2 = 320 * MiB;
constexpr size_t WS_ACT = 0;
constexpr size_t WS_XN = 448 * MiB;
constexpr size_t WS_Y = 576 * MiB;
constexpr size_t WS_PLE = 704 * MiB;
constexpr size_t WS_PB = 832 * MiB;
constexpr size_t WS_WIN = 848 * MiB;
constexpr size_t WS_WOUT = 868 * MiB;
constexpr size_t WS_WGU = 876 * MiB;
constexpr size_t WS_WD = 920 * MiB;
constexpr size_t WS_WPG = 942 * MiB;
constexpr size_t WS_WPP = 950 * MiB;
constexpr size_t WS_WG = 951 * MiB;
constexpr size_t WS_PART = 952 * MiB;
constexpr size_t WS_PATT = 956 * MiB;
constexpr size_t WS_PREC = 957 * MiB;
constexpr size_t WS_SUM = 958 * MiB;
constexpr size_t WS_RSQ = 966 * MiB;

struct Args {
    const float* in[25];
    float* out;
    unsigned char* ws;
    int ph_lo, ph_hi;
};

__device__ __forceinline__ unsigned cvt_pk_bf16(float lo, float hi) { unsigned r; asm volatile("v_cvt_pk_bf16_f32 %0, %1, %2" : "=v"(r) : "v"(lo), "v"(hi)); return r; }
__device__ __forceinline__ float bf_lo(unsigned w) { return __uint_as_float(w << 16); }
__device__ __forceinline__ float bf_hi(unsigned w) { return __uint_as_float(w & 0xffff0000u); }
__device__ __forceinline__ float bf1(unsigned short h) { return __uint_as_float(((unsigned)h) << 16); }
__device__ __forceinline__ float wave_sum(float v) {
#pragma unroll
    for (int o = 1; o < 64; o <<= 1) v += __shfl_xor(v, o);
    return v;
}
__device__ __forceinline__ float fast_sigmoid(float x) { return __builtin_amdgcn_rcpf(1.0f + __expf(-x)); }

namespace pg8 {
constexpr int BM = 256, BK = 64, HALF = 128, HTB = HALF * BK * 2, STAGE_BYTES = 8 * HTB, NXCD = 8, WGM = 8;
__host__ __device__ __forceinline__ int lds_byte(int r, int c) { const int st = (r >> 4) * 2 + (c >> 5), rr = r & 15, cc = c & 31, ob = rr * 64 + cc * 2; return st * 1024 + (ob ^ (((ob >> 9) & 1) << 5)); }
__host__ __device__ __forceinline__ void stage_rc(int b, int& R, int& C) { const int st = b / 1024, sb = b % 1024, swz = sb ^ (((sb >> 9) & 1) << 5); R = (st >> 1) * 16 + swz / 64; C = (st & 1) * 32 + (swz % 64) / 2; }
__host__ __device__ __forceinline__ int perm32(int rho) { const int n = rho >> 4, i = rho & 15; return 8 * (i >> 2) + 4 * n + (i & 3); }
struct Unit { int pm, pn; };
struct Gemm { const bf16_t* A; const bf16_t* Bt; int M, N, K; };
struct StaticOrder {
    int nM, nN, nwg, G, c;
    __device__ void init(int M, int N, int G_, int c_) { nM = M / BM; nN = N / BM; nwg = nM * nN; G = G_; c = c_; }
    __device__ bool next(int i, Unit& u) const {
        const long L = (long)i * G + c; if (L >= nwg) return false;
        int wgid = (int)L; { const int q = nwg / NXCD, r = nwg % NXCD, xcd = wgid % NXCD, off = wgid / NXCD; wgid = (xcd < r ? xcd * (q + 1) : r * (q + 1) + (xcd - r) * q) + off; }
        const int nig = WGM * nN, gid = wgid / nig, fm = gid * WGM, gsz = (nM - fm) < WGM ? (nM - fm) : WGM;
        u.pm = fm + ((wgid % nig) % gsz); u.pn = (wgid % nig) / gsz; return true;
    }
};

struct EpiStore {
    static constexpr bool PERM = true;
    bf16_t* O; int ldc;
    __device__ __forceinline__ void operator()(const f32x4 (&acc)[2][2][4][2], const Unit& u, int wr, int wc, int fr, int fq) const {
        const int row0 = u.pm * BM + wr * 64 + fr, col0 = u.pn * BM + wc * 32 + 8 * fq;
#pragma unroll
        for (int ai = 0; ai < 2; ++ai)
#pragma unroll
            for (int m = 0; m < 4; ++m) { bf16_t* rowp = O + (size_t)(row0 + ai * HALF + m * 16) * ldc + col0;
#pragma unroll
                for (int bj = 0; bj < 2; ++bj) { const f32x4 v0 = acc[ai][bj][m][0], v1 = acc[ai][bj][m][1];
                    u32x4 w; w.x = cvt_pk_bf16(v0[0], v0[1]); w.y = cvt_pk_bf16(v0[2], v0[3]); w.z = cvt_pk_bf16(v1[0], v1[1]); w.w = cvt_pk_bf16(v1[2], v1[3]);
                    *(u32x4*)(rowp + bj * HALF) = w; } }
    }
};
struct EpiStoreSS {
    static constexpr bool PERM = true;
    bf16_t* O; int ldc; float* part;
    __device__ __forceinline__ void operator()(const f32x4 (&acc)[2][2][4][2], const Unit& u, int wr, int wc, int fr, int fq) const {
        const int row0 = u.pm * BM + wr * 64 + fr, col0 = u.pn * BM + wc * 32 + 8 * fq;
#pragma unroll
        for (int ai = 0; ai < 2; ++ai)
#pragma unroll
            for (int m = 0; m < 4; ++m) { const int row = row0 + ai * HALF + m * 16; bf16_t* rowp = O + (size_t)row * ldc + col0; float s = 0.f;
#pragma unroll
                for (int bj = 0; bj < 2; ++bj) { const f32x4 v0 = acc[ai][bj][m][0], v1 = acc[ai][bj][m][1];
                    s += (v0[0] * v0[0] + v0[1] * v0[1]) + (v0[2] * v0[2] + v0[3] * v0[3]) + (v1[0] * v1[0] + v1[1] * v1[1]) + (v1[2] * v1[2] + v1[3] * v1[3]);
                    u32x4 w; w.x = cvt_pk_bf16(v0[0], v0[1]); w.y = cvt_pk_bf16(v0[2], v0[3]); w.z = cvt_pk_bf16(v1[0], v1[1]); w.w = cvt_pk_bf16(v1[2], v1[3]);
                    *(u32x4*)(rowp + bj * HALF) = w; }
                s += __shfl_xor(s, 16); s += __shfl_xor(s, 32);
                if (fq == 0) part[(size_t)row * 32 + u.pn * 4 + wc] = s; }
    }
};
struct EpiSwiglu {
    static constexpr bool PERM = true;
    bf16_t* O; int ldc; const float* rsq;
    __device__ __forceinline__ void operator()(const f32x4 (&acc)[2][2][4][2], const Unit& u, int wr, int wc, int fr, int fq) const {
        const int row0 = u.pm * BM + wr * 64 + fr, col0 = u.pn * HALF + wc * 32 + 8 * fq;
#pragma unroll
        for (int ai = 0; ai < 2; ++ai)
#pragma unroll
            for (int m = 0; m < 4; ++m) { const int row = row0 + ai * HALF + m * 16; bf16_t* rowp = O + (size_t)row * ldc + col0; const float rr = rsq[row];
                float v[8];
#pragma unroll
                for (int n = 0; n < 2; ++n)
#pragma unroll
                    for (int j = 0; j < 4; ++j) { const float g = acc[ai][0][m][n][j] * rr, up = acc[ai][1][m][n][j] * rr; v[n * 4 + j] = g * fast_sigmoid(g) * up; }
                u32x4 w; w.x = cvt_pk_bf16(v[0], v[1]); w.y = cvt_pk_bf16(v[2], v[3]); w.z = cvt_pk_bf16(v[4], v[5]); w.w = cvt_pk_bf16(v[6], v[7]);
                *(u32x4*)rowp = w; }
    }
};
struct EpiPleGate {
    static constexpr bool PERM = true;
    bf16_t* O; int ldc; const bf16_t* ple; float* part; const float* rsq;
    __device__ __forceinline__ void operator()(const f32x4 (&acc)[2][2][4][2], const Unit& u, int wr, int wc, int fr, int fq) const {
        const int row0 = u.pm * BM + wr * 64 + fr, col0 = u.pn * BM + wc * 32 + 8 * fq;
#pragma unroll
        for (int ai = 0; ai < 2; ++ai)
#pragma unroll
            for (int m = 0; m < 4; ++m) { const int row = row0 + ai * HALF + m * 16; const size_t off = (size_t)row * ldc + col0; float s = 0.f; const float rr = rsq[row];
#pragma unroll
                for (int bj = 0; bj < 2; ++bj) { const u32x4 pl = *(const u32x4*)(ple + off + bj * HALF);
                    const f32x4 a0 = acc[ai][bj][m][0] * rr, a1 = acc[ai][bj][m][1] * rr; float v[8];
                    v[0] = fast_sigmoid(a0[0]) * bf_lo(pl.x); v[1] = fast_sigmoid(a0[1]) * bf_hi(pl.x); v[2] = fast_sigmoid(a0[2]) * bf_lo(pl.y); v[3] = fast_sigmoid(a0[3]) * bf_hi(pl.y);
                    v[4] = fast_sigmoid(a1[0]) * bf_lo(pl.z); v[5] = fast_sigmoid(a1[1]) * bf_hi(pl.z); v[6] = fast_sigmoid(a1[2]) * bf_lo(pl.w); v[7] = fast_sigmoid(a1[3]) * bf_hi(pl.w);
#pragma unroll
                    for (int j = 0; j < 8; ++j) s += v[j] * v[j];
                    u32x4 w; w.x = cvt_pk_bf16(v[0], v[1]); w.y = cvt_pk_bf16(v[2], v[3]); w.z = cvt_pk_bf16(v[4], v[5]); w.w = cvt_pk_bf16(v[6], v[7]);
                    *(u32x4*)(O + off + bj * HALF) = w; }
                s += __shfl_xor(s, 16); s += __shfl_xor(s, 32);
                if (fq == 0) part[(size_t)row * 32 + u.pn * 4 + wc] = s; }
    }
};

template <class Epi, class Sched>
__device__ __forceinline__ void gemm_phase(LAS unsigned char* lds, const Gemm g, const Sched& S, const Epi& E) {
    const int tid = threadIdx.x, wid = __builtin_amdgcn_readfirstlane(tid >> 6), lane = tid & 63, wr = wid >> 2, wc = wid & 3, fr = lane & 15, fq = lane >> 4;
    const int K = g.K, nt = K / BK;
    unsigned voffA[2], voffB[2];
#pragma unroll
    for (int i = 0; i < 2; ++i) { int R, C; stage_rc(tid * 16 + i * 8192, R, C); const int Rb = Epi::PERM ? ((R & ~31) + perm32(R & 31)) : R;
        voffA[i] = (unsigned)(R * K + C) * 2u; voffB[i] = (unsigned)(Rb * K + C) * 2u; }
    const size_t kstep = (size_t)(BK * 2);
    const size_t hstep = (size_t)HALF * K * 2;
    const size_t tstep = 2 * hstep;
    const unsigned ldsw = (unsigned)wid * 1024u;
    const int aoff = lds_byte(wr * 64 + fr, fq * 8), boff = lds_byte(wc * 32 + fr, fq * 8);
#define PG8_SA(b, h) (((b) * 2 + (h)) * HTB)
#define PG8_SB(b, h) ((4 + (b) * 2 + (h)) * HTB)
#define PG8_STAGE(bufoff, gbase, voff) do { _Pragma("unroll") for (int _i = 0; _i < 2; ++_i) \
        __builtin_amdgcn_global_load_lds((const unsigned*)((const char*)(gbase) + (voff)[_i]), (LAS unsigned*)(lds + (bufoff) + ldsw + _i * 8192), 16, 0, 0); } while (0)
#define PG8_LDA(dst, b, h) do { _Pragma("unroll") for (int m = 0; m < 4; ++m) _Pragma("unroll") for (int k = 0; k < 2; ++k) dst[m][k] = *(const LAS bf16x8*)(lds + PG8_SA(b, h) + aoff + m * 2048 + k * 1024); } while (0)
#define PG8_LDB(dst, b, h) do { _Pragma("unroll") for (int n = 0; n < 2; ++n) _Pragma("unroll") for (int k = 0; k < 2; ++k) dst[n][k] = *(const LAS bf16x8*)(lds + PG8_SB(b, h) + boff + n * 2048 + k * 1024); } while (0)
#define PG8_MMA(ai, bj, At, Bt) do { __builtin_amdgcn_s_setprio(1); _Pragma("unroll") for (int m = 0; m < 4; ++m) _Pragma("unroll") for (int n = 0; n < 2; ++n) _Pragma("unroll") for (int k = 0; k < 2; ++k) \
        acc[ai][bj][m][n] = __builtin_amdgcn_mfma_f32_16x16x32_bf16(Bt[n][k], At[m][k], acc[ai][bj][m][n], 0, 0, 0); __builtin_amdgcn_s_setprio(0); } while (0)
#define PG8_WAIT_V(n) asm volatile("s_waitcnt vmcnt(" #n ")" ::: "memory")
#define PG8_WAIT_L(n) asm volatile("s_waitcnt lgkmcnt(" #n ")" ::: "memory")
#define PG8_BAR __builtin_amdgcn_s_barrier()
#define PG8_SCHED __builtin_amdgcn_sched_barrier(0)
    Unit cur, nxt; int ui = 0;
    if (!S.next(0, cur)) return;
    f32x4 acc[2][2][4][2];
#pragma unroll
    for (int a = 0; a < 2; ++a)
#pragma unroll
        for (int b = 0; b < 2; ++b)
#pragma unroll
            for (int m = 0; m < 4; ++m)
#pragma unroll
                for (int n = 0; n < 2; ++n) acc[a][b][m][n] = (f32x4){0.f, 0.f, 0.f, 0.f};
    bf16x8 At[4][2], B0[2][2], B1[2][2];
    const char* cA = (const char*)g.A + (size_t)cur.pm * tstep; const char* cB = (const char*)g.Bt + (size_t)cur.pn * tstep;
    PG8_STAGE(PG8_SB(0, 0), cB, voffB); PG8_STAGE(PG8_SA(0, 0), cA, voffA); PG8_STAGE(PG8_SB(0, 1), cB + hstep, voffB); PG8_STAGE(PG8_SA(0, 1), cA + hstep, voffA);
    if (wr == 1) PG8_BAR;
    PG8_WAIT_V(4); PG8_BAR;
    PG8_STAGE(PG8_SB(1, 0), cB + kstep, voffB); PG8_STAGE(PG8_SA(1, 0), cA + kstep, voffA); PG8_STAGE(PG8_SB(1, 1), cB + hstep + kstep, voffB);
    PG8_WAIT_V(6); PG8_BAR;
    for (;;) {
        const bool has_next = S.next(ui + 1, nxt);
        const char* nA = has_next ? (const char*)g.A + (size_t)nxt.pm * tstep : cA; const char* nB = has_next ? (const char*)g.Bt + (size_t)nxt.pn * tstep : cB;
        for (int t = 0; t < nt; t += 2) {
            const bool last = (t == nt - 2);
            const char* a1 = cA + (size_t)(t + 1) * kstep;
            const char* a2 = last ? nA : cA + (size_t)(t + 2) * kstep; const char* b2 = last ? nB : cB + (size_t)(t + 2) * kstep;
            const char* a3 = a2 + kstep; const char* b3 = b2 + kstep;
            PG8_LDB(B0, 0, 0); PG8_SCHED; PG8_LDA(At, 0, 0); PG8_STAGE(PG8_SA(1, 1), a1 + hstep, voffA);
            PG8_WAIT_L(8); PG8_BAR; PG8_WAIT_L(0); PG8_MMA(0, 0, At, B0); PG8_BAR; PG8_SCHED;
            PG8_LDB(B1, 0, 1); PG8_STAGE(PG8_SB(0, 0), b2, voffB);
            PG8_BAR; PG8_WAIT_L(0); PG8_MMA(0, 1, At, B1); PG8_BAR;
            PG8_LDA(At, 0, 1); PG8_STAGE(PG8_SA(0, 0), a2, voffA);
            PG8_BAR; PG8_WAIT_L(0); PG8_MMA(1, 0, At, B0); PG8_BAR; PG8_SCHED;
            PG8_STAGE(PG8_SB(0, 1), b2 + hstep, voffB);
            PG8_WAIT_V(6); PG8_BAR; PG8_MMA(1, 1, At, B1); PG8_BAR;
            PG8_LDB(B0, 1, 0); PG8_SCHED; PG8_LDA(At, 1, 0); PG8_STAGE(PG8_SA(0, 1), a2 + hstep, voffA);
            PG8_WAIT_L(8); PG8_BAR; PG8_WAIT_L(0); PG8_MMA(0, 0, At, B0); PG8_BAR; PG8_SCHED;
            PG8_LDB(B1, 1, 1); PG8_STAGE(PG8_SB(1, 0), b3, voffB);
            PG8_BAR; PG8_WAIT_L(0); PG8_MMA(0, 1, At, B1); PG8_BAR;
            PG8_LDA(At, 1, 1); PG8_STAGE(PG8_SA(1, 0), a3, voffA);
            PG8_BAR; PG8_WAIT_L(0); PG8_MMA(1, 0, At, B0); PG8_BAR; PG8_SCHED;
            PG8_STAGE(PG8_SB(1, 1), b3 + hstep, voffB);
            PG8_WAIT_V(6); PG8_BAR; PG8_MMA(1, 1, At, B1); PG8_BAR;
        }
        E(acc, cur, wr, wc, fr, fq);
        if (!has_next) break;
#pragma unroll
        for (int a = 0; a < 2; ++a)
#pragma unroll
            for (int b = 0; b < 2; ++b)
#pragma unroll
                for (int m = 0; m < 4; ++m)
#pragma unroll
                    for (int n = 0; n < 2; ++n) acc[a][b][m][n] = (f32x4){0.f, 0.f, 0.f, 0.f};
        cur = nxt; cA = nA; cB = nB; ++ui;
    }
    PG8_WAIT_V(0);
    if (wr == 0) PG8_BAR;
    PG8_BAR;
#undef PG8_SA
#undef PG8_SB
#undef PG8_STAGE
#undef PG8_LDA
#undef PG8_LDB
#undef PG8_MMA
#undef PG8_WAIT_V
#undef PG8_WAIT_L
#undef PG8_BAR
#undef PG8_SCHED
}
}

__device__ __forceinline__ void p0_transpose_item(const float* W, int N, bf16_t* WT, int ldk, int k0, int n0, long dst_row0, LAS float* scr, int lane, const float* gk = nullptr) {
#pragma unroll 8
    for (int i = 0; i < 32; ++i) { const int kk = 2 * i + (lane >> 5); scr[kk * 33 + (lane & 31)] = W[(size_t)(k0 + kk) * N + n0 + (lane & 31)] * (gk ? gk[k0 + kk] : 1.0f); }
    asm volatile("s_waitcnt lgkmcnt(0)" ::: "memory");
    const int c = lane & 7;
#pragma unroll
    for (int j = 0; j < 4; ++j) { const int n = (lane >> 3) + 8 * j; const LAS float* s = scr + (8 * c) * 33 + n;
        u32x4 o; o.x = cvt_pk_bf16(s[0 * 33], s[1 * 33]); o.y = cvt_pk_bf16(s[2 * 33], s[3 * 33]); o.z = cvt_pk_bf16(s[4 * 33], s[5 * 33]); o.w = cvt_pk_bf16(s[6 * 33], s[7 * 33]);
        *(u32x4*)(WT + (size_t)(dst_row0 + n) * ldk + k0 + 8 * c) = o; }
    asm volatile("s_waitcnt lgkmcnt(0)" ::: "memory");
}

__device__ __forceinline__ void p0_phase(const Args& a, LAS unsigned char* lds, int tid, int wid, int lane) {
    unsigned char* ws = a.ws;
    LAS float* scr = (LAS float*)(lds + wid * 16384);
    const int gw = blockIdx.x * 8 + wid, NGW = gridDim.x * 8;
    constexpr int I_IN = 32 * 160, I_OUT = 32 * 64, I_G = 32 * 176, I_U = I_G, I_D = 88 * 64, I_PG = 32 * 64, I_PP = 4 * 64, I_RG = 32 * 8;
    constexpr int NITEMS = I_IN + I_OUT + I_G + I_U + I_D + I_PG + I_PP + I_RG;
    for (int it = gw; it < NITEMS; it += NGW) {
        int r = it;
        if (r < I_IN) { const int kb = r / 160, nb = r % 160; p0_transpose_item(a.in[3], DIN, (bf16_t*)(ws + WS_WIN), DM, kb * 64, nb * 32, nb * 32, scr, lane); continue; } r -= I_IN;
        if (r < I_OUT) { const int kb = r / 64, nb = r % 64; p0_transpose_item(a.in[14], DM, (bf16_t*)(ws + WS_WOUT), DM, kb * 64, nb * 32, nb * 32, scr, lane); continue; } r -= I_OUT;
        if (r < I_G) { const int kb = r / 176, nb = r % 176, n0 = nb * 32; p0_transpose_item(a.in[17], DFF, (bf16_t*)(ws + WS_WGU), DM, kb * 64, n0, (n0 >> 7) * 256 + (n0 & 127), scr, lane, a.in[16]); continue; } r -= I_G;
        if (r < I_U) { const int kb = r / 176, nb = r % 176, n0 = nb * 32; p0_transpose_item(a.in[18], DFF, (bf16_t*)(ws + WS_WGU), DM, kb * 64, n0, (n0 >> 7) * 256 + 128 + (n0 & 127), scr, lane, a.in[16]); continue; } r -= I_U;
        if (r < I_D) { const int kb = r / 64, nb = r % 64; p0_transpose_item(a.in[19], DM, (bf16_t*)(ws + WS_WD), DFF, kb * 64, nb * 32, nb * 32, scr, lane); continue; } r -= I_D;
        if (r < I_PG) { const int kb = r / 64, nb = r % 64; p0_transpose_item(a.in[22], DM, (bf16_t*)(ws + WS_WPG), DM, kb * 64, nb * 32, nb * 32, scr, lane, a.in[21]); continue; } r -= I_PG;
        if (r < I_PP) { const int kb = r / 64, nb = r % 64; p0_transpose_item(a.in[23], DM, (bf16_t*)(ws + WS_WPP), DPLE, kb * 64, nb * 32, nb * 32, scr, lane); continue; } r -= I_PP;
        { const int mat = r >> 3, sub = r & 7, kb = sub >> 2, nb = sub & 3; const int zn = mat & 15, z = zn >> 3, n = zn & 7, ty = (mat >> 4) * 2 + z;
          const float* src = (mat < 16 ? a.in[7] : a.in[9]) + (size_t)zn * 16384;
          p0_transpose_item(src, 128, (bf16_t*)(ws + WS_WG), 128, kb * 64, nb * 32, n * 512 + ty * 128 + nb * 32, scr, lane); }
    }
    const float* x = a.in[0]; const float* g = a.in[2]; bf16_t* XN = (bf16_t*)(ws + WS_XN);
    for (int m = gw; m < MTOK; m += NGW) {
        const f32x4* xr = (const f32x4*)(x + (size_t)m * DM);
        f32x4 v[8]; float s = 0.f;
#pragma unroll
        for (int j = 0; j < 8; ++j) { v[j] = xr[j * 64 + lane]; s += (v[j].x * v[j].x + v[j].y * v[j].y) + (v[j].z * v[j].z + v[j].w * v[j].w); }
        const float rs = rsqrtf(wave_sum(s) * (1.f / DM) + EPS);
        u32x2* o = (u32x2*)(XN + (size_t)m * DM);
#pragma unroll
        for (int j = 0; j < 8; ++j) { const f32x4 gv = ((const f32x4*)g)[j * 64 + lane]; u32x2 w; w.x = cvt_pk_bf16(v[j].x * rs * gv.x, v[j].y * rs * gv.y); w.y = cvt_pk_bf16(v[j].z * rs * gv.z, v[j].w * rs * gv.w); o[j * 64 + lane] = w; }
    }
    const f32x4* p4 = (const f32x4*)a.in[1]; u32x2* pb = (u32x2*)(ws + WS_PB);
    for (size_t i = (size_t)blockIdx.x * 512 + tid; i < (size_t)MTOK * DPLE / 4; i += (size_t)gridDim.x * 512) { const f32x4 v = p4[i]; u32x2 w; w.x = cvt_pk_bf16(v.x, v.y); w.y = cvt_pk_bf16(v.z, v.w); pb[i] = w; }
}

__device__ __forceinline__ void attn_phase(const Args& a, LAS unsigned char* lds, int tid, int wid, int lane) {
    const bf16_t* U = (const bf16_t*)(a.ws + WS_U); bf16_t* A2 = (bf16_t*)(a.ws + WS_A2); float* patt = (float*)(a.ws + WS_PATT);
    LAS float* rp = (LAS float*)(lds + 65536);
    for (int i = tid; i < 8 * 15 * 31; i += 512) rp[i] = a.in[4][i];
    __syncthreads();
    const int qb = wid & 3, hh = wid >> 2, l15 = lane & 15, lq = lane >> 4;
    const unsigned vbase = (unsigned)wid * 8192u;
    const unsigned traddr = vbase + (unsigned)((4 * lq + (l15 >> 2)) * 256 + (4 * (lane & 3)) * 2);
    const float LOG2E = 1.4426950408889634f, SC = 0.08838834764831845f * 1.4426950408889634f;
    for (int it = blockIdx.x; it < 512; it += gridDim.x) {
        const int b = it >> 7, r = it & 127;
        const int rstart = min(max(r - 4, 0), 120);
        const int kc0 = min(max(16 * qb - 8, 0), 32);
        const int qcol = 16 * qb + l15, cstart = min(max(qcol - 8, 0), 48);
        const size_t tokq = (size_t)b * SEQ + r * 64 + qcol;
        for (int hi = 0; hi < 4; ++hi) {
            const int h = 2 * hi + hh;
            bf16x8 qf[4]; { const bf16_t* qp = U + tokq * DIN + h * 128 + lq * 8;
#pragma unroll
                for (int ks = 0; ks < 4; ++ks) qf[ks] = *(const bf16x8*)(qp + ks * 32); }
            f32x4 sT[16];
            bf16x8 kf[3][2][4];
#define LOADK(buf, Tg_) do { _Pragma("unroll") for (int tt = 0; tt < 2; ++tt) { const int T = (Tg_) * 2 + tt; \
                const bf16_t* kp = U + ((size_t)b * SEQ + (rstart + (T >> 1)) * 64 + kc0 + 16 * (T & 1) + l15) * DIN + 1024 + h * 128 + lq * 8; \
                _Pragma("unroll") for (int ks = 0; ks < 4; ++ks) kf[buf][tt][ks] = *(const bf16x8*)(kp + ks * 32); } } while (0)
            LOADK(0, 0); LOADK(1, 1);
#pragma unroll
            for (int Tg = 0; Tg < 8; ++Tg) {
                if (Tg < 6) LOADK((Tg + 2) % 3, Tg + 2);
                __builtin_amdgcn_sched_barrier(0);
#pragma unroll
                for (int tt = 0; tt < 2; ++tt) { f32x4 s_ = (f32x4){0.f, 0.f, 0.f, 0.f};
#pragma unroll
                    for (int ks = 0; ks < 4; ++ks) s_ = __builtin_amdgcn_mfma_f32_16x16x32_bf16(kf[Tg % 3][tt][ks], qf[ks], s_, 0, 0, 0);
                    sT[Tg * 2 + tt] = s_; }
                __builtin_amdgcn_sched_barrier(0);
            }
#undef LOADK
            float mx = -1e30f;
#pragma unroll
            for (int T = 0; T < 16; ++T) {
                const int dr = rstart + (T >> 1) - r + 7;
#pragma unroll
                for (int j = 0; j < 4; ++j) {
                    const int kc = kc0 + 16 * (T & 1) + 4 * lq + j; const bool valid = (kc >= cstart) && (kc < cstart + 16);
                    const int dc = min(max(kc - qcol + 15, 0), 30);
                    const float bias = rp[(h * 15 + dr) * 31 + dc];
                    const float t = valid ? (sT[T][j] * SC + bias * LOG2E) : -1e30f;
                    sT[T][j] = t; mx = fmaxf(mx, t);
                }
            }
            mx = fmaxf(mx, __shfl_xor(mx, 16)); mx = fmaxf(mx, __shfl_xor(mx, 32));
            float sum = 0.f;
#pragma unroll
            for (int T = 0; T < 16; ++T)
#pragma unroll
                for (int j = 0; j < 4; ++j) { const float p = __builtin_amdgcn_exp2f(sT[T][j] - mx); sT[T][j] = p; sum += p; }
            sum += __shfl_xor(sum, 16); sum += __shfl_xor(sum, 32);
            union PF { u32x4 u; bf16x8 v; }; PF pf[8];
#pragma unroll
            for (int kr = 0; kr < 8; ++kr) {
                pf[kr].u.x = cvt_pk_bf16(sT[2 * kr][0], sT[2 * kr][1]); pf[kr].u.y = cvt_pk_bf16(sT[2 * kr][2], sT[2 * kr][3]);
                pf[kr].u.z = cvt_pk_bf16(sT[2 * kr + 1][0], sT[2 * kr + 1][1]); pf[kr].u.w = cvt_pk_bf16(sT[2 * kr + 1][2], sT[2 * kr + 1][3]); }
            f32x4 oT[8];
#pragma unroll
            for (int dt = 0; dt < 8; ++dt) oT[dt] = (f32x4){0.f, 0.f, 0.f, 0.f};
            u32x4 vst[3][8];
#define LOADV(buf, kr_) do { const bf16_t* vp = U + ((size_t)b * SEQ + (rstart + (kr_)) * 64 + kc0) * DIN + 2048 + h * 128; \
                _Pragma("unroll") for (int jj = 0; jj < 8; ++jj) { const int c = jj * 64 + lane; vst[buf][jj] = *(const u32x4*)(vp + (size_t)(c >> 4) * DIN + (c & 15) * 8); } } while (0)
            LOADV(0, 0); LOADV(1, 1);
#pragma unroll
            for (int kr = 0; kr < 8; ++kr) {
#pragma unroll
                for (int jj = 0; jj < 8; ++jj) { const int c = jj * 64 + lane; *(LAS u32x4*)(lds + vbase + (c >> 4) * 256 + (c & 15) * 16) = vst[kr % 3][jj]; }
                if (kr < 6) { __builtin_amdgcn_sched_barrier(0); LOADV((kr + 2) % 3, kr + 2); __builtin_amdgcn_sched_barrier(0); }
                s16x4 t0, t1, t2, t3, t4, t5, t6, t7, t8, t9, t10, t11, t12, t13, t14, t15;
                asm volatile("s_waitcnt lgkmcnt(0)\n\t"
                             "ds_read_b64_tr_b16 %0, %16 offset:0\n\t"   "ds_read_b64_tr_b16 %1, %16 offset:4096\n\t"
                             "ds_read_b64_tr_b16 %2, %16 offset:32\n\t"  "ds_read_b64_tr_b16 %3, %16 offset:4128\n\t"
                             "ds_read_b64_tr_b16 %4, %16 offset:64\n\t"  "ds_read_b64_tr_b16 %5, %16 offset:4160\n\t"
                             "ds_read_b64_tr_b16 %6, %16 offset:96\n\t"  "ds_read_b64_tr_b16 %7, %16 offset:4192\n\t"
                             "ds_read_b64_tr_b16 %8, %16 offset:128\n\t" "ds_read_b64_tr_b16 %9, %16 offset:4224\n\t"
                             "ds_read_b64_tr_b16 %10, %16 offset:160\n\t" "ds_read_b64_tr_b16 %11, %16 offset:4256\n\t"
                             "ds_read_b64_tr_b16 %12, %16 offset:192\n\t" "ds_read_b64_tr_b16 %13, %16 offset:4288\n\t"
                             "ds_read_b64_tr_b16 %14, %16 offset:224\n\t" "ds_read_b64_tr_b16 %15, %16 offset:4320\n\t"
                             "s_waitcnt lgkmcnt(0)"
                             : "=&v"(t0), "=&v"(t1), "=&v"(t2), "=&v"(t3), "=&v"(t4), "=&v"(t5), "=&v"(t6), "=&v"(t7),
                               "=&v"(t8), "=&v"(t9), "=&v"(t10), "=&v"(t11), "=&v"(t12), "=&v"(t13), "=&v"(t14), "=&v"(t15)
                             : "v"(traddr) : "memory");
#define PV_MMA(dt, lo, hi) { bf16x8 vf; vf[0] = lo[0]; vf[1] = lo[1]; vf[2] = lo[2]; vf[3] = lo[3]; vf[4] = hi[0]; vf[5] = hi[1]; vf[6] = hi[2]; vf[7] = hi[3]; \
                    oT[dt] = __builtin_amdgcn_mfma_f32_16x16x32_bf16(vf, pf[kr].v, oT[dt], 0, 0, 0); }
                PV_MMA(0, t0, t1) PV_MMA(1, t2, t3) PV_MMA(2, t4, t5) PV_MMA(3, t6, t7) PV_MMA(4, t8, t9) PV_MMA(5, t10, t11) PV_MMA(6, t12, t13) PV_MMA(7, t14, t15)
#undef PV_MMA
            }
#undef LOADV
            const float inv = 1.0f / sum; float ss = 0.f;
            bf16_t* op = A2 + tokq * DM + h * 128 + 4 * lq;
#pragma unroll
            for (int dt = 0; dt < 8; ++dt) { const f32x4 o = oT[dt] * inv; ss += (o[0] * o[0] + o[1] * o[1]) + (o[2] * o[2] + o[3] * o[3]);
                u32x2 w; w.x = cvt_pk_bf16(o[0], o[1]); w.y = cvt_pk_bf16(o[2], o[3]); *(u32x2*)(op + 16 * dt) = w; }
            ss += __shfl_xor(ss, 16); ss += __shfl_xor(ss, 32);
            if (lq == 0) patt[tokq * 8 + h] = ss;
        }
    }
    __syncthreads();
}

__device__ __forceinline__ void attn_phase_naive(const Args& a, int wid, int lane) {
    const bf16_t* U = (const bf16_t*)(a.ws + WS_U); bf16_t* A2 = (bf16_t*)(a.ws + WS_A2); float* patt = (float*)(a.ws + WS_PATT);
    const float* rpb = a.in[4];
    const int gw = blockIdx.x * 8 + wid, NGW = gridDim.x * 8;
    for (int wi = gw; wi < MTOK * 8; wi += NGW) {
        const int h = wi & 7, tok = wi >> 3, b = tok >> 13, s = tok & 8191, r = s >> 6, qcol = s & 63;
        const int rstart = min(max(r - 4, 0), 120), cstart = min(max(qcol - 8, 0), 48);
        const unsigned qw = *(const unsigned*)(U + (size_t)tok * DIN + h * 128 + 2 * lane);
        const float q0 = bf_lo(qw) * 0.08838834764831845f, q1 = bf_hi(qw) * 0.08838834764831845f;
        float mx = -1e30f, l = 0.f, o0 = 0.f, o1 = 0.f;
        for (int kr = 0; kr < 8; ++kr)
            for (int kc = 0; kc < 16; ++kc) {
                const size_t kt = (size_t)b * SEQ + (rstart + kr) * 64 + cstart + kc;
                const unsigned kw = *(const unsigned*)(U + kt * DIN + 1024 + h * 128 + 2 * lane);
                const unsigned vw = *(const unsigned*)(U + kt * DIN + 2048 + h * 128 + 2 * lane);
                float d = wave_sum(q0 * bf_lo(kw) + q1 * bf_hi(kw));
                d += rpb[(h * 15 + (rstart + kr - r + 7)) * 31 + (cstart + kc - qcol + 15)];
                const float nm = fmaxf(mx, d), sc = __expf(mx - nm), p = __expf(d - nm);
                l = l * sc + p; o0 = o0 * sc + p * bf_lo(vw); o1 = o1 * sc + p * bf_hi(vw); mx = nm;
            }
        o0 /= l; o1 /= l;
        *(unsigned*)(A2 + (size_t)tok * DM + h * 128 + 2 * lane) = cvt_pk_bf16(o0, o1);
        const float ss = wave_sum(o0 * o0 + o1 * o1);
        if (lane == 0) patt[(size_t)tok * 8 + h] = ss;
    }
}

template <bool FINAL>
__device__ __forceinline__ void rglru_phase(const Args& a, LAS unsigned char* lds, int tid, int wid, int lane) {
    const bf16_t* U = (const bf16_t*)(a.ws + WS_U); bf16_t* A2 = (bf16_t*)(a.ws + WS_A2); float* prec = (float*)(a.ws + WS_PREC);
    float* sumr = (float*)(a.ws + WS_SUM); const bf16_t* WG = (const bf16_t*)(a.ws + WS_WG);
    const float* conv_w = a.in[5]; const float* conv_b = a.in[6]; const float* b_a = a.in[8]; const float* b_i = a.in[10]; const float* lam = a.in[11];
    constexpr int XC_OFF = 0, YG_OFF = 34816, REC_OFF = 69632, RS = 272;
    const int cgp0 = tid & 15, tq0 = tid >> 4, l150 = lane & 15, lq0 = lane >> 4;
    for (int it = blockIdx.x; it < 2048; it += gridDim.x) {
        int cgp = cgp0, tq = tq0, l15 = l150, lq = lq0;
        asm volatile("" : "+v"(cgp), "+v"(tq), "+v"(l15), "+v"(lq));
        const int n = it & 7, c = (it >> 3) & 63, b = it >> 9, t0 = c * 128;
        {
            const int chb = n * 128 + cgp * 8;
            float xin[7][8];
#pragma unroll
            for (int rr = 0; rr < 7; ++rr) { const int ts = t0 + 4 * tq - 2 + rr;
                u32x4 v = (u32x4){0u, 0u, 0u, 0u};
                if (ts >= 0 && ts < SEQ) v = *(const u32x4*)(U + ((size_t)b * SEQ + ts) * DIN + 3072 + chb);
                xin[rr][0] = bf_lo(v.x); xin[rr][1] = bf_hi(v.x); xin[rr][2] = bf_lo(v.y); xin[rr][3] = bf_hi(v.y); xin[rr][4] = bf_lo(v.z); xin[rr][5] = bf_hi(v.z); xin[rr][6] = bf_lo(v.w); xin[rr][7] = bf_hi(v.w); }
            float cw[4][8], cb[8];
#pragma unroll
            for (int j = 0; j < 4; ++j) { const f32x4 w0 = *(const f32x4*)(conv_w + j * DREC + chb), w1 = *(const f32x4*)(conv_w + j * DREC + chb + 4);
                cw[j][0] = w0.x; cw[j][1] = w0.y; cw[j][2] = w0.z; cw[j][3] = w0.w; cw[j][4] = w1.x; cw[j][5] = w1.y; cw[j][6] = w1.z; cw[j][7] = w1.w; }
            { const f32x4 w0 = *(const f32x4*)(conv_b + chb), w1 = *(const f32x4*)(conv_b + chb + 4); cb[0] = w0.x; cb[1] = w0.y; cb[2] = w0.z; cb[3] = w0.w; cb[4] = w1.x; cb[5] = w1.y; cb[6] = w1.z; cb[7] = w1.w; }
#pragma unroll
            for (int i = 0; i < 4; ++i) { float o[8];
#pragma unroll
                for (int e = 0; e < 8; ++e) o[e] = cb[e] + cw[0][e] * xin[i][e] + cw[1][e] * xin[i + 1][e] + cw[2][e] * xin[i + 2][e] + cw[3][e] * xin[i + 3][e];
                u32x4 w; w.x = cvt_pk_bf16(o[0], o[1]); w.y = cvt_pk_bf16(o[2], o[3]); w.z = cvt_pk_bf16(o[4], o[5]); w.w = cvt_pk_bf16(o[6], o[7]);
                *(LAS u32x4*)(lds + XC_OFF + (4 * tq + i) * RS + cgp * 16) = w; }
            if (FINAL) {
#pragma unroll
                for (int i = 0; i < 4; ++i) { const u32x4 v = *(const u32x4*)(U + ((size_t)b * SEQ + t0 + 4 * tq + i) * DIN + 4096 + chb); *(LAS u32x4*)(lds + YG_OFF + (4 * tq + i) * RS + cgp * 16) = v; }
            }
        }
        __syncthreads();
        const int chl = 16 * wid + l15, gch = n * 128 + chl;
        float cend[2], ptot[2];
        f32x4 hs[8];
#pragma unroll
        for (int dir = 0; dir < 2; ++dir) {
            f32x4 acc[2][8];
#pragma unroll
            for (int ty = 0; ty < 2; ++ty)
#pragma unroll
                for (int mt = 0; mt < 8; ++mt) acc[ty][mt] = (f32x4){0.f, 0.f, 0.f, 0.f};
#pragma unroll
            for (int ks = 0; ks < 4; ++ks) {
                bf16x8 af[8];
#pragma unroll
                for (int mt = 0; mt < 8; ++mt) af[mt] = *(const LAS bf16x8*)(lds + XC_OFF + (16 * mt + l15) * RS + (ks * 32 + lq * 8) * 2);
#pragma unroll
                for (int ty = 0; ty < 2; ++ty) { const bf16x8 wf = *(const bf16x8*)(WG + (size_t)(n * 512 + (ty * 2 + dir) * 128 + chl) * 128 + ks * 32 + lq * 8);
#pragma unroll
                    for (int mt = 0; mt < 8; ++mt) acc[ty][mt] = __builtin_amdgcn_mfma_f32_16x16x32_bf16(af[mt], wf, acc[ty][mt], 0, 0, 0); }
            }
            __builtin_amdgcn_sched_barrier(0);
            const float ba = b_a[dir * DREC + gch], bi = b_i[dir * DREC + gch];
            const float kf = 8.0f * log1pf(expf(-lam[dir * DREC + gch]));
#pragma unroll
            for (int mt = 0; mt < 8; ++mt) {
#pragma unroll
                for (int r = 0; r < 4; ++r) {
                    const int tt = 16 * mt + 4 * lq + r;
                    const float xcv = bf1(*(const LAS unsigned short*)(lds + XC_OFF + tt * RS + chl * 2));
                    const float rg = fast_sigmoid(acc[0][mt][r] + ba), ig = fast_sigmoid(acc[1][mt][r] + bi), av = __expf(-kf * rg);
                    acc[0][mt][r] = av; acc[1][mt][r] = sqrtf(fmaxf(1.0f - av * av, 0.f)) * ig * xcv;
                }
                __builtin_amdgcn_sched_barrier(0);
            }
            __builtin_amdgcn_sched_barrier(0);
            float cr = 0.f;
            if (FINAL) {
                float P = 1.f, H = 0.f;
                if (dir == 0) { const int lo = lq * 16, hi = min(lo + 16, c);
                    for (int cc = lo; cc < hi; ++cc) { const float* sp = sumr + ((size_t)((b * 64 + cc) * 2 + 0) * 2) * 1024 + gch; const float A = sp[0], Hc = sp[1024]; H = A * H + Hc; P *= A; }
#pragma unroll
                    for (int g = 0; g < 4; ++g) { const float Pg = __shfl(P, g * 16 + l15), Hg = __shfl(H, g * 16 + l15); cr = Pg * cr + Hg; } }
                else { const int lo = max(lq * 16, c + 1), hi = lq * 16 + 16;
                    for (int cc = hi - 1; cc >= lo; --cc) { const float* sp = sumr + ((size_t)((b * 64 + cc) * 2 + 1) * 2) * 1024 + gch; const float A = sp[0], Hc = sp[1024]; H = A * H + Hc; P *= A; }
#pragma unroll
                    for (int g = 3; g >= 0; --g) { const float Pg = __shfl(P, g * 16 + l15), Hg = __shfl(H, g * 16 + l15); cr = Pg * cr + Hg; } }
            }
            __builtin_amdgcn_sched_barrier(0);
            float pt = 1.f;
            if (dir == 0) {
#pragma unroll
                for (int mt = 0; mt < 8; ++mt) {
                    float H = 0.f, P = 1.f, hl[4], pl[4];
#pragma unroll
                    for (int r = 0; r < 4; ++r) { H = acc[0][mt][r] * H + acc[1][mt][r]; P *= acc[0][mt][r]; hl[r] = H; pl[r] = P; }
                    const float P0 = __shfl(P, l15), H0 = __shfl(H, l15), P1 = __shfl(P, 16 + l15), H1 = __shfl(H, 16 + l15), P2 = __shfl(P, 32 + l15), H2 = __shfl(H, 32 + l15), P3 = __shfl(P, 48 + l15), H3 = __shfl(H, 48 + l15);
                    const float c0 = cr, c1 = P0 * c0 + H0, c2 = P1 * c1 + H1, c3 = P2 * c2 + H2, c4 = P3 * c3 + H3;
                    if (FINAL) { const float mine = lq == 0 ? c0 : (lq == 1 ? c1 : (lq == 2 ? c2 : c3));
#pragma unroll
                        for (int r = 0; r < 4; ++r) hs[mt][r] = hl[r] + pl[r] * mine; }
                    else pt *= (P0 * P1) * (P2 * P3);
                    cr = c4;
                }
            } else {
#pragma unroll
                for (int mt = 7; mt >= 0; --mt) {
                    float H = 0.f, P = 1.f, hl[4], pl[4];
#pragma unroll
                    for (int r = 3; r >= 0; --r) { H = acc[0][mt][r] * H + acc[1][mt][r]; P *= acc[0][mt][r]; hl[r] = H; pl[r] = P; }
                    const float P0 = __shfl(P, l15), H0 = __shfl(H, l15), P1 = __shfl(P, 16 + l15), H1 = __shfl(H, 16 + l15), P2 = __shfl(P, 32 + l15), H2 = __shfl(H, 32 + l15), P3 = __shfl(P, 48 + l15), H3 = __shfl(H, 48 + l15);
                    const float c3 = cr, c2 = P3 * c3 + H3, c1 = P2 * c2 + H2, c0 = P1 * c1 + H1, cn = P0 * c0 + H0;
                    if (FINAL) { const float mine = lq == 0 ? c0 : (lq == 1 ? c1 : (lq == 2 ? c2 : c3));
#pragma unroll
                        for (int r = 0; r < 4; ++r) hs[mt][r] += hl[r] + pl[r] * mine; }
                    else pt *= (P0 * P1) * (P2 * P3);
                    cr = cn;
                }
            }
            cend[dir] = cr; ptot[dir] = pt;
            __builtin_amdgcn_sched_barrier(0);
        }
        if (!FINAL) {
            if (lq == 0) { float* sp = sumr + ((size_t)((b * 64 + c) * 2 + 0) * 2) * 1024 + gch; sp[0] = ptot[0]; sp[1024] = cend[0]; sp[2048] = ptot[1]; sp[3072] = cend[1]; }
            __syncthreads();
        } else {
#pragma unroll
            for (int mt = 0; mt < 8; ++mt) {
#pragma unroll
                for (int r = 0; r < 4; ++r) { const int tt = 16 * mt + 4 * lq + r;
                    const float y = bf1(*(const LAS unsigned short*)(lds + YG_OFF + tt * RS + chl * 2));
                    const float z = 0.7978845608028654f * (y + 0.044715f * y * y * y);
                    const float gl = y * fast_sigmoid(2.0f * z);
                    const float v = hs[mt][r] * gl;
                    *(LAS unsigned short*)(lds + REC_OFF + tt * RS + chl * 2) = (unsigned short)(cvt_pk_bf16(v, 0.f) & 0xffffu); }
                __builtin_amdgcn_sched_barrier(0);
            }
            __syncthreads();
            { const int tok = tid >> 2, qtr = tid & 3; float ss = 0.f;
              bf16_t* dst = A2 + ((size_t)b * SEQ + t0 + tok) * DM + DATT + n * 128 + qtr * 32;
#pragma unroll
              for (int j = 0; j < 4; ++j) { const u32x4 v = *(const LAS u32x4*)(lds + REC_OFF + tok * RS + qtr * 64 + j * 16);
                  const float e0 = bf_lo(v.x), e1 = bf_hi(v.x), e2 = bf_lo(v.y), e3 = bf_hi(v.y), e4 = bf_lo(v.z), e5 = bf_hi(v.z), e6 = bf_lo(v.w), e7 = bf_hi(v.w);
                  ss += (e0 * e0 + e1 * e1) + (e2 * e2 + e3 * e3) + (e4 * e4 + e5 * e5) + (e6 * e6 + e7 * e7);
                  *(u32x4*)(dst + j * 8) = v; }
              ss += __shfl_xor(ss, 1); ss += __shfl_xor(ss, 2);
              if (qtr == 0) prec[((size_t)b * SEQ + t0 + tok) * 8 + n] = ss; }
            __syncthreads();
        }
    }
}

__device__ __forceinline__ void fixup_phase(const Args& a, int wid, int lane) {
    bf16_t* A2 = (bf16_t*)(a.ws + WS_A2); const float* patt = (const float*)(a.ws + WS_PATT); const float* prec = (const float*)(a.ws + WS_PREC);
    const float* ga = a.in[12]; const float* gr = a.in[13];
    const int gw = blockIdx.x * 8 + wid, NGW = gridDim.x * 8;
    for (int m = gw; m < MTOK; m += NGW) {
        float pv = (lane < 8) ? patt[(size_t)m * 8 + lane] : ((lane < 16) ? prec[(size_t)m * 8 + lane - 8] : 0.f);
        pv += __shfl_xor(pv, 1); pv += __shfl_xor(pv, 2); pv += __shfl_xor(pv, 4);
        const float ssa = __shfl(pv, 0), ssr = __shfl(pv, 8);
        const float rsa = rsqrtf(ssa * (1.f / DATT) + EPS), rsr = rsqrtf(ssr * (1.f / DREC) + EPS);
        u32x4* row = (u32x4*)(A2 + (size_t)m * DM);
#pragma unroll
        for (int j = 0; j < 4; ++j) { const int ci = j * 64 + lane; const u32x4 v = row[ci];
            const float rs = (j < 2) ? rsa : rsr; const float* gp = (j < 2) ? (ga + ci * 8) : (gr + (ci - 128) * 8);
            const f32x4 g0 = *(const f32x4*)gp, g1 = *(const f32x4*)(gp + 4);
            u32x4 w; w.x = cvt_pk_bf16(bf_lo(v.x) * rs * g0.x, bf_hi(v.x) * rs * g0.y); w.y = cvt_pk_bf16(bf_lo(v.y) * rs * g0.z, bf_hi(v.y) * rs * g0.w);
            w.z = cvt_pk_bf16(bf_lo(v.z) * rs * g1.x, bf_hi(v.z) * rs * g1.y); w.w = cvt_pk_bf16(bf_lo(v.w) * rs * g1.z, bf_hi(v.w) * rs * g1.w);
            row[ci] = w; }
    }
}

template <int MODE>
__device__ __forceinline__ void epass_phase(const Args& a, const float* g_post, float* rsq, int wid, int lane) {
    const bf16_t* Y = (const bf16_t*)(a.ws + WS_Y); const float* part = (const float*)(a.ws + WS_PART); bf16_t* HB = (bf16_t*)(a.ws + WS_XN); float* out = a.out; const float* x = a.in[0];
    const int gw = blockIdx.x * 8 + wid, NGW = gridDim.x * 8;
    for (int m = gw; m < MTOK; m += NGW) {
        float pv = part[(size_t)m * 32 + (lane & 31)];
#pragma unroll
        for (int o = 1; o < 32; o <<= 1) pv += __shfl_xor(pv, o);
        const float rs = rsqrtf(pv * (1.f / DM) + EPS);
        const u32x2* yr = (const u32x2*)(Y + (size_t)m * DM); u32x2* hb = (u32x2*)(HB + (size_t)m * DM);
        f32x4 h[8]; float s2 = 0.f;
#pragma unroll
        for (int j = 0; j < 8; ++j) { f32x4 hv;
            if (MODE == 0) hv = ((const f32x4*)(x + (size_t)m * DM))[j * 64 + lane];
            else { const u32x2 hw = hb[j * 64 + lane]; hv.x = bf_lo(hw.x); hv.y = bf_hi(hw.x); hv.z = bf_lo(hw.y); hv.w = bf_hi(hw.y); }
            const u32x2 yv = yr[j * 64 + lane]; const f32x4 g = ((const f32x4*)g_post)[j * 64 + lane];
            f32x4 o; o.x = hv.x + bf_lo(yv.x) * rs * g.x; o.y = hv.y + bf_hi(yv.x) * rs * g.y; o.z = hv.z + bf_lo(yv.y) * rs * g.z; o.w = hv.w + bf_hi(yv.y) * rs * g.w;
            h[j] = o; s2 += (o.x * o.x + o.y * o.y) + (o.z * o.z + o.w * o.w); }
        if (MODE == 2) { f32x4* orow = (f32x4*)(out + (size_t)m * DM);
#pragma unroll
            for (int j = 0; j < 8; ++j) orow[j * 64 + lane] = h[j]; }
        else {
#pragma unroll
            for (int j = 0; j < 8; ++j) { u32x2 w; w.x = cvt_pk_bf16(h[j].x, h[j].y); w.y = cvt_pk_bf16(h[j].z, h[j].w); hb[j * 64 + lane] = w; }
            const float rs2 = rsqrtf(wave_sum(s2) * (1.f / DM) + EPS);
            if (lane == 0) rsq[m] = rs2; }
    }
}

__global__ void __launch_bounds__(512) fwd_kernel(Args a) {
    extern __shared__ __attribute__((aligned(16))) unsigned char lds_raw[];
    LAS unsigned char* lds = (LAS unsigned char*)lds_raw;
    const int tid = threadIdx.x, wid = __builtin_amdgcn_readfirstlane(tid >> 6), lane = tid & 63;
    unsigned char* ws = a.ws;
    const int lo = a.ph_lo, hi = a.ph_hi;
#define IN(k) (lo <= (k) && (k) < hi && PH_ON(k))
#define SEAM(k) do { if (lo <= (k) && (k) + 1 < hi) cg::this_grid().sync(); } while (0)
#define PHASE(k, ...) do { if (IN(k)) { __VA_ARGS__ } if (NREP(k) > 1) { if (IN(k)) { __VA_ARGS__ } } } while (0)
    PHASE(0, p0_phase(a, lds, tid, wid, lane););
    SEAM(0);
    PHASE(1,
        for (int gi = 0; gi < 2; ++gi) {
            pg8::Gemm g{(const bf16_t*)(ws + (gi ? WS_PB : WS_XN)), (const bf16_t*)(ws + (gi ? WS_WPP : WS_WIN)), MTOK, gi ? DM : DIN, gi ? DPLE : DM}; pg8::StaticOrder S; S.init(MTOK, gi ? DM : DIN, gridDim.x, blockIdx.x);
            pg8::EpiStore E{(bf16_t*)(ws + (gi ? WS_PLE : WS_U)), gi ? DM : DIN}; pg8::gemm_phase(lds, g, S, E); }
    );
    SEAM(1);
    PHASE(2,
        if (NAIVE_ATTN) attn_phase_naive(a, wid, lane); else attn_phase(a, lds, tid, wid, lane);
#ifdef DUP_ATTN
        attn_phase(a, lds, tid, wid, lane);
#endif
        rglru_phase<false>(a, lds, tid, wid, lane);
    );
    SEAM(2);
    PHASE(3, rglru_phase<true>(a, lds, tid, wid, lane););
    SEAM(3);
    PHASE(4, fixup_phase(a, wid, lane););
    SEAM(4);
    PHASE(5, pg8::Gemm g{(const bf16_t*)(ws + WS_A2), (const bf16_t*)(ws + WS_WOUT), MTOK, DM, DM}; pg8::StaticOrder S; S.init(MTOK, DM, gridDim.x, blockIdx.x);
        pg8::EpiStoreSS E{(bf16_t*)(ws + WS_Y), DM, (float*)(ws + WS_PART)}; pg8::gemm_phase(lds, g, S, E););
    SEAM(5);
    PHASE(6, epass_phase<0>(a, a.in[15], (float*)(ws + WS_RSQ), wid, lane););
    SEAM(6);
    PHASE(7, pg8::Gemm g{(const bf16_t*)(ws + WS_XN), (const bf16_t*)(ws + WS_WGU), MTOK, 2 * DFF, DM}; pg8::StaticOrder S; S.init(MTOK, 2 * DFF, gridDim.x, blockIdx.x);
        pg8::EpiSwiglu E{(bf16_t*)(ws + WS_ACT), DFF, (const float*)(ws + WS_RSQ)}; pg8::gemm_phase(lds, g, S, E););
    SEAM(7);
    PHASE(8, pg8::Gemm g{(const bf16_t*)(ws + WS_ACT), (const bf16_t*)(ws + WS_WD), MTOK, DM, DFF}; pg8::StaticOrder S; S.init(MTOK, DM, gridDim.x, blockIdx.x);
        pg8::EpiStoreSS E{(bf16_t*)(ws + WS_Y), DM, (float*)(ws + WS_PART)}; pg8::gemm_phase(lds, g, S, E););
    SEAM(8);
    PHASE(9, epass_phase<1>(a, a.in[20], (float*)(ws + WS_RSQ) + MTOK, wid, lane););
    SEAM(9);
    PHASE(10, pg8::Gemm g{(const bf16_t*)(ws + WS_XN), (const bf16_t*)(ws + WS_WPG), MTOK, DM, DM}; pg8::StaticOrder S; S.init(MTOK, DM, gridDim.x, blockIdx.x);
        pg8::EpiPleGate E{(bf16_t*)(ws + WS_Y), DM, (const bf16_t*)(ws + WS_PLE), (float*)(ws + WS_PART), (const float*)(ws + WS_RSQ) + MTOK}; pg8::gemm_phase(lds, g, S, E););
    SEAM(10);
    PHASE(11, epass_phase<2>(a, a.in[24], nullptr, wid, lane););
#undef IN
#undef SEAM
#undef PHASE
}

extern "C" void kernel_launch(void* const* d_in, const int* in_sizes, int n_in, void* d_out, int out_size, void* d_ws, size_t ws_size, hipStream_t stream) {
    static int grid = 0;
    if (grid == 0) {
        int dev = 0, cus = 0;
        if (hipGetDevice(&dev) != hipSuccess || hipDeviceGetAttribute(&cus, hipDeviceAttributeMultiprocessorCount, dev) != hipSuccess) { fprintf(stderr, "device query failed\n"); grid = -1; return; }
        if (hipFuncSetAttribute((const void*)fwd_kernel, hipFuncAttributeMaxDynamicSharedMemorySize, LDS_BYTES) != hipSuccess) { fprintf(stderr, "hipFuncSetAttribute failed\n"); grid = -1; return; }
        int per_cu = 0;
        if (hipOccupancyMaxActiveBlocksPerMultiprocessor(&per_cu, (const void*)fwd_kernel, 512, LDS_BYTES) != hipSuccess || per_cu < 1) { fprintf(stderr, "occupancy query: %d\n", per_cu); per_cu = 1; }
        (void)hipGetLastError();
        grid = cus;
        if (ws_size < 968 * MiB) fprintf(stderr, "workspace too small: %zu\n", ws_size);
    }
    if (grid < 0) return;
    Args a{};
    for (int i = 0; i < 25; ++i) a.in[i] = (const float*)d_in[i];
    a.out = (float*)d_out; a.ws = (unsigned char*)d_ws;
#if MK_ONE_LAUNCH
    a.ph_lo = 0; a.ph_hi = NPH;
    void* args[] = {&a};
    hipError_t e = hipLaunchCooperativeKernel((const void*)fwd_kernel, dim3(grid), dim3(512), args, LDS_BYTES, stream);
    if (e != hipSuccess) fprintf(stderr, "cooperative launch failed: %s (grid %d)\n", hipGetErrorString(e), grid);
#else
    for (int ph = 0; ph < NPH; ++ph) { a.ph_lo = ph; a.ph_hi = ph + 1; hipLaunchKernelGGL(fwd_kernel, dim3(grid), dim3(512), LDS_BYTES, stream, a); }
#endif
}
```

```cpp
#include <hip/hip_runtime.h>
#include <hip/hip_cooperative_groups.h>
#include <cstdio>
namespace cg = cooperative_groups;

#ifndef MK_ONE_LAUNCH
#define MK_ONE_LAUNCH 1
#endif
#ifndef PH_MASK
#define PH_MASK 0xFFF
#endif
#define PH_ON(k) ((PH_MASK >> (k)) & 1)
#ifndef DUP_MASK
#define DUP_MASK 0x0
#endif
#define NREP(k) (1 + ((DUP_MASK >> (k)) & 1))
#ifndef NAIVE_ATTN
#define NAIVE_ATTN 0
#endif

#define LAS __attribute__((address_space(3)))
typedef unsigned short bf16_t;
typedef short bf16x8 __attribute__((ext_vector_type(8)));
typedef short s16x4 __attribute__((ext_vector_type(4)));
typedef float f32x4 __attribute__((ext_vector_type(4)));
typedef float f32x2 __attribute__((ext_vector_type(2)));
typedef unsigned u32x4 __attribute__((ext_vector_type(4)));
typedef unsigned u32x2 __attribute__((ext_vector_type(2)));

constexpr int MTOK = 32768, DM = 2048, DIN = 5120, DATT = 1024, DREC = 1024, DFF = 5632, DPLE = 256, SEQ = 8192;
constexpr float EPS = 1e-6f;
constexpr int NPH = 12;
constexpr int LDS_BYTES = 147456;

constexpr size_t MiB = 1u << 20;
constexpr size_t WS_U = 0;
constexpr size_t WS_A2 = 320 * MiB;
constexpr size_t WS_ACT = 0;
constexpr size_t WS_XN = 448 * MiB;
constexpr size_t WS_Y = 576 * MiB;
constexpr size_t WS_PLE = 704 * MiB;
constexpr size_t WS_PB = 832 * MiB;
constexpr size_t WS_WIN = 848 * MiB;
constexpr size_t WS_WOUT = 868 * MiB;
constexpr size_t WS_WGU = 876 * MiB;
constexpr size_t WS_WD = 920 * MiB;
constexpr size_t WS_WPG = 942 * MiB;
constexpr size_t WS_WPP = 950 * MiB;
constexpr size_t WS_WG = 951 * MiB;
constexpr size_t WS_PART = 952 * MiB;
constexpr size_t WS_PATT = 956 * MiB;
constexpr size_t WS_PREC = 957 * MiB;
constexpr size_t WS_SUM = 958 * MiB;
constexpr size_t WS_BAR = 967 * MiB;
constexpr size_t WS_RSQ = 966 * MiB;

struct Args {
    const float* in[25];
    float* out;
    unsigned char* ws;
    int ph_lo, ph_hi;
};

__device__ __forceinline__ unsigned cvt_pk_bf16(float lo, float hi) { unsigned r; asm volatile("v_cvt_pk_bf16_f32 %0, %1, %2" : "=v"(r) : "v"(lo), "v"(hi)); return r; }
__device__ __forceinline__ float bf_lo(unsigned w) { return __uint_as_float(w << 16); }
__device__ __forceinline__ float bf_hi(unsigned w) { return __uint_as_float(w & 0xffff0000u); }
__device__ __forceinline__ float bf1(unsigned short h) { return __uint_as_float(((unsigned)h) << 16); }
__device__ __forceinline__ float wave_sum(float v) {
#pragma unroll
    for (int o = 1; o < 64; o <<= 1) v += __shfl_xor(v, o);
    return v;
}
__device__ __forceinline__ float fast_sigmoid(float x) { return __builtin_amdgcn_rcpf(1.0f + __expf(-x)); }

namespace pg8 {
constexpr int BM = 256, BK = 64, HALF = 128, HTB = HALF * BK * 2, STAGE_BYTES = 8 * HTB, NXCD = 8, WGM = 8;
__host__ __device__ __forceinline__ int lds_byte(int r, int c) { const int st = (r >> 4) * 2 + (c >> 5), rr = r & 15, cc = c & 31, ob = rr * 64 + cc * 2; return st * 1024 + (ob ^ (((ob >> 9) & 1) << 5)); }
__host__ __device__ __forceinline__ void stage_rc(int b, int& R, int& C) { const int st = b / 1024, sb = b % 1024, swz = sb ^ (((sb >> 9) & 1) << 5); R = (st >> 1) * 16 + swz / 64; C = (st & 1) * 32 + (swz % 64) / 2; }
__host__ __device__ __forceinline__ int perm32(int rho) { const int n = rho >> 4, i = rho & 15; return 8 * (i >> 2) + 4 * n + (i & 3); }
struct Unit { int pm, pn; };
struct Gemm { const bf16_t* A; const bf16_t* Bt; int M, N, K; };
struct StaticOrder {
    int nM, nN, nwg, G, c;
    __device__ void init(int M, int N, int G_, int c_) { nM = M / BM; nN = N / BM; nwg = nM * nN; G = G_; c = c_; }
    __device__ bool next(int i, Unit& u) const {
        const long L = (long)i * G + c; if (L >= nwg) return false;
        int wgid = (int)L; { const int q = nwg / NXCD, r = nwg % NXCD, xcd = wgid % NXCD, off = wgid / NXCD; wgid = (xcd < r ? xcd * (q + 1) : r * (q + 1) + (xcd - r) * q) + off; }
        const int nig = WGM * nN, gid = wgid / nig, fm = gid * WGM, gsz = (nM - fm) < WGM ? (nM - fm) : WGM;
        u.pm = fm + ((wgid % nig) % gsz); u.pn = (wgid % nig) / gsz; return true;
    }
};

struct EpiStore {
    static constexpr bool PERM = true;
    bf16_t* O; int ldc;
    __device__ __forceinline__ void operator()(const f32x4 (&acc)[2][2][4][2], const Unit& u, int wr, int wc, int fr, int fq) const {
        const int row0 = u.pm * BM + wr * 64 + fr, col0 = u.pn * BM + wc * 32 + 8 * fq;
#pragma unroll
        for (int ai = 0; ai < 2; ++ai)
#pragma unroll
            for (int m = 0; m < 4; ++m) { bf16_t* rowp = O + (size_t)(row0 + ai * HALF + m * 16) * ldc + col0;
#pragma unroll
                for (int bj = 0; bj < 2; ++bj) { const f32x4 v0 = acc[ai][bj][m][0], v1 = acc[ai][bj][m][1];
                    u32x4 w; w.x = cvt_pk_bf16(v0[0], v0[1]); w.y = cvt_pk_bf16(v0[2], v0[3]); w.z = cvt_pk_bf16(v1[0], v1[1]); w.w = cvt_pk_bf16(v1[2], v1[3]);
                    __builtin_nontemporal_store(w, (u32x4*)(rowp + bj * HALF)); } }
    }
};
struct EpiStoreSS {
    static constexpr bool PERM = true;
    bf16_t* O; int ldc; float* part;
    __device__ __forceinline__ void operator()(const f32x4 (&acc)[2][2][4][2], const Unit& u, int wr, int wc, int fr, int fq) const {
        const int row0 = u.pm * BM + wr * 64 + fr, col0 = u.pn * BM + wc * 32 + 8 * fq;
#pragma unroll
        for (int ai = 0; ai < 2; ++ai)
#pragma unroll
            for (int m = 0; m < 4; ++m) { const int row = row0 + ai * HALF + m * 16; bf16_t* rowp = O + (size_t)row * ldc + col0; float s = 0.f;
#pragma unroll
                for (int bj = 0; bj < 2; ++bj) { const f32x4 v0 = acc[ai][bj][m][0], v1 = acc[ai][bj][m][1];
                    s += (v0[0] * v0[0] + v0[1] * v0[1]) + (v0[2] * v0[2] + v0[3] * v0[3]) + (v1[0] * v1[0] + v1[1] * v1[1]) + (v1[2] * v1[2] + v1[3] * v1[3]);
                    u32x4 w; w.x = cvt_pk_bf16(v0[0], v0[1]); w.y = cvt_pk_bf16(v0[2], v0[3]); w.z = cvt_pk_bf16(v1[0], v1[1]); w.w = cvt_pk_bf16(v1[2], v1[3]);
                    *(u32x4*)(rowp + bj * HALF) = w; }
                s += __shfl_xor(s, 16); s += __shfl_xor(s, 32);
                if (fq == 0) part[(size_t)row * 32 + u.pn * 4 + wc] = s; }
    }
};
struct EpiSwiglu {
    static constexpr bool PERM = true;
    bf16_t* O; int ldc; const float* rsq;
    __device__ __forceinline__ void operator()(const f32x4 (&acc)[2][2][4][2], const Unit& u, int wr, int wc, int fr, int fq) const {
        const int row0 = u.pm * BM + wr * 64 + fr, col0 = u.pn * HALF + wc * 32 + 8 * fq;
        float rrv[2][4];
#pragma unroll
        for (int ai = 0; ai < 2; ++ai)
#pragma unroll
            for (int m = 0; m < 4; ++m) rrv[ai][m] = rsq[row0 + ai * HALF + m * 16];
#pragma unroll
        for (int ai = 0; ai < 2; ++ai)
#pragma unroll
            for (int m = 0; m < 4; ++m) { const int row = row0 + ai * HALF + m * 16; bf16_t* rowp = O + (size_t)row * ldc + col0; const float rr = rrv[ai][m];
                float v[8];
#pragma unroll
                for (int n = 0; n < 2; ++n)
#pragma unroll
                    for (int j = 0; j < 4; ++j) { const float g = acc[ai][0][m][n][j] * rr, up = acc[ai][1][m][n][j] * rr; v[n * 4 + j] = g * fast_sigmoid(g) * up; }
                u32x4 w; w.x = cvt_pk_bf16(v[0], v[1]); w.y = cvt_pk_bf16(v[2], v[3]); w.z = cvt_pk_bf16(v[4], v[5]); w.w = cvt_pk_bf16(v[6], v[7]);
                *(u32x4*)rowp = w; }
    }
};
struct EpiPleGate {
    static constexpr bool PERM = true, FUSED = false;
    bf16_t* O; int ldc; const bf16_t* ple; float* part; const float* rsq;
    __device__ __forceinline__ void operator()(const f32x4 (&acc)[2][2][4][2], const Unit& u, int wr, int wc, int fr, int fq) const {
        const int row0 = u.pm * BM + wr * 64 + fr, col0 = u.pn * BM + wc * 32 + 8 * fq;
#pragma unroll
        for (int ai = 0; ai < 2; ++ai) {
            u32x4 plv[4][2]; float rrv[4];
#pragma unroll
            for (int m = 0; m < 4; ++m) { const int row = row0 + ai * HALF + m * 16; const size_t off = (size_t)row * ldc + col0; rrv[m] = rsq[row];
#pragma unroll
                for (int bj = 0; bj < 2; ++bj) plv[m][bj] = __builtin_nontemporal_load((const u32x4*)(ple + off + bj * HALF)); }
#pragma unroll
            for (int m = 0; m < 4; ++m) { const int row = row0 + ai * HALF + m * 16; const size_t off = (size_t)row * ldc + col0; float s = 0.f; const float rr = rrv[m];
#pragma unroll
                for (int bj = 0; bj < 2; ++bj) { const u32x4 pl = plv[m][bj];
                    const f32x4 a0 = acc[ai][bj][m][0] * rr, a1 = acc[ai][bj][m][1] * rr; float v[8];
                    v[0] = fast_sigmoid(a0[0]) * bf_lo(pl.x); v[1] = fast_sigmoid(a0[1]) * bf_hi(pl.x); v[2] = fast_sigmoid(a0[2]) * bf_lo(pl.y); v[3] = fast_sigmoid(a0[3]) * bf_hi(pl.y);
                    v[4] = fast_sigmoid(a1[0]) * bf_lo(pl.z); v[5] = fast_sigmoid(a1[1]) * bf_hi(pl.z); v[6] = fast_sigmoid(a1[2]) * bf_lo(pl.w); v[7] = fast_sigmoid(a1[3]) * bf_hi(pl.w);
#pragma unroll
                    for (int j = 0; j < 8; ++j) s += v[j] * v[j];
                    u32x4 w; w.x = cvt_pk_bf16(v[0], v[1]); w.y = cvt_pk_bf16(v[2], v[3]); w.z = cvt_pk_bf16(v[4], v[5]); w.w = cvt_pk_bf16(v[6], v[7]);
                    *(u32x4*)(O + off + bj * HALF) = w; }
                s += __shfl_xor(s, 16); s += __shfl_xor(s, 32);
                if (fq == 0) part[(size_t)row * 32 + u.pn * 4 + wc] = s; }
        }
    }
};

template <class Epi, class Sched>
__device__ __forceinline__ void gemm_phase(LAS unsigned char* lds, const Gemm g, const Sched& S, const Epi& E) {
    const int tid = threadIdx.x, wid = __builtin_amdgcn_readfirstlane(tid >> 6), lane = tid & 63, wr = wid >> 2, wc = wid & 3, fr = lane & 15, fq = lane >> 4;
    const int K = g.K, nt = K / BK;
    unsigned voffA[2], voffB[2];
#pragma unroll
    for (int i = 0; i < 2; ++i) { int R, C; stage_rc(tid * 16 + i * 8192, R, C); const int Rb = Epi::PERM ? ((R & ~31) + perm32(R & 31)) : R;
        voffA[i] = (unsigned)(R * K + C) * 2u; voffB[i] = (unsigned)(Rb * K + C) * 2u; }
    const size_t kstep = (size_t)(BK * 2);
    const size_t hstep = (size_t)HALF * K * 2;
    const size_t tstep = 2 * hstep;
    const unsigned ldsw = (unsigned)wid * 1024u;
    const int aoff = lds_byte(wr * 64 + fr, fq * 8), boff = lds_byte(wc * 32 + fr, fq * 8);
#define PG8_SA(b, h) (((b) * 2 + (h)) * HTB)
#define PG8_SB(b, h) ((4 + (b) * 2 + (h)) * HTB)
#define PG8_STAGE(bufoff, gbase, voff) do { _Pragma("unroll") for (int _i = 0; _i < 2; ++_i) \
        __builtin_amdgcn_global_load_lds((const unsigned*)((const char*)(gbase) + (voff)[_i]), (LAS unsigned*)(lds + (bufoff) + ldsw + _i * 8192), 16, 0, 0); } while (0)
#define PG8_LDA(dst, b, h) do { _Pragma("unroll") for (int m = 0; m < 4; ++m) _Pragma("unroll") for (int k = 0; k < 2; ++k) dst[m][k] = *(const LAS bf16x8*)(lds + PG8_SA(b, h) + aoff + m * 2048 + k * 1024); } while (0)
#define PG8_LDB(dst, b, h) do { _Pragma("unroll") for (int n = 0; n < 2; ++n) _Pragma("unroll") for (int k = 0; k < 2; ++k) dst[n][k] = *(const LAS bf16x8*)(lds + PG8_SB(b, h) + boff + n * 2048 + k * 1024); } while (0)
#define PG8_MMA(ai, bj, At, Bt) do { __builtin_amdgcn_s_setprio(1); _Pragma("unroll") for (int m = 0; m < 4; ++m) _Pragma("unroll") for (int n = 0; n < 2; ++n) _Pragma("unroll") for (int k = 0; k < 2; ++k) \
        acc[ai][bj][m][n] = __builtin_amdgcn_mfma_f32_16x16x32_bf16(Bt[n][k], At[m][k], acc[ai][bj][m][n], 0, 0, 0); __builtin_amdgcn_s_setprio(0); } while (0)
#define PG8_WAIT_V(n) asm volatile("s_waitcnt vmcnt(" #n ")" ::: "memory")
#define PG8_WAIT_L(n) asm volatile("s_waitcnt lgkmcnt(" #n ")" ::: "memory")
#define PG8_BAR __builtin_amdgcn_s_barrier()
#define PG8_SCHED __builtin_amdgcn_sched_barrier(0)
    Unit cur, nxt; int ui = 0;
    if (!S.next(0, cur)) return;
    f32x4 acc[2][2][4][2];
#pragma unroll
    for (int a = 0; a < 2; ++a)
#pragma unroll
        for (int b = 0; b < 2; ++b)
#pragma unroll
            for (int m = 0; m < 4; ++m)
#pragma unroll
                for (int n = 0; n < 2; ++n) acc[a][b][m][n] = (f32x4){0.f, 0.f, 0.f, 0.f};
    bf16x8 At[4][2], B0[2][2], B1[2][2];
    const char* cA = (const char*)g.A + (size_t)cur.pm * tstep; const char* cB = (const char*)g.Bt + (size_t)cur.pn * tstep;
    PG8_STAGE(PG8_SB(0, 0), cB, voffB); PG8_STAGE(PG8_SA(0, 0), cA, voffA); PG8_STAGE(PG8_SB(0, 1), cB + hstep, voffB); PG8_STAGE(PG8_SA(0, 1), cA + hstep, voffA);
    if (wr == 1) PG8_BAR;
    PG8_WAIT_V(4); PG8_BAR;
    PG8_STAGE(PG8_SB(1, 0), cB + kstep, voffB); PG8_STAGE(PG8_SA(1, 0), cA + kstep, voffA); PG8_STAGE(PG8_SB(1, 1), cB + hstep + kstep, voffB);
    PG8_WAIT_V(6); PG8_BAR;
    for (;;) {
        const bool has_next = S.next(ui + 1, nxt);
        const char* nA = has_next ? (const char*)g.A + (size_t)nxt.pm * tstep : cA; const char* nB = has_next ? (const char*)g.Bt + (size_t)nxt.pn * tstep : cB;
        for (int t = 0; t < nt; t += 2) {
            const bool last = (t == nt - 2);
            const char* a1 = cA + (size_t)(t + 1) * kstep;
            const char* a2 = last ? nA : cA + (size_t)(t + 2) * kstep; const char* b2 = last ? nB : cB + (size_t)(t + 2) * kstep;
            const char* a3 = a2 + kstep; const char* b3 = b2 + kstep;
            PG8_LDB(B0, 0, 0); PG8_SCHED; PG8_LDA(At, 0, 0); PG8_STAGE(PG8_SA(1, 1), a1 + hstep, voffA);
            PG8_WAIT_L(8); PG8_BAR; PG8_WAIT_L(0); PG8_MMA(0, 0, At, B0); PG8_BAR; PG8_SCHED;
            PG8_LDB(B1, 0, 1); PG8_STAGE(PG8_SB(0, 0), b2, voffB);
            PG8_BAR; PG8_WAIT_L(0); PG8_MMA(0, 1, At, B1); PG8_BAR;
            PG8_LDA(At, 0, 1); PG8_STAGE(PG8_SA(0, 0), a2, voffA);
            PG8_BAR; PG8_WAIT_L(0); PG8_MMA(1, 0, At, B0); PG8_BAR; PG8_SCHED;
            PG8_STAGE(PG8_SB(0, 1), b2 + hstep, voffB);
            PG8_WAIT_V(6); PG8_BAR; PG8_MMA(1, 1, At, B1); PG8_BAR;
            PG8_LDB(B0, 1, 0); PG8_SCHED; PG8_LDA(At, 1, 0); PG8_STAGE(PG8_SA(0, 1), a2 + hstep, voffA);
            PG8_WAIT_L(8); PG8_BAR; PG8_WAIT_L(0); PG8_MMA(0, 0, At, B0); PG8_BAR; PG8_SCHED;
            PG8_LDB(B1, 1, 1); PG8_STAGE(PG8_SB(1, 0), b3, voffB);
            PG8_BAR; PG8_WAIT_L(0); PG8_MMA(0, 1, At, B1); PG8_BAR;
            PG8_LDA(At, 1, 1); PG8_STAGE(PG8_SA(1, 0), a3, voffA);
            PG8_BAR; PG8_WAIT_L(0); PG8_MMA(1, 0, At, B0); PG8_BAR; PG8_SCHED;
            PG8_STAGE(PG8_SB(1, 1), b3 + hstep, voffB);
            PG8_WAIT_V(6); PG8_BAR; PG8_MMA(1, 1, At, B1); PG8_BAR;
        }
        E(acc, cur, wr, wc, fr, fq);
        if (!has_next) break;
#pragma unroll
        for (int a = 0; a < 2; ++a)
#pragma unroll
            for (int b = 0; b < 2; ++b)
#pragma unroll
                for (int m = 0; m < 4; ++m)
#pragma unroll
                    for (int n = 0; n < 2; ++n) acc[a][b][m][n] = (f32x4){0.f, 0.f, 0.f, 0.f};
        cur = nxt; cA = nA; cB = nB; ++ui;
    }
    PG8_WAIT_V(0);
    if (wr == 0) PG8_BAR;
    PG8_BAR;
#undef PG8_SA
#undef PG8_SB
#undef PG8_STAGE
#undef PG8_LDA
#undef PG8_LDB
#undef PG8_MMA
#undef PG8_WAIT_V
#undef PG8_WAIT_L
#undef PG8_BAR
#undef PG8_SCHED
}
}

__device__ __forceinline__ void p0_transpose_item(const float* W, int N, bf16_t* WT, int ldk, int k0, int n0, long dst_row0, LAS float* scr, int lane, const float* gk = nullptr) {
    float wv[32];
#pragma unroll
    for (int i = 0; i < 32; ++i) { const int kk = 2 * i + (lane >> 5); wv[i] = __builtin_nontemporal_load(W + (size_t)(k0 + kk) * N + n0 + (lane & 31)); }
#pragma unroll
    for (int i = 0; i < 32; ++i) { const int kk = 2 * i + (lane >> 5); scr[kk * 33 + (lane & 31)] = wv[i] * (gk ? gk[k0 + kk] : 1.0f); }
    if (false)
    for (int i = 0; i < 32; ++i) { const int kk = 2 * i + (lane >> 5); scr[kk * 33 + (lane & 31)] = __builtin_nontemporal_load(W + (size_t)(k0 + kk) * N + n0 + (lane & 31)) * (gk ? gk[k0 + kk] : 1.0f); }
    asm volatile("s_waitcnt lgkmcnt(0)" ::: "memory");
    const int c = lane & 7;
#pragma unroll
    for (int j = 0; j < 4; ++j) { const int n = (lane >> 3) + 8 * j; const LAS float* s = scr + (8 * c) * 33 + n;
        u32x4 o; o.x = cvt_pk_bf16(s[0 * 33], s[1 * 33]); o.y = cvt_pk_bf16(s[2 * 33], s[3 * 33]); o.z = cvt_pk_bf16(s[4 * 33], s[5 * 33]); o.w = cvt_pk_bf16(s[6 * 33], s[7 * 33]);
        *(u32x4*)(WT + (size_t)(dst_row0 + n) * ldk + k0 + 8 * c) = o; }
    asm volatile("s_waitcnt lgkmcnt(0)" ::: "memory");
}

__device__ __forceinline__ void weight_items(const Args& a, LAS unsigned char* lds, int wid, int lane, int it_lo, int it_hi, int first, int step) {
    unsigned char* ws = a.ws;
    LAS float* scr = (LAS float*)(lds + wid * 16384);
    constexpr int I_IN = 32 * 160, I_OUT = 32 * 64, I_G = 32 * 176, I_U = I_G, I_D = 88 * 64, I_PG = 32 * 64, I_PP = 4 * 64, I_RG = 32 * 8;
    constexpr int NITEMS = I_IN + I_OUT + I_G + I_U + I_D + I_PG + I_PP + I_RG;
    for (int it = it_lo + first; it < it_hi; it += step) {
        int r = it;
        if (r < I_IN) { const int kb = r / 160, nb = r % 160; p0_transpose_item(a.in[3], DIN, (bf16_t*)(ws + WS_WIN), DM, kb * 64, nb * 32, nb * 32, scr, lane); continue; } r -= I_IN;
        if (r < I_OUT) { const int kb = r / 64, nb = r % 64; p0_transpose_item(a.in[14], DM, (bf16_t*)(ws + WS_WOUT), DM, kb * 64, nb * 32, nb * 32, scr, lane); continue; } r -= I_OUT;
        if (r < I_G) { const int kb = r / 176, nb = r % 176, n0 = nb * 32; p0_transpose_item(a.in[17], DFF, (bf16_t*)(ws + WS_WGU), DM, kb * 64, n0, (n0 >> 7) * 256 + (n0 & 127), scr, lane, a.in[16]); continue; } r -= I_G;
        if (r < I_U) { const int kb = r / 176, nb = r % 176, n0 = nb * 32; p0_transpose_item(a.in[18], DFF, (bf16_t*)(ws + WS_WGU), DM, kb * 64, n0, (n0 >> 7) * 256 + 128 + (n0 & 127), scr, lane, a.in[16]); continue; } r -= I_U;
        if (r < I_D) { const int kb = r / 64, nb = r % 64; p0_transpose_item(a.in[19], DM, (bf16_t*)(ws + WS_WD), DFF, kb * 64, nb * 32, nb * 32, scr, lane); continue; } r -= I_D;
        if (r < I_PG) { const int kb = r / 64, nb = r % 64; p0_transpose_item(a.in[22], DM, (bf16_t*)(ws + WS_WPG), DM, kb * 64, nb * 32, nb * 32, scr, lane, a.in[21]); continue; } r -= I_PG;
        if (r < I_PP) { const int kb = r / 64, nb = r % 64; p0_transpose_item(a.in[23], DM, (bf16_t*)(ws + WS_WPP), DPLE, kb * 64, nb * 32, nb * 32, scr, lane); continue; } r -= I_PP;
        { const int mat = r >> 3, sub = r & 7, kb = sub >> 2, nb = sub & 3; const int zn = mat & 15, z = zn >> 3, n = zn & 7, ty = (mat >> 4) * 2 + z;
          const float* src = (mat < 16 ? a.in[7] : a.in[9]) + (size_t)zn * 16384;
          p0_transpose_item(src, 128, (bf16_t*)(ws + WS_WG), 128, kb * 64, nb * 32, n * 512 + ty * 128 + nb * 32, scr, lane); }
    }
}

__device__ __forceinline__ void p0_phase(const Args& a, LAS unsigned char* lds, int tid, int wid, int lane) {
    unsigned char* ws = a.ws;
    LAS float* scr = (LAS float*)(lds + wid * 16384);
    const int gw = blockIdx.x * 8 + wid, NGW = gridDim.x * 8;
    constexpr int I_IN = 32 * 160, I_LATE = 32 * 64 + 3 * (32 * 176) + 32 * 64, I_TAIL = 4 * 64 + 32 * 8;
    if (gridDim.x == 256) { weight_items(a, lds, wid, lane, 0, I_IN, gw, NGW); weight_items(a, lds, wid, lane, I_IN + I_LATE, I_IN + I_LATE + I_TAIL, gw, NGW); }
    else weight_items(a, lds, wid, lane, 0, I_IN + I_LATE + I_TAIL, gw, NGW);
    if (blockIdx.x == 0) { unsigned* bz = (unsigned*)(ws + WS_BAR); for (int i = tid; i < 3456; i += 512) __hip_atomic_store(bz + i, 0u, __ATOMIC_RELAXED, __HIP_MEMORY_SCOPE_AGENT); }
    const float* x = a.in[0]; const float* g = a.in[2]; bf16_t* XN = (bf16_t*)(ws + WS_XN);
    for (int m = gw; m < MTOK; m += NGW) {
        const f32x4* xr = (const f32x4*)(x + (size_t)m * DM);
        f32x4 v[8]; float s = 0.f;
#pragma unroll
        for (int j = 0; j < 8; ++j) { v[j] = __builtin_nontemporal_load(xr + j * 64 + lane); s += (v[j].x * v[j].x + v[j].y * v[j].y) + (v[j].z * v[j].z + v[j].w * v[j].w); }
        const float rs = rsqrtf(wave_sum(s) * (1.f / DM) + EPS);
        u32x2* o = (u32x2*)(XN + (size_t)m * DM);
#pragma unroll
        for (int j = 0; j < 8; ++j) { const f32x4 gv = ((const f32x4*)g)[j * 64 + lane]; u32x2 w; w.x = cvt_pk_bf16(v[j].x * rs * gv.x, v[j].y * rs * gv.y); w.y = cvt_pk_bf16(v[j].z * rs * gv.z, v[j].w * rs * gv.w); o[j * 64 + lane] = w; }
    }
    const f32x4* p4 = (const f32x4*)a.in[1]; u32x2* pb = (u32x2*)(ws + WS_PB);
    {
        const size_t tot = (size_t)MTOK * DPLE / 4, strd = (size_t)gridDim.x * 512;
        for (size_t i0 = (size_t)blockIdx.x * 512 + tid; i0 < tot; i0 += 8 * strd) { f32x4 v[8];
#pragma unroll
            for (int k = 0; k < 8; ++k) { const size_t i = i0 + k * strd; v[k] = (i < tot) ? __builtin_nontemporal_load(p4 + i) : (f32x4){0.f, 0.f, 0.f, 0.f}; }
#pragma unroll
            for (int k = 0; k < 8; ++k) { const size_t i = i0 + k * strd; if (i < tot) { u32x2 w; w.x = cvt_pk_bf16(v[k].x, v[k].y); w.y = cvt_pk_bf16(v[k].z, v[k].w); pb[i] = w; } } }
    }
}

__device__ __forceinline__ void attn_phase(const Args& a, LAS unsigned char* lds, int tid, int wid, int lane, int it_base, int it_step, int it_n, int hi_begin, int hi_end) {
    const bf16_t* U = (const bf16_t*)(a.ws + WS_U); bf16_t* A2 = (bf16_t*)(a.ws + WS_A2); float* patt = (float*)(a.ws + WS_PATT);
    LAS float* rp = (LAS float*)(lds + 65536);
    for (int i = tid; i < 8 * 15 * 31; i += 512) rp[i] = a.in[4][i];
    __syncthreads();
    const int qb = wid & 3, hh = wid >> 2, l15_0 = lane & 15, lq_0 = lane >> 4;
    int l15 = l15_0, lq = lq_0;
    const unsigned vbase = (unsigned)wid * 8192u;
    const unsigned traddr = vbase + (unsigned)((4 * lq + (l15 >> 2)) * 256 + (4 * (lane & 3)) * 2);
    const float LOG2E = 1.4426950408889634f, SC = 0.08838834764831845f * 1.4426950408889634f;
    for (int ii = 0; ii < it_n; ++ii) {
        const int it = it_base + ii * it_step;
        const int b = it >> 7, r = it & 127;
        const int rstart = min(max(r - 4, 0), 120);
        const int kc0 = min(max(16 * qb - 8, 0), 32);
        const int qcol = 16 * qb + l15, cstart = min(max(qcol - 8, 0), 48);
        const size_t tokq = (size_t)b * SEQ + r * 64 + qcol;
        for (int hi = hi_begin; hi < hi_end; ++hi) {
            l15 = l15_0; lq = lq_0; asm volatile("" : "+v"(l15), "+v"(lq));
            const int h = 2 * hi + hh;
            bf16x8 qf[4]; { const bf16_t* qp = U + tokq * DIN + h * 128 + lq * 8;
#pragma unroll
                for (int ks = 0; ks < 4; ++ks) qf[ks] = *(const bf16x8*)(qp + ks * 32); }
            f32x4 sT[16];
            bf16x8 kf[3][2][4];
#define LOADK(buf, Tg_) do { _Pragma("unroll") for (int tt = 0; tt < 2; ++tt) { const int T = (Tg_) * 2 + tt; \
                const bf16_t* kp = U + ((size_t)b * SEQ + (rstart + (T >> 1)) * 64 + kc0 + 16 * (T & 1) + l15) * DIN + 1024 + h * 128 + lq * 8; \
                _Pragma("unroll") for (int ks = 0; ks < 4; ++ks) kf[buf][tt][ks] = *(const bf16x8*)(kp + ks * 32); } } while (0)
            LOADK(0, 0); LOADK(1, 1);
#pragma unroll
            for (int Tg = 0; Tg < 8; ++Tg) {
                if (Tg < 6) LOADK((Tg + 2) % 3, Tg + 2);
                __builtin_amdgcn_sched_barrier(0);
#pragma unroll
                for (int tt = 0; tt < 2; ++tt) { f32x4 s_ = (f32x4){0.f, 0.f, 0.f, 0.f};
#pragma unroll
                    for (int ks = 0; ks < 4; ++ks) s_ = __builtin_amdgcn_mfma_f32_16x16x32_bf16(kf[Tg % 3][tt][ks], qf[ks], s_, 0, 0, 0);
                    sT[Tg * 2 + tt] = s_; }
                __builtin_amdgcn_sched_barrier(0);
            }
#undef LOADK
            float mx = -1e30f;
#pragma unroll
            for (int T = 0; T < 16; ++T) {
                const int dr = rstart + (T >> 1) - r + 7;
#pragma unroll
                for (int j = 0; j < 4; ++j) {
                    const int kc = kc0 + 16 * (T & 1) + 4 * lq + j; const bool valid = (kc >= cstart) && (kc < cstart + 16);
                    const int dc = min(max(kc - qcol + 15, 0), 30);
                    const float bias = rp[(h * 15 + dr) * 31 + dc];
                    const float t = valid ? (sT[T][j] * SC + bias * LOG2E) : -1e30f;
                    sT[T][j] = t; mx = fmaxf(mx, t);
                }
            }
            mx = fmaxf(mx, __shfl_xor(mx, 16)); mx = fmaxf(mx, __shfl_xor(mx, 32));
            float sum = 0.f;
#pragma unroll
            for (int T = 0; T < 16; ++T)
#pragma unroll
                for (int j = 0; j < 4; ++j) { const float p = __builtin_amdgcn_exp2f(sT[T][j] - mx); sT[T][j] = p; sum += p; }
            sum += __shfl_xor(sum, 16); sum += __shfl_xor(sum, 32);
            union PF { u32x4 u; bf16x8 v; }; PF pf[8];
#pragma unroll
            for (int kr = 0; kr < 8; ++kr) {
                pf[kr].u.x = cvt_pk_bf16(sT[2 * kr][0], sT[2 * kr][1]); pf[kr].u.y = cvt_pk_bf16(sT[2 * kr][2], sT[2 * kr][3]);
                pf[kr].u.z = cvt_pk_bf16(sT[2 * kr + 1][0], sT[2 * kr + 1][1]); pf[kr].u.w = cvt_pk_bf16(sT[2 * kr + 1][2], sT[2 * kr + 1][3]); }
            f32x4 oT[8];
#pragma unroll
            for (int dt = 0; dt < 8; ++dt) oT[dt] = (f32x4){0.f, 0.f, 0.f, 0.f};
            u32x4 vst[3][8];
#define LOADV(buf, kr_) do { const bf16_t* vp = U + ((size_t)b * SEQ + (rstart + (kr_)) * 64 + kc0) * DIN + 2048 + h * 128; \
                _Pragma("unroll") for (int jj = 0; jj < 8; ++jj) { const int c = jj * 64 + lane; vst[buf][jj] = *(const u32x4*)(vp + (size_t)(c >> 4) * DIN + (c & 15) * 8); } } while (0)
            LOADV(0, 0); LOADV(1, 1);
#pragma unroll
            for (int kr = 0; kr < 8; ++kr) {
#pragma unroll
                for (int jj = 0; jj < 8; ++jj) { const int c = jj * 64 + lane; *(LAS u32x4*)(lds + vbase + (c >> 4) * 256 + (c & 15) * 16) = vst[kr % 3][jj]; }
                if (kr < 6) { __builtin_amdgcn_sched_barrier(0); LOADV((kr + 2) % 3, kr + 2); __builtin_amdgcn_sched_barrier(0); }
                s16x4 t0, t1, t2, t3, t4, t5, t6, t7, t8, t9, t10, t11, t12, t13, t14, t15;
                asm volatile("s_waitcnt lgkmcnt(0)\n\t"
                             "ds_read_b64_tr_b16 %0, %16 offset:0\n\t"   "ds_read_b64_tr_b16 %1, %16 offset:4096\n\t"
                             "ds_read_b64_tr_b16 %2, %16 offset:32\n\t"  "ds_read_b64_tr_b16 %3, %16 offset:4128\n\t"
                             "ds_read_b64_tr_b16 %4, %16 offset:64\n\t"  "ds_read_b64_tr_b16 %5, %16 offset:4160\n\t"
                             "ds_read_b64_tr_b16 %6, %16 offset:96\n\t"  "ds_read_b64_tr_b16 %7, %16 offset:4192\n\t"
                             "ds_read_b64_tr_b16 %8, %16 offset:128\n\t" "ds_read_b64_tr_b16 %9, %16 offset:4224\n\t"
                             "ds_read_b64_tr_b16 %10, %16 offset:160\n\t" "ds_read_b64_tr_b16 %11, %16 offset:4256\n\t"
                             "ds_read_b64_tr_b16 %12, %16 offset:192\n\t" "ds_read_b64_tr_b16 %13, %16 offset:4288\n\t"
                             "ds_read_b64_tr_b16 %14, %16 offset:224\n\t" "ds_read_b64_tr_b16 %15, %16 offset:4320\n\t"
                             "s_waitcnt lgkmcnt(0)"
                             : "=&v"(t0), "=&v"(t1), "=&v"(t2), "=&v"(t3), "=&v"(t4), "=&v"(t5), "=&v"(t6), "=&v"(t7),
                               "=&v"(t8), "=&v"(t9), "=&v"(t10), "=&v"(t11), "=&v"(t12), "=&v"(t13), "=&v"(t14), "=&v"(t15)
                             : "v"(traddr) : "memory");
#define PV_MMA(dt, lo, hi) { bf16x8 vf; vf[0] = lo[0]; vf[1] = lo[1]; vf[2] = lo[2]; vf[3] = lo[3]; vf[4] = hi[0]; vf[5] = hi[1]; vf[6] = hi[2]; vf[7] = hi[3]; \
                    oT[dt] = __builtin_amdgcn_mfma_f32_16x16x32_bf16(vf, pf[kr].v, oT[dt], 0, 0, 0); }
                PV_MMA(0, t0, t1) PV_MMA(1, t2, t3) PV_MMA(2, t4, t5) PV_MMA(3, t6, t7) PV_MMA(4, t8, t9) PV_MMA(5, t10, t11) PV_MMA(6, t12, t13) PV_MMA(7, t14, t15)
#undef PV_MMA
            }
#undef LOADV
            const float inv = 1.0f / sum; float ss = 0.f;
            bf16_t* op = A2 + tokq * DM + h * 128 + 4 * lq;
#pragma unroll
            for (int dt = 0; dt < 8; ++dt) { const f32x4 o = oT[dt] * inv; ss += (o[0] * o[0] + o[1] * o[1]) + (o[2] * o[2] + o[3] * o[3]);
                u32x2 w; w.x = cvt_pk_bf16(o[0], o[1]); w.y = cvt_pk_bf16(o[2], o[3]); *(u32x2*)(op + 16 * dt) = w; }
            ss += __shfl_xor(ss, 16); ss += __shfl_xor(ss, 32);
            if (lq == 0) patt[tokq * 8 + h] = ss;
        }
    }
    __syncthreads();
}

__device__ __forceinline__ void attn2_phase(const Args& a, LAS unsigned char* lds, int tid, int wid, int lane, int it_base, int it_step, int it_n, int hi_begin, int hi_end) {
    const bf16_t* U = (const bf16_t*)(a.ws + WS_U); bf16_t* A2 = (bf16_t*)(a.ws + WS_A2); float* patt = (float*)(a.ws + WS_PATT);
    constexpr int SLAB = 2 * 64 * 272, RPB_OFF = 2 * SLAB;
    LAS float* rp = (LAS float*)(lds + RPB_OFF);
    for (int i = tid; i < 8 * 15 * 31; i += 512) rp[i] = a.in[4][i];
    __syncthreads();
    const int qb = wid & 3, hh = wid >> 2, l15_0 = lane & 15, lq_0 = lane >> 4;
    const int s_h = tid >> 8, s_col = (tid >> 2) & 63, s_q = tid & 3;
    const unsigned s_lds = (unsigned)(s_h * (64 * 272) + s_col * 272 + s_q * 64);
    const float LOG2E = 1.4426950408889634f, SC = 0.08838834764831845f * 1.4426950408889634f;
    for (int ii = 0; ii < it_n; ++ii) {
        const int it = it_base + ii * it_step;
        const int b = it >> 7, r = it & 127;
        const int rstart = min(max(r - 4, 0), 120);
        const int kc0 = min(max(16 * qb - 8, 0), 32);
        for (int hi = hi_begin; hi < hi_end; ++hi) {
            int l15 = l15_0, lq = lq_0; asm volatile("" : "+v"(l15), "+v"(lq));
            const int qcol = 16 * qb + l15, cstart = min(max(qcol - 8, 0), 48);
            const size_t tokq = (size_t)b * SEQ + r * 64 + qcol;
            const int h = 2 * hi + hh;
            bf16x8 qf[4]; { const bf16_t* qp = U + tokq * DIN + h * 128 + lq * 8;
#pragma unroll
                for (int ks = 0; ks < 4; ++ks) qf[ks] = *(const bf16x8*)(qp + ks * 32); }
            const bf16_t* sbase = U + ((size_t)b * SEQ + rstart * 64 + s_col) * DIN + 1024 + (2 * hi + s_h) * 128 + s_q * 32;
            u32x4 st[2][4];
#define LOADS(set, j_) do { const bf16_t* sp = sbase + (size_t)((j_) & 7) * 64 * DIN + ((j_) >> 3) * 1024; \
                _Pragma("unroll") for (int e = 0; e < 4; ++e) st[set][e] = *(const u32x4*)(sp + e * 8); } while (0)
#define WRITES(set, buf) do { _Pragma("unroll") for (int e = 0; e < 4; ++e) *(LAS u32x4*)(lds + (buf) * SLAB + s_lds + e * 16) = st[set][e]; } while (0)
            LOADS(0, 0); LOADS(1, 1);
            __syncthreads();
            WRITES(0, 0); LOADS(0, 2);
            f32x4 sT[16]; f32x4 oT[8]; union PF { u32x4 u; bf16x8 v; }; PF pf[8]; float sum = 0.f;
#pragma unroll
            for (int dt = 0; dt < 8; ++dt) oT[dt] = (f32x4){0.f, 0.f, 0.f, 0.f};
#pragma clang loop unroll(full)
            for (int j = 0; j < 16; ++j) {
                __syncthreads();
                if (j == 8) {
                    float mx = -1e30f;
#pragma unroll
                    for (int T = 0; T < 16; ++T) { const int dr = rstart + (T >> 1) - r + 7;
#pragma unroll
                        for (int jj = 0; jj < 4; ++jj) { const int kc = kc0 + 16 * (T & 1) + 4 * lq + jj; const bool valid = (kc >= cstart) && (kc < cstart + 16);
                            const int dc = min(max(kc - qcol + 15, 0), 30); const float bias = rp[(h * 15 + dr) * 31 + dc];
                            const float t = valid ? (sT[T][jj] * SC + bias * LOG2E) : -1e30f; sT[T][jj] = t; mx = fmaxf(mx, t); } }
                    mx = fmaxf(mx, __shfl_xor(mx, 16)); mx = fmaxf(mx, __shfl_xor(mx, 32));
#pragma unroll
                    for (int T = 0; T < 16; ++T)
#pragma unroll
                        for (int jj = 0; jj < 4; ++jj) { const float p = __builtin_amdgcn_exp2f(sT[T][jj] - mx); sT[T][jj] = p; sum += p; }
                    sum += __shfl_xor(sum, 16); sum += __shfl_xor(sum, 32);
#pragma unroll
                    for (int kr = 0; kr < 8; ++kr) {
                        pf[kr].u.x = cvt_pk_bf16(sT[2 * kr][0], sT[2 * kr][1]); pf[kr].u.y = cvt_pk_bf16(sT[2 * kr][2], sT[2 * kr][3]);
                        pf[kr].u.z = cvt_pk_bf16(sT[2 * kr + 1][0], sT[2 * kr + 1][1]); pf[kr].u.w = cvt_pk_bf16(sT[2 * kr + 1][2], sT[2 * kr + 1][3]); }
                }
                if (j < 8) {
#pragma unroll
                    for (int tt = 0; tt < 2; ++tt) { f32x4 s_ = (f32x4){0.f, 0.f, 0.f, 0.f};
#pragma unroll
                        for (int ks = 0; ks < 4; ++ks) { const bf16x8 kfr = *(const LAS bf16x8*)(lds + (j & 1) * SLAB + hh * (64 * 272) + (kc0 + 16 * tt + l15) * 272 + (ks * 32 + lq * 8) * 2);
                            s_ = __builtin_amdgcn_mfma_f32_16x16x32_bf16(kfr, qf[ks], s_, 0, 0, 0); }
                        sT[j * 2 + tt] = s_; }
                } else {
                    const unsigned traddr = (unsigned)((j & 1) * SLAB + hh * (64 * 272) + (kc0 + 4 * lq + (l15 >> 2)) * 272 + (4 * (lane & 3)) * 2);
                    s16x4 t0, t1, t2, t3, t4, t5, t6, t7, t8, t9, t10, t11, t12, t13, t14, t15;
                    asm volatile("s_waitcnt lgkmcnt(0)\n\t"
                                 "ds_read_b64_tr_b16 %0, %16 offset:0\n\t"   "ds_read_b64_tr_b16 %1, %16 offset:4352\n\t"
                                 "ds_read_b64_tr_b16 %2, %16 offset:32\n\t"  "ds_read_b64_tr_b16 %3, %16 offset:4384\n\t"
                                 "ds_read_b64_tr_b16 %4, %16 offset:64\n\t"  "ds_read_b64_tr_b16 %5, %16 offset:4416\n\t"
                                 "ds_read_b64_tr_b16 %6, %16 offset:96\n\t"  "ds_read_b64_tr_b16 %7, %16 offset:4448\n\t"
                                 "ds_read_b64_tr_b16 %8, %16 offset:128\n\t" "ds_read_b64_tr_b16 %9, %16 offset:4480\n\t"
                                 "ds_read_b64_tr_b16 %10, %16 offset:160\n\t" "ds_read_b64_tr_b16 %11, %16 offset:4512\n\t"
                                 "ds_read_b64_tr_b16 %12, %16 offset:192\n\t" "ds_read_b64_tr_b16 %13, %16 offset:4544\n\t"
                                 "ds_read_b64_tr_b16 %14, %16 offset:224\n\t" "ds_read_b64_tr_b16 %15, %16 offset:4576\n\t"
                                 "s_waitcnt lgkmcnt(0)"
                                 : "=&v"(t0), "=&v"(t1), "=&v"(t2), "=&v"(t3), "=&v"(t4), "=&v"(t5), "=&v"(t6), "=&v"(t7),
                                   "=&v"(t8), "=&v"(t9), "=&v"(t10), "=&v"(t11), "=&v"(t12), "=&v"(t13), "=&v"(t14), "=&v"(t15)
                                 : "v"(traddr) : "memory");
#define PV_MMA(dt, lo, hi_) { bf16x8 vf; vf[0] = lo[0]; vf[1] = lo[1]; vf[2] = lo[2]; vf[3] = lo[3]; vf[4] = hi_[0]; vf[5] = hi_[1]; vf[6] = hi_[2]; vf[7] = hi_[3]; \
                        oT[dt] = __builtin_amdgcn_mfma_f32_16x16x32_bf16(vf, pf[j - 8].v, oT[dt], 0, 0, 0); }
                    PV_MMA(0, t0, t1) PV_MMA(1, t2, t3) PV_MMA(2, t4, t5) PV_MMA(3, t6, t7) PV_MMA(4, t8, t9) PV_MMA(5, t10, t11) PV_MMA(6, t12, t13) PV_MMA(7, t14, t15)
#undef PV_MMA
                }
                if (j < 15) { WRITES((j + 1) & 1, (j + 1) & 1); if (j < 13) LOADS((j + 1) & 1, j + 3); }
            }
#undef LOADS
#undef WRITES
            const float inv = 1.0f / sum; float ss = 0.f;
            bf16_t* op = A2 + tokq * DM + h * 128 + 4 * lq;
#pragma unroll
            for (int dt = 0; dt < 8; ++dt) { const f32x4 o = oT[dt] * inv; ss += (o[0] * o[0] + o[1] * o[1]) + (o[2] * o[2] + o[3] * o[3]);
                u32x2 w; w.x = cvt_pk_bf16(o[0], o[1]); w.y = cvt_pk_bf16(o[2], o[3]); *(u32x2*)(op + 16 * dt) = w; }
            ss += __shfl_xor(ss, 16); ss += __shfl_xor(ss, 32);
            if (lq == 0) patt[tokq * 8 + h] = ss;
        }
    }
    __syncthreads();
}

__device__ __forceinline__ void attn_phase_naive(const Args& a, int wid, int lane) {
    const bf16_t* U = (const bf16_t*)(a.ws + WS_U); bf16_t* A2 = (bf16_t*)(a.ws + WS_A2); float* patt = (float*)(a.ws + WS_PATT);
    const float* rpb = a.in[4];
    const int gw = blockIdx.x * 8 + wid, NGW = gridDim.x * 8;
    for (int wi = gw; wi < MTOK * 8; wi += NGW) {
        const int h = wi & 7, tok = wi >> 3, b = tok >> 13, s = tok & 8191, r = s >> 6, qcol = s & 63;
        const int rstart = min(max(r - 4, 0), 120), cstart = min(max(qcol - 8, 0), 48);
        const unsigned qw = *(const unsigned*)(U + (size_t)tok * DIN + h * 128 + 2 * lane);
        const float q0 = bf_lo(qw) * 0.08838834764831845f, q1 = bf_hi(qw) * 0.08838834764831845f;
        float mx = -1e30f, l = 0.f, o0 = 0.f, o1 = 0.f;
        for (int kr = 0; kr < 8; ++kr)
            for (int kc = 0; kc < 16; ++kc) {
                const size_t kt = (size_t)b * SEQ + (rstart + kr) * 64 + cstart + kc;
                const unsigned kw = *(const unsigned*)(U + kt * DIN + 1024 + h * 128 + 2 * lane);
                const unsigned vw = *(const unsigned*)(U + kt * DIN + 2048 + h * 128 + 2 * lane);
                float d = wave_sum(q0 * bf_lo(kw) + q1 * bf_hi(kw));
                d += rpb[(h * 15 + (rstart + kr - r + 7)) * 31 + (cstart + kc - qcol + 15)];
                const float nm = fmaxf(mx, d), sc = __expf(mx - nm), p = __expf(d - nm);
                l = l * sc + p; o0 = o0 * sc + p * bf_lo(vw); o1 = o1 * sc + p * bf_hi(vw); mx = nm;
            }
        o0 /= l; o1 /= l;
        *(unsigned*)(A2 + (size_t)tok * DM + h * 128 + 2 * lane) = cvt_pk_bf16(o0, o1);
        const float ss = wave_sum(o0 * o0 + o1 * o1);
        if (lane == 0) patt[(size_t)tok * 8 + h] = ss;
    }
}

template <bool FINAL>
__device__ __forceinline__ void rglru_phase(const Args& a, LAS unsigned char* lds, int tid, int wid, int lane) {
    const bf16_t* U = (const bf16_t*)(a.ws + WS_U); bf16_t* A2 = (bf16_t*)(a.ws + WS_A2); float* prec = (float*)(a.ws + WS_PREC);
    float* sumr = (float*)(a.ws + WS_SUM); const bf16_t* WG = (const bf16_t*)(a.ws + WS_WG);
    const float* conv_w = a.in[5]; const float* conv_b = a.in[6]; const float* b_a = a.in[8]; const float* b_i = a.in[10]; const float* lam = a.in[11];
    constexpr int XC_OFF = 0, YG_OFF = 34816, REC_OFF = 69632, RS = 272;
    const int cgp0 = tid & 15, tq0 = tid >> 4, l150 = lane & 15, lq0 = lane >> 4;
    for (int it = blockIdx.x; it < 2048; it += gridDim.x) {
        int cgp = cgp0, tq = tq0, l15 = l150, lq = lq0;
        asm volatile("" : "+v"(cgp), "+v"(tq), "+v"(l15), "+v"(lq));
        const int n = it & 7, c = (it >> 3) & 63, b = it >> 9, t0 = c * 128;
        {
            const int chb = n * 128 + cgp * 8;
            float xin[7][8];
#pragma unroll
            for (int rr = 0; rr < 7; ++rr) { const int ts = t0 + 4 * tq - 2 + rr;
                u32x4 v = (u32x4){0u, 0u, 0u, 0u};
                if (ts >= 0 && ts < SEQ) v = *(const u32x4*)(U + ((size_t)b * SEQ + ts) * DIN + 3072 + chb);
                xin[rr][0] = bf_lo(v.x); xin[rr][1] = bf_hi(v.x); xin[rr][2] = bf_lo(v.y); xin[rr][3] = bf_hi(v.y); xin[rr][4] = bf_lo(v.z); xin[rr][5] = bf_hi(v.z); xin[rr][6] = bf_lo(v.w); xin[rr][7] = bf_hi(v.w); }
            float cw[4][8], cb[8];
#pragma unroll
            for (int j = 0; j < 4; ++j) { const f32x4 w0 = *(const f32x4*)(conv_w + j * DREC + chb), w1 = *(const f32x4*)(conv_w + j * DREC + chb + 4);
                cw[j][0] = w0.x; cw[j][1] = w0.y; cw[j][2] = w0.z; cw[j][3] = w0.w; cw[j][4] = w1.x; cw[j][5] = w1.y; cw[j][6] = w1.z; cw[j][7] = w1.w; }
            { const f32x4 w0 = *(const f32x4*)(conv_b + chb), w1 = *(const f32x4*)(conv_b + chb + 4); cb[0] = w0.x; cb[1] = w0.y; cb[2] = w0.z; cb[3] = w0.w; cb[4] = w1.x; cb[5] = w1.y; cb[6] = w1.z; cb[7] = w1.w; }
#pragma unroll
            for (int i = 0; i < 4; ++i) { float o[8];
#pragma unroll
                for (int e = 0; e < 8; ++e) o[e] = cb[e] + cw[0][e] * xin[i][e] + cw[1][e] * xin[i + 1][e] + cw[2][e] * xin[i + 2][e] + cw[3][e] * xin[i + 3][e];
                u32x4 w; w.x = cvt_pk_bf16(o[0], o[1]); w.y = cvt_pk_bf16(o[2], o[3]); w.z = cvt_pk_bf16(o[4], o[5]); w.w = cvt_pk_bf16(o[6], o[7]);
                *(LAS u32x4*)(lds + XC_OFF + (4 * tq + i) * RS + cgp * 16) = w; }
            if (FINAL) {
#pragma unroll
                for (int i = 0; i < 4; ++i) { const u32x4 v = *(const u32x4*)(U + ((size_t)b * SEQ + t0 + 4 * tq + i) * DIN + 4096 + chb); *(LAS u32x4*)(lds + YG_OFF + (4 * tq + i) * RS + cgp * 16) = v; }
            }
        }
        __syncthreads();
        const int chl = 16 * wid + l15, gch = n * 128 + chl;
        float cend[2], ptot[2];
        f32x4 hs[8];
#pragma unroll
        for (int dir = 0; dir < 2; ++dir) {
            f32x4 acc[2][8];
#pragma unroll
            for (int ty = 0; ty < 2; ++ty)
#pragma unroll
                for (int mt = 0; mt < 8; ++mt) acc[ty][mt] = (f32x4){0.f, 0.f, 0.f, 0.f};
#pragma unroll
            for (int ks = 0; ks < 4; ++ks) {
                bf16x8 af[8];
#pragma unroll
                for (int mt = 0; mt < 8; ++mt) af[mt] = *(const LAS bf16x8*)(lds + XC_OFF + (16 * mt + l15) * RS + (ks * 32 + lq * 8) * 2);
#pragma unroll
                for (int ty = 0; ty < 2; ++ty) { const bf16x8 wf = *(const bf16x8*)(WG + (size_t)(n * 512 + (ty * 2 + dir) * 128 + chl) * 128 + ks * 32 + lq * 8);
#pragma unroll
                    for (int mt = 0; mt < 8; ++mt) acc[ty][mt] = __builtin_amdgcn_mfma_f32_16x16x32_bf16(af[mt], wf, acc[ty][mt], 0, 0, 0); }
            }
            __builtin_amdgcn_sched_barrier(0);
            const float ba = b_a[dir * DREC + gch], bi = b_i[dir * DREC + gch];
            const float kf = 8.0f * log1pf(expf(-lam[dir * DREC + gch]));
#pragma unroll
            for (int mt = 0; mt < 8; ++mt) {
#pragma unroll
                for (int r = 0; r < 4; ++r) {
                    const int tt = 16 * mt + 4 * lq + r;
                    const float xcv = bf1(*(const LAS unsigned short*)(lds + XC_OFF + tt * RS + chl * 2));
                    const float rg = fast_sigmoid(acc[0][mt][r] + ba), ig = fast_sigmoid(acc[1][mt][r] + bi), av = __expf(-kf * rg);
                    acc[0][mt][r] = av; acc[1][mt][r] = sqrtf(fmaxf(1.0f - av * av, 0.f)) * ig * xcv;
                }
                __builtin_amdgcn_sched_barrier(0);
            }
            __builtin_amdgcn_sched_barrier(0);
            float cr = 0.f;
            if (FINAL) {
                float P = 1.f, H = 0.f;
                if (dir == 0) { const int lo = lq * 16, hi = min(lo + 16, c);
                    for (int cc = lo; cc < hi; ++cc) { const float* sp = sumr + ((size_t)((b * 64 + cc) * 2 + 0) * 2) * 1024 + gch; const float A = sp[0], Hc = sp[1024]; H = A * H + Hc; P *= A; }
#pragma unroll
                    for (int g = 0; g < 4; ++g) { const float Pg = __shfl(P, g * 16 + l15), Hg = __shfl(H, g * 16 + l15); cr = Pg * cr + Hg; } }
                else { const int lo = max(lq * 16, c + 1), hi = lq * 16 + 16;
                    for (int cc = hi - 1; cc >= lo; --cc) { const float* sp = sumr + ((size_t)((b * 64 + cc) * 2 + 1) * 2) * 1024 + gch; const float A = sp[0], Hc = sp[1024]; H = A * H + Hc; P *= A; }
#pragma unroll
                    for (int g = 3; g >= 0; --g) { const float Pg = __shfl(P, g * 16 + l15), Hg = __shfl(H, g * 16 + l15); cr = Pg * cr + Hg; } }
            }
            __builtin_amdgcn_sched_barrier(0);
            float pt = 1.f;
            if (dir == 0) {
#pragma unroll
                for (int mt = 0; mt < 8; ++mt) {
                    float H = 0.f, P = 1.f, hl[4], pl[4];
#pragma unroll
                    for (int r = 0; r < 4; ++r) { H = acc[0][mt][r] * H + acc[1][mt][r]; P *= acc[0][mt][r]; hl[r] = H; pl[r] = P; }
                    const float P0 = __shfl(P, l15), H0 = __shfl(H, l15), P1 = __shfl(P, 16 + l15), H1 = __shfl(H, 16 + l15), P2 = __shfl(P, 32 + l15), H2 = __shfl(H, 32 + l15), P3 = __shfl(P, 48 + l15), H3 = __shfl(H, 48 + l15);
                    const float c0 = cr, c1 = P0 * c0 + H0, c2 = P1 * c1 + H1, c3 = P2 * c2 + H2, c4 = P3 * c3 + H3;
                    if (FINAL) { const float mine = lq == 0 ? c0 : (lq == 1 ? c1 : (lq == 2 ? c2 : c3));
#pragma unroll
                        for (int r = 0; r < 4; ++r) hs[mt][r] = hl[r] + pl[r] * mine; }
                    else pt *= (P0 * P1) * (P2 * P3);
                    cr = c4;
                }
            } else {
#pragma unroll
                for (int mt = 7; mt >= 0; --mt) {
                    float H = 0.f, P = 1.f, hl[4], pl[4];
#pragma unroll
                    for (int r = 3; r >= 0; --r) { H = acc[0][mt][r] * H + acc[1][mt][r]; P *= acc[0][mt][r]; hl[r] = H; pl[r] = P; }
                    const float P0 = __shfl(P, l15), H0 = __shfl(H, l15), P1 = __shfl(P, 16 + l15), H1 = __shfl(H, 16 + l15), P2 = __shfl(P, 32 + l15), H2 = __shfl(H, 32 + l15), P3 = __shfl(P, 48 + l15), H3 = __shfl(H, 48 + l15);
                    const float c3 = cr, c2 = P3 * c3 + H3, c1 = P2 * c2 + H2, c0 = P1 * c1 + H1, cn = P0 * c0 + H0;
                    if (FINAL) { const float mine = lq == 0 ? c0 : (lq == 1 ? c1 : (lq == 2 ? c2 : c3));
#pragma unroll
                        for (int r = 0; r < 4; ++r) hs[mt][r] += hl[r] + pl[r] * mine; }
                    else pt *= (P0 * P1) * (P2 * P3);
                    cr = cn;
                }
            }
            cend[dir] = cr; ptot[dir] = pt;
            __builtin_amdgcn_sched_barrier(0);
        }
        if (!FINAL) {
            if (lq == 0) { float* sp = sumr + ((size_t)((b * 64 + c) * 2 + 0) * 2) * 1024 + gch; sp[0] = ptot[0]; sp[1024] = cend[0]; sp[2048] = ptot[1]; sp[3072] = cend[1]; }
            __syncthreads();
        } else {
#pragma unroll
            for (int mt = 0; mt < 8; ++mt) {
#pragma unroll
                for (int r = 0; r < 4; ++r) { const int tt = 16 * mt + 4 * lq + r;
                    const float y = bf1(*(const LAS unsigned short*)(lds + YG_OFF + tt * RS + chl * 2));
                    const float z = 0.7978845608028654f * (y + 0.044715f * y * y * y);
                    const float gl = y * fast_sigmoid(2.0f * z);
                    const float v = hs[mt][r] * gl;
                    *(LAS unsigned short*)(lds + REC_OFF + tt * RS + chl * 2) = (unsigned short)(cvt_pk_bf16(v, 0.f) & 0xffffu); }
                __builtin_amdgcn_sched_barrier(0);
            }
            __syncthreads();
            { const int tok = tid >> 2, qtr = tid & 3; float ss = 0.f;
              bf16_t* dst = A2 + ((size_t)b * SEQ + t0 + tok) * DM + DATT + n * 128 + qtr * 32;
#pragma unroll
              for (int j = 0; j < 4; ++j) { const u32x4 v = *(const LAS u32x4*)(lds + REC_OFF + tok * RS + qtr * 64 + j * 16);
                  const float e0 = bf_lo(v.x), e1 = bf_hi(v.x), e2 = bf_lo(v.y), e3 = bf_hi(v.y), e4 = bf_lo(v.z), e5 = bf_hi(v.z), e6 = bf_lo(v.w), e7 = bf_hi(v.w);
                  ss += (e0 * e0 + e1 * e1) + (e2 * e2 + e3 * e3) + (e4 * e4 + e5 * e5) + (e6 * e6 + e7 * e7);
                  *(u32x4*)(dst + j * 8) = v; }
              ss += __shfl_xor(ss, 1); ss += __shfl_xor(ss, 2);
              if (qtr == 0) prec[((size_t)b * SEQ + t0 + tok) * 8 + n] = ss; }
            __syncthreads();
        }
    }
}

template <bool FINAL>
__device__ __forceinline__ void scan2(const f32x4 (&A)[2], const f32x4 (&B)[2], int dir, float cin, int l15, int lq, float& cout, float& ptot, f32x4 (&hout)[2]) {
    float cr = cin, pt = 1.f;
#pragma unroll
    for (int k = 0; k < 2; ++k) {
        if (dir == 0) { const int mt = k;
            float H = 0.f, P = 1.f, hl[4], pl[4];
#pragma unroll
            for (int r = 0; r < 4; ++r) { H = A[mt][r] * H + B[mt][r]; P *= A[mt][r]; hl[r] = H; pl[r] = P; }
            const float P0 = __shfl(P, l15), H0 = __shfl(H, l15), P1 = __shfl(P, 16 + l15), H1 = __shfl(H, 16 + l15), P2 = __shfl(P, 32 + l15), H2 = __shfl(H, 32 + l15), P3 = __shfl(P, 48 + l15), H3 = __shfl(H, 48 + l15);
            const float c0 = cr, c1 = P0 * c0 + H0, c2 = P1 * c1 + H1, c3 = P2 * c2 + H2, c4 = P3 * c3 + H3;
            if (FINAL) { const float mine = lq == 0 ? c0 : (lq == 1 ? c1 : (lq == 2 ? c2 : c3));
#pragma unroll
                for (int r = 0; r < 4; ++r) hout[mt][r] = hl[r] + pl[r] * mine; }
            else pt *= (P0 * P1) * (P2 * P3);
            cr = c4;
        } else { const int mt = 1 - k;
            float H = 0.f, P = 1.f, hl[4], pl[4];
#pragma unroll
            for (int r = 3; r >= 0; --r) { H = A[mt][r] * H + B[mt][r]; P *= A[mt][r]; hl[r] = H; pl[r] = P; }
            const float P0 = __shfl(P, l15), H0 = __shfl(H, l15), P1 = __shfl(P, 16 + l15), H1 = __shfl(H, 16 + l15), P2 = __shfl(P, 32 + l15), H2 = __shfl(H, 32 + l15), P3 = __shfl(P, 48 + l15), H3 = __shfl(H, 48 + l15);
            const float c3 = cr, c2 = P3 * c3 + H3, c1 = P2 * c2 + H2, c0 = P1 * c1 + H1, cn = P0 * c0 + H0;
            if (FINAL) { const float mine = lq == 0 ? c0 : (lq == 1 ? c1 : (lq == 2 ? c2 : c3));
#pragma unroll
                for (int r = 0; r < 4; ++r) hout[mt][r] = hl[r] + pl[r] * mine; }
            else pt *= (P0 * P1) * (P2 * P3);
            cr = cn;
        }
    }
    cout = cr; ptot = pt;
}

__device__ __forceinline__ void rglru_stream_phase(const Args& a, LAS unsigned char* lds, int tid, int wid, int lane) {
    const bf16_t* U = (const bf16_t*)(a.ws + WS_U); bf16_t* A2 = (bf16_t*)(a.ws + WS_A2); bf16_t* HBW = (bf16_t*)(a.ws + WS_Y); const bf16_t* WG = (const bf16_t*)(a.ws + WS_WG);
    const float* conv_w = a.in[5]; const float* conv_b = a.in[6]; const float* b_a = a.in[8]; const float* b_i = a.in[10]; const float* lam = a.in[11];
    constexpr int XC_OFF = 0, RS = 272, TOT_OFF = 34816;
    LAS float* TOT = (LAS float*)(lds + TOT_OFF);
    const int l15 = lane & 15, lq = lane >> 4, cgp = tid & 15, tq = tid >> 4, ct = wid & 1, g = wid >> 1;
    for (int s0 = blockIdx.x; s0 < 256; s0 += gridDim.x) {
        const int s = (gridDim.x == 256) ? ((s0 & 7) * 32 + (s0 >> 3)) : s0;
        const int q = s & 3, dir = (s >> 2) & 1, n = (s >> 3) & 7, b = s >> 6;
        const int chl = q * 32 + ct * 16 + l15, gch = n * 128 + chl;
        const float ba = b_a[dir * DREC + gch], bi = b_i[dir * DREC + gch], kf = 8.0f * log1pf(expf(-lam[dir * DREC + gch]));
        bf16x8 wf[2][4];
#pragma unroll
        for (int ty = 0; ty < 2; ++ty)
#pragma unroll
            for (int ks = 0; ks < 4; ++ks) wf[ty][ks] = *(const bf16x8*)(WG + (size_t)(n * 512 + (ty * 2 + dir) * 128 + chl) * 128 + ks * 32 + lq * 8);
        const int chb = n * 128 + cgp * 8;
        float cw[4][8], cb[8];
#pragma unroll
        for (int j = 0; j < 4; ++j) { const f32x4 w0 = *(const f32x4*)(conv_w + j * DREC + chb), w1 = *(const f32x4*)(conv_w + j * DREC + chb + 4);
            cw[j][0] = w0.x; cw[j][1] = w0.y; cw[j][2] = w0.z; cw[j][3] = w0.w; cw[j][4] = w1.x; cw[j][5] = w1.y; cw[j][6] = w1.z; cw[j][7] = w1.w; }
        { const f32x4 w0 = *(const f32x4*)(conv_b + chb), w1 = *(const f32x4*)(conv_b + chb + 4); cb[0] = w0.x; cb[1] = w0.y; cb[2] = w0.z; cb[3] = w0.w; cb[4] = w1.x; cb[5] = w1.y; cb[6] = w1.z; cb[7] = w1.w; }
        const bf16_t* xbase = U + (size_t)b * SEQ * DIN + 3072 + chb;
        bf16_t* hdst = dir ? (HBW + (size_t)b * SEQ * DREC + gch) : (A2 + (size_t)b * SEQ * DM + DATT + gch);
        const int hld = dir ? DREC : DM;
        float carry = 0.f;
        u32x4 raw[7];
        { const int t0 = (dir ? 63 : 0) * 128;
#pragma unroll
          for (int rr = 0; rr < 7; ++rr) { const int ts = t0 + 4 * tq - 2 + rr; raw[rr] = (u32x4){0u, 0u, 0u, 0u}; if (ts >= 0 && ts < SEQ) raw[rr] = *(const u32x4*)(xbase + (size_t)ts * DIN); } }
        for (int step = 0; step < 64; ++step) {
            const int c = dir ? 63 - step : step, t0 = c * 128;
            {
                float xin[7][8];
#pragma unroll
                for (int rr = 0; rr < 7; ++rr) { const u32x4 v = raw[rr];
                    xin[rr][0] = bf_lo(v.x); xin[rr][1] = bf_hi(v.x); xin[rr][2] = bf_lo(v.y); xin[rr][3] = bf_hi(v.y); xin[rr][4] = bf_lo(v.z); xin[rr][5] = bf_hi(v.z); xin[rr][6] = bf_lo(v.w); xin[rr][7] = bf_hi(v.w); }
#pragma unroll
                for (int i = 0; i < 4; ++i) { float o[8];
#pragma unroll
                    for (int e = 0; e < 8; ++e) o[e] = cb[e] + cw[0][e] * xin[i][e] + cw[1][e] * xin[i + 1][e] + cw[2][e] * xin[i + 2][e] + cw[3][e] * xin[i + 3][e];
                    u32x4 w; w.x = cvt_pk_bf16(o[0], o[1]); w.y = cvt_pk_bf16(o[2], o[3]); w.z = cvt_pk_bf16(o[4], o[5]); w.w = cvt_pk_bf16(o[6], o[7]);
                    *(LAS u32x4*)(lds + XC_OFF + (4 * tq + i) * RS + cgp * 16) = w; }
            }
            if (step < 63) { const int t1 = (dir ? c - 1 : c + 1) * 128;
#pragma unroll
                for (int rr = 0; rr < 7; ++rr) { const int ts = t1 + 4 * tq - 2 + rr; raw[rr] = (u32x4){0u, 0u, 0u, 0u}; if (ts >= 0 && ts < SEQ) raw[rr] = *(const u32x4*)(xbase + (size_t)ts * DIN); } }
            __syncthreads();
            f32x4 A[2], B[2];
#pragma unroll
            for (int mt = 0; mt < 2; ++mt) { A[mt] = (f32x4){0.f, 0.f, 0.f, 0.f}; B[mt] = (f32x4){0.f, 0.f, 0.f, 0.f}; }
#pragma unroll
            for (int ks = 0; ks < 4; ++ks)
#pragma unroll
                for (int mt = 0; mt < 2; ++mt) { const bf16x8 af = *(const LAS bf16x8*)(lds + XC_OFF + (32 * g + 16 * mt + l15) * RS + (ks * 32 + lq * 8) * 2);
                    A[mt] = __builtin_amdgcn_mfma_f32_16x16x32_bf16(af, wf[0][ks], A[mt], 0, 0, 0); B[mt] = __builtin_amdgcn_mfma_f32_16x16x32_bf16(af, wf[1][ks], B[mt], 0, 0, 0); }
#pragma unroll
            for (int mt = 0; mt < 2; ++mt)
#pragma unroll
                for (int r = 0; r < 4; ++r) { const int tt = 32 * g + 16 * mt + 4 * lq + r;
                    const float xcv = bf1(*(const LAS unsigned short*)(lds + XC_OFF + tt * RS + (cgp * 0 + q * 32 + ct * 16 + l15) * 2));
                    const float rg = fast_sigmoid(A[mt][r] + ba), ig = fast_sigmoid(B[mt][r] + bi), av = __expf(-kf * rg);
                    A[mt][r] = av; B[mt][r] = sqrtf(fmaxf(1.0f - av * av, 0.f)) * ig * xcv; }
            float hl[2][4], pl[2][4], PG[2][4], HG[2][4];
#pragma unroll
            for (int mt = 0; mt < 2; ++mt) { float H = 0.f, P = 1.f;
                if (dir == 0) {
#pragma unroll
                    for (int r = 0; r < 4; ++r) { H = A[mt][r] * H + B[mt][r]; P *= A[mt][r]; hl[mt][r] = H; pl[mt][r] = P; } }
                else {
#pragma unroll
                    for (int r = 3; r >= 0; --r) { H = A[mt][r] * H + B[mt][r]; P *= A[mt][r]; hl[mt][r] = H; pl[mt][r] = P; } }
#pragma unroll
                for (int gq = 0; gq < 4; ++gq) { PG[mt][gq] = __shfl(P, gq * 16 + l15); HG[mt][gq] = __shfl(H, gq * 16 + l15); } }
            float pseg = 1.f, hseg = 0.f;
            if (dir == 0) {
#pragma unroll
                for (int k = 0; k < 8; ++k) { const int mt = k >> 2, gq = k & 3; hseg = PG[mt][gq] * hseg + HG[mt][gq]; pseg *= PG[mt][gq]; } }
            else {
#pragma unroll
                for (int k = 0; k < 8; ++k) { const int mt = 1 - (k >> 2), gq = 3 - (k & 3); hseg = PG[mt][gq] * hseg + HG[mt][gq]; pseg *= PG[mt][gq]; } }
            if (lq == 0) { TOT[((ct * 4 + g) * 16 + l15) * 2] = pseg; TOT[((ct * 4 + g) * 16 + l15) * 2 + 1] = hseg; }
            __syncthreads();
            float cin = carry, wgc = carry; const int pos = dir ? 3 - g : g;
#pragma unroll
            for (int k = 0; k < 4; ++k) { const int gg = dir ? 3 - k : k; const float P = TOT[((ct * 4 + gg) * 16 + l15) * 2], H = TOT[((ct * 4 + gg) * 16 + l15) * 2 + 1];
                if (k < pos) cin = P * cin + H; wgc = P * wgc + H; }
            carry = wgc;
            f32x4 hout[2]; float cr = cin;
            if (dir == 0) {
#pragma unroll
                for (int k = 0; k < 8; ++k) { const int mt = k >> 2, gq = k & 3;
                    if (gq == lq) {
#pragma unroll
                        for (int r = 0; r < 4; ++r) hout[mt][r] = hl[mt][r] + pl[mt][r] * cr; }
                    cr = PG[mt][gq] * cr + HG[mt][gq]; } }
            else {
#pragma unroll
                for (int k = 0; k < 8; ++k) { const int mt = 1 - (k >> 2), gq = 3 - (k & 3);
                    if (gq == lq) {
#pragma unroll
                        for (int r = 0; r < 4; ++r) hout[mt][r] = hl[mt][r] + pl[mt][r] * cr; }
                    cr = PG[mt][gq] * cr + HG[mt][gq]; } }
#pragma unroll
            for (int mt = 0; mt < 2; ++mt)
#pragma unroll
                for (int r = 0; r < 4; ++r) { const int tt = 32 * g + 16 * mt + 4 * lq + r;
                    hdst[(size_t)(t0 + tt) * hld] = (unsigned short)(cvt_pk_bf16(hout[mt][r], 0.f) & 0xffffu); }
        }
        __syncthreads();
    }
}

__device__ __forceinline__ void rglru_stream2_phase(const Args& a, LAS unsigned char* lds, int tid, int wid, int lane, int s_first, int s_step) {
    const bf16_t* U = (const bf16_t*)(a.ws + WS_U); bf16_t* A2 = (bf16_t*)(a.ws + WS_A2); bf16_t* HBW = (bf16_t*)(a.ws + WS_Y); const bf16_t* WG = (const bf16_t*)(a.ws + WS_WG);
    const float* conv_w = a.in[5]; const float* conv_b = a.in[6]; const float* b_a = a.in[8]; const float* b_i = a.in[10]; const float* lam = a.in[11];
    constexpr int XC_OFF = 0, RS = 272, TOT_OFF = 34816;
    LAS float* TOT = (LAS float*)(lds + TOT_OFF);
    const int l15 = lane & 15, lq = lane >> 4, cgp = tid & 15, tq = tid >> 4, cth = wid & 1, g = wid >> 1;
    for (int s = s_first; s < 128; s += s_step) {
        const int hq = s & 1, dir = (s >> 1) & 1, n = (s >> 2) & 7, b = s >> 5;
        int chl[2]; float ba[2], bi[2], kf[2]; bf16x8 wf[2][2][4]; bf16_t* hdst[2];
#pragma unroll
        for (int cc = 0; cc < 2; ++cc) { chl[cc] = hq * 64 + (cth * 2 + cc) * 16 + l15; const int gch = n * 128 + chl[cc];
            ba[cc] = -1.4426950408889634f * b_a[dir * DREC + gch]; bi[cc] = -1.4426950408889634f * b_i[dir * DREC + gch]; kf[cc] = -1.4426950408889634f * 8.0f * log1pf(expf(-lam[dir * DREC + gch]));
#pragma unroll
            for (int ty = 0; ty < 2; ++ty)
#pragma unroll
                for (int ks = 0; ks < 4; ++ks) wf[cc][ty][ks] = *(const bf16x8*)(WG + (size_t)(n * 512 + (ty * 2 + dir) * 128 + chl[cc]) * 128 + ks * 32 + lq * 8);
            hdst[cc] = dir ? (HBW + (size_t)b * SEQ * DREC + gch) : (A2 + (size_t)b * SEQ * DM + DATT + gch); }
        const int hld = dir ? DREC : DM;
        const int chb = n * 128 + cgp * 8;
        float cw[4][8], cb[8];
#pragma unroll
        for (int j = 0; j < 4; ++j) { const f32x4 w0 = *(const f32x4*)(conv_w + j * DREC + chb), w1 = *(const f32x4*)(conv_w + j * DREC + chb + 4);
            cw[j][0] = w0.x; cw[j][1] = w0.y; cw[j][2] = w0.z; cw[j][3] = w0.w; cw[j][4] = w1.x; cw[j][5] = w1.y; cw[j][6] = w1.z; cw[j][7] = w1.w; }
        { const f32x4 w0 = *(const f32x4*)(conv_b + chb), w1 = *(const f32x4*)(conv_b + chb + 4); cb[0] = w0.x; cb[1] = w0.y; cb[2] = w0.z; cb[3] = w0.w; cb[4] = w1.x; cb[5] = w1.y; cb[6] = w1.z; cb[7] = w1.w; }
        const bf16_t* xbase = U + (size_t)b * SEQ * DIN + 3072 + chb;
        float carry[2] = {0.f, 0.f};
        u32x4 raw[7];
        { const int t0 = (dir ? 63 : 0) * 128;
#pragma unroll
          for (int rr = 0; rr < 7; ++rr) { const int ts = t0 + 4 * tq - 2 + rr; raw[rr] = (u32x4){0u, 0u, 0u, 0u}; if (ts >= 0 && ts < SEQ) raw[rr] = *(const u32x4*)(xbase + (size_t)ts * DIN); } }
        for (int step = 0; step < 64; ++step) {
            const int c = dir ? 63 - step : step, t0 = c * 128;
            {
                float xin[7][8];
#pragma unroll
                for (int rr = 0; rr < 7; ++rr) { const u32x4 v = raw[rr];
                    xin[rr][0] = bf_lo(v.x); xin[rr][1] = bf_hi(v.x); xin[rr][2] = bf_lo(v.y); xin[rr][3] = bf_hi(v.y); xin[rr][4] = bf_lo(v.z); xin[rr][5] = bf_hi(v.z); xin[rr][6] = bf_lo(v.w); xin[rr][7] = bf_hi(v.w); }
#pragma unroll
                for (int i = 0; i < 4; ++i) { float o[8];
#pragma unroll
                    for (int e = 0; e < 8; ++e) o[e] = cb[e] + cw[0][e] * xin[i][e] + cw[1][e] * xin[i + 1][e] + cw[2][e] * xin[i + 2][e] + cw[3][e] * xin[i + 3][e];
                    u32x4 w; w.x = cvt_pk_bf16(o[0], o[1]); w.y = cvt_pk_bf16(o[2], o[3]); w.z = cvt_pk_bf16(o[4], o[5]); w.w = cvt_pk_bf16(o[6], o[7]);
                    *(LAS u32x4*)(lds + XC_OFF + (4 * tq + i) * RS + cgp * 16) = w; }
            }
            if (step < 63) { const int t1 = (dir ? c - 1 : c + 1) * 128;
#pragma unroll
                for (int rr = 0; rr < 7; ++rr) { const int ts = t1 + 4 * tq - 2 + rr; raw[rr] = (u32x4){0u, 0u, 0u, 0u}; if (ts >= 0 && ts < SEQ) raw[rr] = *(const u32x4*)(xbase + (size_t)ts * DIN); } }
            __syncthreads();
            f32x4 A[2][2], B[2][2];
#pragma unroll
            for (int cc = 0; cc < 2; ++cc)
#pragma unroll
                for (int mt = 0; mt < 2; ++mt) { A[cc][mt] = (f32x4){0.f, 0.f, 0.f, 0.f}; B[cc][mt] = (f32x4){0.f, 0.f, 0.f, 0.f}; }
#pragma unroll
            for (int ks = 0; ks < 4; ++ks)
#pragma unroll
                for (int mt = 0; mt < 2; ++mt) { const bf16x8 af = *(const LAS bf16x8*)(lds + XC_OFF + (32 * g + 16 * mt + l15) * RS + (ks * 32 + lq * 8) * 2);
#pragma unroll
                    for (int cc = 0; cc < 2; ++cc) { A[cc][mt] = __builtin_amdgcn_mfma_f32_16x16x32_bf16(af, wf[cc][0][ks], A[cc][mt], 0, 0, 0); B[cc][mt] = __builtin_amdgcn_mfma_f32_16x16x32_bf16(af, wf[cc][1][ks], B[cc][mt], 0, 0, 0); } }
#pragma unroll
            for (int cc = 0; cc < 2; ++cc)
#pragma unroll
                for (int mt = 0; mt < 2; ++mt)
#pragma unroll
                    for (int r = 0; r < 4; ++r) { const int tt = 32 * g + 16 * mt + 4 * lq + r;
                        const float xcv = bf1(*(const LAS unsigned short*)(lds + XC_OFF + tt * RS + chl[cc] * 2));
                        const float rg = __builtin_amdgcn_rcpf(1.0f + __builtin_amdgcn_exp2f(__builtin_fmaf(A[cc][mt][r], -1.4426950408889634f, ba[cc])));
                        const float ig = __builtin_amdgcn_rcpf(1.0f + __builtin_amdgcn_exp2f(__builtin_fmaf(B[cc][mt][r], -1.4426950408889634f, bi[cc])));
                        const float av = __builtin_amdgcn_exp2f(kf[cc] * rg);
                        A[cc][mt][r] = av; B[cc][mt][r] = __builtin_amdgcn_sqrtf(fmaxf(__builtin_fmaf(-av, av, 1.0f), 0.f)) * ig * xcv; }
            float PG[2][2][4], HG[2][2][4];
#pragma unroll
            for (int cc = 0; cc < 2; ++cc) {
#pragma unroll
                for (int mt = 0; mt < 2; ++mt) { float H = 0.f, P = 1.f;
                    if (dir == 0) {
#pragma unroll
                        for (int r = 0; r < 4; ++r) { H = A[cc][mt][r] * H + B[cc][mt][r]; P *= A[cc][mt][r]; } }
                    else {
#pragma unroll
                        for (int r = 3; r >= 0; --r) { H = A[cc][mt][r] * H + B[cc][mt][r]; P *= A[cc][mt][r]; } }
#pragma unroll
                    for (int gq = 0; gq < 4; ++gq) { PG[cc][mt][gq] = __shfl(P, gq * 16 + l15); HG[cc][mt][gq] = __shfl(H, gq * 16 + l15); } }
                float pseg = 1.f, hseg = 0.f;
                if (dir == 0) {
#pragma unroll
                    for (int k = 0; k < 8; ++k) { const int mt = k >> 2, gq = k & 3; hseg = PG[cc][mt][gq] * hseg + HG[cc][mt][gq]; pseg *= PG[cc][mt][gq]; } }
                else {
#pragma unroll
                    for (int k = 0; k < 8; ++k) { const int mt = 1 - (k >> 2), gq = 3 - (k & 3); hseg = PG[cc][mt][gq] * hseg + HG[cc][mt][gq]; pseg *= PG[cc][mt][gq]; } }
                if (lq == 0) { const int ti = (((cth * 2 + cc) * 4 + g) * 16 + l15) * 2; TOT[ti] = pseg; TOT[ti + 1] = hseg; }
            }
            __syncthreads();
#pragma unroll
            for (int cc = 0; cc < 2; ++cc) {
                float cin = carry[cc], wgc = carry[cc]; const int pos = dir ? 3 - g : g;
#pragma unroll
                for (int k = 0; k < 4; ++k) { const int gg = dir ? 3 - k : k; const int ti = (((cth * 2 + cc) * 4 + gg) * 16 + l15) * 2; const float P = TOT[ti], H = TOT[ti + 1];
                    if (k < pos) cin = P * cin + H; wgc = P * wgc + H; }
                carry[cc] = wgc;
                float mycr[2] = {0.f, 0.f}; float cr = cin;
                if (dir == 0) {
#pragma unroll
                    for (int k = 0; k < 8; ++k) { const int mt = k >> 2, gq = k & 3; mycr[mt] = (gq == lq) ? cr : mycr[mt]; cr = PG[cc][mt][gq] * cr + HG[cc][mt][gq]; } }
                else {
#pragma unroll
                    for (int k = 0; k < 8; ++k) { const int mt = 1 - (k >> 2), gq = 3 - (k & 3); mycr[mt] = (gq == lq) ? cr : mycr[mt]; cr = PG[cc][mt][gq] * cr + HG[cc][mt][gq]; } }
#pragma unroll
                for (int mt = 0; mt < 2; ++mt) { float H = mycr[mt]; float ho[4];
                    if (dir == 0) {
#pragma unroll
                        for (int r = 0; r < 4; ++r) { H = A[cc][mt][r] * H + B[cc][mt][r]; ho[r] = H; } }
                    else {
#pragma unroll
                        for (int r = 3; r >= 0; --r) { H = A[cc][mt][r] * H + B[cc][mt][r]; ho[r] = H; } }
#pragma unroll
                    for (int r = 0; r < 4; ++r) { const int tt = 32 * g + 16 * mt + 4 * lq + r;
                        __builtin_nontemporal_store((unsigned short)(cvt_pk_bf16(ho[r], 0.f) & 0xffffu), hdst[cc] + (size_t)(t0 + tt) * hld); } }
            }
        }
        __syncthreads();
    }
}

__device__ __forceinline__ void fixup_phase(const Args& a, int wid, int lane) {
    bf16_t* A2 = (bf16_t*)(a.ws + WS_A2); const float* patt = (const float*)(a.ws + WS_PATT); const bf16_t* HBW = (const bf16_t*)(a.ws + WS_Y); const bf16_t* U = (const bf16_t*)(a.ws + WS_U);
    const float* ga = a.in[12]; const float* gr = a.in[13];
    const int gw = blockIdx.x * 8 + wid, NGW = gridDim.x * 8;
    f32x4 gA[2][2], gR[2][2];
#pragma unroll
    for (int j = 0; j < 2; ++j) { const int ci = j * 64 + lane; gA[j][0] = *(const f32x4*)(ga + ci * 8); gA[j][1] = *(const f32x4*)(ga + ci * 8 + 4); gR[j][0] = *(const f32x4*)(gr + ci * 8); gR[j][1] = *(const f32x4*)(gr + ci * 8 + 4); }
    for (int m = gw; m < MTOK; m += NGW) {
        float pv = (lane < 8) ? patt[(size_t)m * 8 + lane] : 0.f;
        pv += __shfl_xor(pv, 1); pv += __shfl_xor(pv, 2); pv += __shfl_xor(pv, 4);
        const float ssa = __shfl(pv, 0);
        const float rsa = rsqrtf(ssa * (1.f / DATT) + EPS);
        u32x4* row = (u32x4*)(A2 + (size_t)m * DM);
        float rec[2][8]; float ssr = 0.f;
#pragma unroll
        for (int j = 0; j < 2; ++j) { const int ci = j * 64 + lane;
            const u32x4 hf = row[128 + ci], hb = __builtin_nontemporal_load((const u32x4*)(HBW + (size_t)m * DREC + ci * 8)), yg = __builtin_nontemporal_load((const u32x4*)(U + (size_t)m * DIN + 4096 + ci * 8));
            const float hs[8] = {bf_lo(hf.x) + bf_lo(hb.x), bf_hi(hf.x) + bf_hi(hb.x), bf_lo(hf.y) + bf_lo(hb.y), bf_hi(hf.y) + bf_hi(hb.y), bf_lo(hf.z) + bf_lo(hb.z), bf_hi(hf.z) + bf_hi(hb.z), bf_lo(hf.w) + bf_lo(hb.w), bf_hi(hf.w) + bf_hi(hb.w)};
            const float ys[8] = {bf_lo(yg.x), bf_hi(yg.x), bf_lo(yg.y), bf_hi(yg.y), bf_lo(yg.z), bf_hi(yg.z), bf_lo(yg.w), bf_hi(yg.w)};
#pragma unroll
            for (int e = 0; e < 8; ++e) { const float y = ys[e], z = 0.7978845608028654f * (y + 0.044715f * y * y * y); const float v = hs[e] * y * fast_sigmoid(2.0f * z); rec[j][e] = v; ssr += v * v; } }
        const float rsr = rsqrtf(wave_sum(ssr) * (1.f / DREC) + EPS);
#pragma unroll
        for (int j = 0; j < 2; ++j) { const int ci = j * 64 + lane; const u32x4 v = row[ci];
            const f32x4 g0 = gA[j][0], g1 = gA[j][1];
            u32x4 w; w.x = cvt_pk_bf16(bf_lo(v.x) * rsa * g0.x, bf_hi(v.x) * rsa * g0.y); w.y = cvt_pk_bf16(bf_lo(v.y) * rsa * g0.z, bf_hi(v.y) * rsa * g0.w);
            w.z = cvt_pk_bf16(bf_lo(v.z) * rsa * g1.x, bf_hi(v.z) * rsa * g1.y); w.w = cvt_pk_bf16(bf_lo(v.w) * rsa * g1.z, bf_hi(v.w) * rsa * g1.w);
            row[ci] = w; }
#pragma unroll
        for (int j = 0; j < 2; ++j) { const int ci = j * 64 + lane;
            const f32x4 g0 = gR[j][0], g1 = gR[j][1];
            u32x4 w; w.x = cvt_pk_bf16(rec[j][0] * rsr * g0.x, rec[j][1] * rsr * g0.y); w.y = cvt_pk_bf16(rec[j][2] * rsr * g0.z, rec[j][3] * rsr * g0.w);
            w.z = cvt_pk_bf16(rec[j][4] * rsr * g1.x, rec[j][5] * rsr * g1.y); w.w = cvt_pk_bf16(rec[j][6] * rsr * g1.z, rec[j][7] * rsr * g1.w);
            row[128 + ci] = w; }
    }
}

template <int MODE>
__device__ __forceinline__ void epass_phase(const Args& a, const float* g_post, float* rsq, int wid, int lane) {
    const bf16_t* Y = (const bf16_t*)(a.ws + WS_Y); const float* part = (const float*)(a.ws + WS_PART); bf16_t* HB = (bf16_t*)(a.ws + WS_XN); float* out = a.out; const float* x = a.in[0];
    const int gw = blockIdx.x * 8 + wid, NGW = gridDim.x * 8;
    f32x4 g[4][2];
#pragma unroll
    for (int j = 0; j < 4; ++j) { g[j][0] = ((const f32x4*)g_post)[(j * 64 + lane) * 2]; g[j][1] = ((const f32x4*)g_post)[(j * 64 + lane) * 2 + 1]; }
    for (int m0 = gw; m0 < MTOK; m0 += 2 * NGW) {
        int mr[2]; mr[0] = m0; mr[1] = (m0 + NGW < MTOK) ? m0 + NGW : m0;
        float pv[2]; u32x4 yv[2][4]; f32x4 h[2][4][2]; u32x4 hw[2][4];
#pragma unroll
        for (int rr = 0; rr < 2; ++rr) { const int m = mr[rr];
            pv[rr] = part[(size_t)m * 32 + (lane & 31)];
            const u32x4* yr = (const u32x4*)(Y + (size_t)m * DM);
#pragma unroll
            for (int j = 0; j < 4; ++j) yv[rr][j] = __builtin_nontemporal_load(yr + j * 64 + lane);
            if (MODE == 0) {
#pragma unroll
                for (int j = 0; j < 4; ++j) { h[rr][j][0] = __builtin_nontemporal_load((const f32x4*)(x + (size_t)m * DM) + (j * 64 + lane) * 2); h[rr][j][1] = __builtin_nontemporal_load((const f32x4*)(x + (size_t)m * DM) + (j * 64 + lane) * 2 + 1); }
            } else { const u32x4* hb = (const u32x4*)(HB + (size_t)m * DM);
#pragma unroll
                for (int j = 0; j < 4; ++j) hw[rr][j] = hb[j * 64 + lane]; } }
#pragma unroll
        for (int rr = 0; rr < 2; ++rr) { const int m = mr[rr];
            if (MODE != 0) {
#pragma unroll
                for (int j = 0; j < 4; ++j) { const u32x4 w = hw[rr][j];
                    h[rr][j][0] = (f32x4){bf_lo(w.x), bf_hi(w.x), bf_lo(w.y), bf_hi(w.y)}; h[rr][j][1] = (f32x4){bf_lo(w.z), bf_hi(w.z), bf_lo(w.w), bf_hi(w.w)}; } }
            float p = pv[rr];
#pragma unroll
            for (int o = 1; o < 32; o <<= 1) p += __shfl_xor(p, o);
            const float rs = rsqrtf(p * (1.f / DM) + EPS);
            float s2 = 0.f;
#pragma unroll
            for (int j = 0; j < 4; ++j) { const u32x4 yw = yv[rr][j]; const f32x4 y0 = (f32x4){bf_lo(yw.x), bf_hi(yw.x), bf_lo(yw.y), bf_hi(yw.y)}, y1 = (f32x4){bf_lo(yw.z), bf_hi(yw.z), bf_lo(yw.w), bf_hi(yw.w)};
                const f32x4 a0 = h[rr][j][0] + y0 * g[j][0] * rs, a1 = h[rr][j][1] + y1 * g[j][1] * rs; h[rr][j][0] = a0; h[rr][j][1] = a1;
                s2 += (a0.x * a0.x + a0.y * a0.y) + (a0.z * a0.z + a0.w * a0.w) + (a1.x * a1.x + a1.y * a1.y) + (a1.z * a1.z + a1.w * a1.w); }
            if (MODE == 2) { f32x4* orow = (f32x4*)(out + (size_t)m * DM);
#pragma unroll
                for (int j = 0; j < 4; ++j) { __builtin_nontemporal_store(h[rr][j][0], orow + (j * 64 + lane) * 2); __builtin_nontemporal_store(h[rr][j][1], orow + (j * 64 + lane) * 2 + 1); } }
            else { u32x4* hb = (u32x4*)(HB + (size_t)m * DM);
#pragma unroll
                for (int j = 0; j < 4; ++j) { u32x4 w; w.x = cvt_pk_bf16(h[rr][j][0].x, h[rr][j][0].y); w.y = cvt_pk_bf16(h[rr][j][0].z, h[rr][j][0].w); w.z = cvt_pk_bf16(h[rr][j][1].x, h[rr][j][1].y); w.w = cvt_pk_bf16(h[rr][j][1].z, h[rr][j][1].w); hb[j * 64 + lane] = w; }
                const float rs2 = rsqrtf(wave_sum(s2) * (1.f / DM) + EPS);
                if (lane == 0) rsq[m] = rs2; }
        }
    }
}

__device__ __forceinline__ void grid_barrier(unsigned* bar, unsigned target) {
    asm volatile("s_waitcnt vmcnt(0)" ::: "memory");
    __syncthreads();
    if (threadIdx.x == 0) {
        __builtin_amdgcn_fence(__ATOMIC_RELEASE, "agent");
        asm volatile("s_waitcnt vmcnt(0)" ::: "memory");
        __hip_atomic_fetch_add(bar, 1u, __ATOMIC_RELAXED, __HIP_MEMORY_SCOPE_AGENT);
        const unsigned long long t0 = __builtin_amdgcn_s_memrealtime();
        while (__hip_atomic_load(bar, __ATOMIC_RELAXED, __HIP_MEMORY_SCOPE_AGENT) < target) {
            if (__builtin_amdgcn_s_memrealtime() - t0 > 5000000ull) break;
            __builtin_amdgcn_s_sleep(1); }
        __builtin_amdgcn_fence(__ATOMIC_ACQUIRE, "agent");
        asm volatile("s_waitcnt vmcnt(0)" ::: "memory");
    }
    __syncthreads();
}

#define XB_TMO      128
#define XB_XCNT(j)  (256  + 64 * (j))
#define XB_XSUB(j)  (1280 + 64 * (j))
#define XB_XGEN(j)  (2304 + 64 * (j))
#define XB_TOP      3328
#define XB_TOPGEN   3392
#define XCD_BAR_WORDS 3456
#define XB_SPIN_CAP (1u << 18)
__device__ __forceinline__ unsigned xb_ld(unsigned* p)              { return __hip_atomic_load(p, __ATOMIC_RELAXED, __HIP_MEMORY_SCOPE_AGENT); }
__device__ __forceinline__ unsigned xb_add(unsigned* p, unsigned v) { return __hip_atomic_fetch_add(p, v, __ATOMIC_RELAXED, __HIP_MEMORY_SCOPE_AGENT); }
__device__ __forceinline__ unsigned xb_xcc_id() { return (unsigned)__builtin_amdgcn_s_getreg((3 << 11) | 20) & 0xFu; }
#define XB_SPIN(cond, bar) do { unsigned _sp = 0; while (cond) { __builtin_amdgcn_s_sleep(1); \
    if ((++_sp & 255u) == 0u) { if (xb_ld(&(bar)[XB_TMO])) break; if (_sp > XB_SPIN_CAP) { atomicAdd(&(bar)[XB_TMO], 1u); break; } } } } while (0)
struct XcdBarrier { unsigned* bar; unsigned x; volatile LAS unsigned* st; };
__device__ __forceinline__ void xcd_barrier_complete(unsigned* bar, unsigned x, unsigned& nloc, unsigned& nx) {
    const unsigned G = gridDim.x * gridDim.y * gridDim.z;
    unsigned sum, cnt, mine, sp = 0u;
    for (;;) {
        sum = 0u; cnt = 0u; mine = 0u;
#pragma unroll
        for (unsigned j = 0; j < 16; ++j) { const unsigned c = xb_ld(&bar[XB_XCNT(j)]); sum += c; cnt += (c > 0u) ? 1u : 0u; mine = (j == x) ? c : mine; }
        if (sum == G) break;
        __builtin_amdgcn_s_sleep(1);
        if ((++sp & 255u) == 0u) { if (xb_ld(&bar[XB_TMO])) break; if (sp > XB_SPIN_CAP) { atomicAdd(&bar[XB_TMO], 1u); break; } }
    }
    nloc = mine > 0u ? mine : 1u; nx = cnt > 0u ? cnt : 1u;
}
__device__ __forceinline__ void xcd_barrier(const XcdBarrier& b) {
    asm volatile("s_waitcnt vmcnt(0)" ::: "memory");
    __syncthreads();
    if (threadIdx.x == 0) {
        unsigned* bar = b.bar;
        __builtin_amdgcn_s_waitcnt(0);
        unsigned nloc = b.st[0], nx = b.st[1];
        if (nloc == 0u) { xcd_barrier_complete(bar, b.x, nloc, nx); b.st[0] = nloc; b.st[1] = nx; }
        const unsigned old = xb_add(&bar[XB_XSUB(b.x)], 1u);
        const unsigned gen = old / nloc;
        if (old + 1u == (gen + 1u) * nloc) {
            __builtin_amdgcn_fence(__ATOMIC_RELEASE, "agent");
            asm volatile("s_waitcnt vmcnt(0)" ::: "memory");
            const unsigned og = xb_add(&bar[XB_TOP], 1u);
            const unsigned tg = og / nx;
            if (og + 1u == (tg + 1u) * nx) xb_add(&bar[XB_TOPGEN], 1u);
            else XB_SPIN(xb_ld(&bar[XB_TOPGEN]) == tg, bar);
            __builtin_amdgcn_fence(__ATOMIC_ACQUIRE, "agent");
            xb_add(&bar[XB_XGEN(b.x)], 1u);
            asm volatile("s_waitcnt vmcnt(0)" ::: "memory");
        } else {
            XB_SPIN(xb_ld(&bar[XB_XGEN(b.x)]) == gen, bar);
            __builtin_amdgcn_fence(__ATOMIC_ACQUIRE, "agent");
            asm volatile("s_waitcnt vmcnt(0)" ::: "memory");
        }
    }
    __syncthreads();
}

__global__ void __launch_bounds__(512) fwd_kernel(Args a) {
    extern __shared__ __attribute__((aligned(16))) unsigned char lds_raw[];
    LAS unsigned char* lds = (LAS unsigned char*)lds_raw;
    const int tid = threadIdx.x, wid = __builtin_amdgcn_readfirstlane(tid >> 6), lane = tid & 63;
    unsigned char* ws = a.ws;
    const int lo = a.ph_lo, hi = a.ph_hi;
#define IN(k) (lo <= (k) && (k) < hi && PH_ON(k))
    volatile LAS unsigned* xst = (volatile LAS unsigned*)(lds + LDS_BYTES - 16);
    if (tid == 0) { xst[0] = 0u; xst[1] = 0u; }
    __syncthreads();
    XcdBarrier xbar; xbar.bar = (unsigned*)(ws + WS_BAR); xbar.x = xb_xcc_id(); xbar.st = xst;
#define SEAM(k) do { if (lo <= (k) && (k) + 1 < hi) { if ((k) == 0) { cg::this_grid().sync(); if (tid == 0) (void)xb_add(&xbar.bar[XB_XCNT(xbar.x)], 1u); } else xcd_barrier(xbar); } } while (0)
#define PHASE(k, ...) do { if (IN(k)) { __VA_ARGS__ } if (NREP(k) > 1) { if (IN(k)) { __VA_ARGS__ } } } while (0)
    PHASE(0, p0_phase(a, lds, tid, wid, lane););
    SEAM(0);
    PHASE(1,
        for (int gi = 0; gi < 2; ++gi) {
            pg8::Gemm g{(const bf16_t*)(ws + (gi ? WS_PB : WS_XN)), (const bf16_t*)(ws + (gi ? WS_WPP : WS_WIN)), MTOK, gi ? DM : DIN, gi ? DPLE : DM}; pg8::StaticOrder S; S.init(MTOK, gi ? DM : DIN, gridDim.x, blockIdx.x);
            pg8::EpiStore E{(bf16_t*)(ws + (gi ? WS_PLE : WS_U)), gi ? DM : DIN}; pg8::gemm_phase(lds, g, S, E); }
    );
    SEAM(1);
    PHASE(2,
        if (gridDim.x == 256) {
            const int c = blockIdx.x, x = c & 7;
            if (c < 128) { rglru_stream2_phase(a, lds, tid, wid, lane, x * 16 + (c >> 3), 1 << 20); attn2_phase(a, lds, tid, wid, lane, x * 64 + 48 + (c >> 3), 16, 1, 2, 4); }
            else { attn2_phase(a, lds, tid, wid, lane, x * 64 + ((c - 128) >> 3), 16, 3, 0, 4); attn2_phase(a, lds, tid, wid, lane, x * 64 + 48 + ((c - 128) >> 3), 16, 1, 0, 2);
                   weight_items(a, lds, wid, lane, 32 * 160, 32 * 160 + 32 * 64 + 3 * (32 * 176) + 32 * 64, (c - 128) * 8 + wid, 1024); __syncthreads(); }
        } else {
            attn2_phase(a, lds, tid, wid, lane, blockIdx.x, gridDim.x, (512 - (int)blockIdx.x + (int)gridDim.x - 1) / (int)gridDim.x, 0, 4);
            rglru_stream2_phase(a, lds, tid, wid, lane, blockIdx.x, gridDim.x);
        }
    );
    SEAM(2);
    PHASE(4, fixup_phase(a, wid, lane););
    SEAM(4);
    PHASE(5, pg8::Gemm g{(const bf16_t*)(ws + WS_A2), (const bf16_t*)(ws + WS_WOUT), MTOK, DM, DM}; pg8::StaticOrder S; S.init(MTOK, DM, gridDim.x, blockIdx.x);
        pg8::EpiStoreSS E{(bf16_t*)(ws + WS_Y), DM, (float*)(ws + WS_PART)}; pg8::gemm_phase(lds, g, S, E););
    SEAM(5);
    PHASE(6, epass_phase<0>(a, a.in[15], (float*)(ws + WS_RSQ), wid, lane););
    SEAM(6);
    PHASE(7, pg8::Gemm g{(const bf16_t*)(ws + WS_XN), (const bf16_t*)(ws + WS_WGU), MTOK, 2 * DFF, DM}; pg8::StaticOrder S; S.init(MTOK, 2 * DFF, gridDim.x, blockIdx.x);
        pg8::EpiSwiglu E{(bf16_t*)(ws + WS_ACT), DFF, (const float*)(ws + WS_RSQ)}; pg8::gemm_phase(lds, g, S, E););
    SEAM(7);
    PHASE(8, pg8::Gemm g{(const bf16_t*)(ws + WS_ACT), (const bf16_t*)(ws + WS_WD), MTOK, DM, DFF}; pg8::StaticOrder S; S.init(MTOK, DM, gridDim.x, blockIdx.x);
        pg8::EpiStoreSS E{(bf16_t*)(ws + WS_Y), DM, (float*)(ws + WS_PART)}; pg8::gemm_phase(lds, g, S, E););
    SEAM(8);
    PHASE(9, epass_phase<1>(a, a.in[20], (float*)(ws + WS_RSQ) + MTOK, wid, lane););
    SEAM(9);
    PHASE(10, pg8::Gemm g{(const bf16_t*)(ws + WS_XN), (const bf16_t*)(ws + WS_WPG), MTOK, DM, DM}; pg8::StaticOrder S; S.init(MTOK, DM, gridDim.x, blockIdx.x);
        pg8::EpiPleGate E{(bf16_t*)(ws + WS_Y), DM, (const bf16_t*)(ws + WS_PLE), (float*)(ws + WS_PART), (const float*)(ws + WS_RSQ) + MTOK}; pg8::gemm_phase(lds, g, S, E););
    SEAM(10);
    PHASE(11, epass_phase<2>(a, a.in[24], nullptr, wid, lane););
#undef IN
#undef SEAM
#undef PHASE
}

extern "C" void kernel_launch(void* const* d_in, const int* in_sizes, int n_in, void* d_out, int out_size, void* d_ws, size_t ws_size, hipStream_t stream) {
    static int grid = 0;
    if (grid == 0) {
        int dev = 0, cus = 0;
        if (hipGetDevice(&dev) != hipSuccess || hipDeviceGetAttribute(&cus, hipDeviceAttributeMultiprocessorCount, dev) != hipSuccess) { fprintf(stderr, "device query failed\n"); grid = -1; return; }
        if (hipFuncSetAttribute((const void*)fwd_kernel, hipFuncAttributeMaxDynamicSharedMemorySize, LDS_BYTES) != hipSuccess) { fprintf(stderr, "hipFuncSetAttribute failed\n"); grid = -1; return; }
        int per_cu = 0;
        if (hipOccupancyMaxActiveBlocksPerMultiprocessor(&per_cu, (const void*)fwd_kernel, 512, LDS_BYTES) != hipSuccess || per_cu < 1) { fprintf(stderr, "occupancy query: %d\n", per_cu); per_cu = 1; }
        (void)hipGetLastError();
        grid = cus;
        if (ws_size < 968 * MiB) fprintf(stderr, "workspace too small: %zu\n", ws_size);
    }
    if (grid < 0) return;
    Args a{};
    for (int i = 0; i < 25; ++i) a.in[i] = (const float*)d_in[i];
    a.out = (float*)d_out; a.ws = (unsigned char*)d_ws;
#if MK_ONE_LAUNCH
    a.ph_lo = 0; a.ph_hi = NPH;
    void* args[] = {&a};
    hipError_t e = hipLaunchCooperativeKernel((const void*)fwd_kernel, dim3(grid), dim3(512), args, LDS_BYTES, stream);
    if (e != hipSuccess) fprintf(stderr, "cooperative launch failed: %s (grid %d)\n", hipGetErrorString(e), grid);
#else
    for (int ph = 0; ph < NPH; ++ph) { a.ph_lo = ph; a.ph_hi = ph + 1; hipLaunchKernelGGL(fwd_kernel, dim3(grid), dim3(512), LDS_BYTES, stream, a); }
#endif
}
```

```cpp
#include <hip/hip_runtime.h>
#include <hip/hip_cooperative_groups.h>
#include <cstdio>
namespace cg = cooperative_groups;

#ifndef MK_ONE_LAUNCH
#define MK_ONE_LAUNCH 1
#endif
#ifndef PH_MASK
#define PH_MASK 0xFFF
#endif
#define PH_ON(k) ((PH_MASK >> (k)) & 1)
#ifndef DUP_MASK
#define DUP_MASK 0x0
#endif
#define NREP(k) (1 + ((DUP_MASK >> (k)) & 1))
#ifndef NAIVE_ATTN
#define NAIVE_ATTN 0
#endif

#define LAS __attribute__((address_space(3)))
typedef unsigned short bf16_t;
typedef short bf16x8 __attribute__((ext_vector_type(8)));
typedef short s16x4 __attribute__((ext_vector_type(4)));
typedef float f32x4 __attribute__((ext_vector_type(4)));
typedef float f32x2 __attribute__((ext_vector_type(2)));
typedef unsigned u32x4 __attribute__((ext_vector_type(4)));
typedef unsigned u32x2 __attribute__((ext_vector_type(2)));

constexpr int MTOK = 32768, DM = 2048, DIN = 5120, DATT = 1024, DREC = 1024, DFF = 5632, DPLE = 256, SEQ = 8192;
constexpr float EPS = 1e-6f;
constexpr int NPH = 12;
constexpr int LDS_BYTES = 147456;

constexpr size_t MiB = 1u << 20;
constexpr size_t WS_U = 0;
constexpr size_t WS_A2 = 320 * MiB;
constexpr size_t WS_ACT = 0;
constexpr size_t WS_XN = 448 * MiB;
constexpr size_t WS_Y = 576 * MiB;
constexpr size_t WS_PLE = 704 * MiB;
constexpr size_t WS_PB = 832 * MiB;
constexpr size_t WS_WIN = 848 * MiB;
constexpr size_t WS_WOUT = 868 * MiB;
constexpr size_t WS_WGU = 876 * MiB;
constexpr size_t WS_WD = 920 * MiB;
constexpr size_t WS_WPG = 942 * MiB;
constexpr size_t WS_WPP = 950 * MiB;
constexpr size_t WS_WG = 951 * MiB;
constexpr size_t WS_PART = 952 * MiB;
constexpr size_t WS_PATT = 956 * MiB;
constexpr size_t WS_PREC = 957 * MiB;
constexpr size_t WS_SUM = 958 * MiB;
constexpr size_t WS_BAR = 967 * MiB;
constexpr size_t WS_RSQ = 966 * MiB;

struct Args {
    const float* in[25];
    float* out;
    unsigned char* ws;
    int ph_lo, ph_hi;
};

__device__ __forceinline__ unsigned cvt_pk_bf16(float lo, float hi) { unsigned r; asm volatile("v_cvt_pk_bf16_f32 %0, %1, %2" : "=v"(r) : "v"(lo), "v"(hi)); return r; }
__device__ __forceinline__ float bf_lo(unsigned w) { return __uint_as_float(w << 16); }
__device__ __forceinline__ float bf_hi(unsigned w) { return __uint_as_float(w & 0xffff0000u); }
__device__ __forceinline__ float bf1(unsigned short h) { return __uint_as_float(((unsigned)h) << 16); }
__device__ __forceinline__ float wave_sum(float v) {
#pragma unroll
    for (int o = 1; o < 64; o <<= 1) v += __shfl_xor(v, o);
    return v;
}
__device__ __forceinline__ float fast_sigmoid(float x) { return __builtin_amdgcn_rcpf(1.0f + __expf(-x)); }

namespace pg8 {
constexpr int BM = 256, BK = 64, HALF = 128, HTB = HALF * BK * 2, STAGE_BYTES = 8 * HTB, NXCD = 8, WGM = 8;
__host__ __device__ __forceinline__ int lds_byte(int r, int c) { const int st = (r >> 4) * 2 + (c >> 5), rr = r & 15, cc = c & 31, ob = rr * 64 + cc * 2; return st * 1024 + (ob ^ (((ob >> 9) & 1) << 5)); }
__host__ __device__ __forceinline__ void stage_rc(int b, int& R, int& C) { const int st = b / 1024, sb = b % 1024, swz = sb ^ (((sb >> 9) & 1) << 5); R = (st >> 1) * 16 + swz / 64; C = (st & 1) * 32 + (swz % 64) / 2; }
__host__ __device__ __forceinline__ int perm32(int rho) { const int n = rho >> 4, i = rho & 15; return 8 * (i >> 2) + 4 * n + (i & 3); }
struct Unit { int pm, pn; };
struct Gemm { const bf16_t* A; const bf16_t* Bt; int M, N, K; };
struct StaticOrder {
    int nM, nN, nwg, G, c;
    __device__ void init(int M, int N, int G_, int c_) { nM = M / BM; nN = N / BM; nwg = nM * nN; G = G_; c = c_; }
    __device__ bool next(int i, Unit& u) const {
        const long L = (long)i * G + c; if (L >= nwg) return false;
        int wgid = (int)L; { const int q = nwg / NXCD, r = nwg % NXCD, xcd = wgid % NXCD, off = wgid / NXCD; wgid = (xcd < r ? xcd * (q + 1) : r * (q + 1) + (xcd - r) * q) + off; }
        const int nig = WGM * nN, gid = wgid / nig, fm = gid * WGM, gsz = (nM - fm) < WGM ? (nM - fm) : WGM;
        u.pm = fm + ((wgid % nig) % gsz); u.pn = (wgid % nig) / gsz; return true;
    }
};

struct EpiStore {
    static constexpr bool PERM = true;
    bf16_t* O; int ldc;
    __device__ __forceinline__ void operator()(const f32x4 (&acc)[2][2][4][2], const Unit& u, int wr, int wc, int fr, int fq) const {
        const int row0 = u.pm * BM + wr * 64 + fr, col0 = u.pn * BM + wc * 32 + 8 * fq;
#pragma unroll
        for (int ai = 0; ai < 2; ++ai)
#pragma unroll
            for (int m = 0; m < 4; ++m) { bf16_t* rowp = O + (size_t)(row0 + ai * HALF + m * 16) * ldc + col0;
#pragma unroll
                for (int bj = 0; bj < 2; ++bj) { const f32x4 v0 = acc[ai][bj][m][0], v1 = acc[ai][bj][m][1];
                    u32x4 w; w.x = cvt_pk_bf16(v0[0], v0[1]); w.y = cvt_pk_bf16(v0[2], v0[3]); w.z = cvt_pk_bf16(v1[0], v1[1]); w.w = cvt_pk_bf16(v1[2], v1[3]);
                    __builtin_nontemporal_store(w, (u32x4*)(rowp + bj * HALF)); } }
    }
};
struct EpiStoreSS {
    static constexpr bool PERM = true;
    bf16_t* O; int ldc; float* part;
    __device__ __forceinline__ void operator()(const f32x4 (&acc)[2][2][4][2], const Unit& u, int wr, int wc, int fr, int fq) const {
        const int row0 = u.pm * BM + wr * 64 + fr, col0 = u.pn * BM + wc * 32 + 8 * fq;
#pragma unroll
        for (int ai = 0; ai < 2; ++ai)
#pragma unroll
            for (int m = 0; m < 4; ++m) { const int row = row0 + ai * HALF + m * 16; bf16_t* rowp = O + (size_t)row * ldc + col0; float s = 0.f;
#pragma unroll
                for (int bj = 0; bj < 2; ++bj) { const f32x4 v0 = acc[ai][bj][m][0], v1 = acc[ai][bj][m][1];
                    s += (v0[0] * v0[0] + v0[1] * v0[1]) + (v0[2] * v0[2] + v0[3] * v0[3]) + (v1[0] * v1[0] + v1[1] * v1[1]) + (v1[2] * v1[2] + v1[3] * v1[3]);
                    u32x4 w; w.x = cvt_pk_bf16(v0[0], v0[1]); w.y = cvt_pk_bf16(v0[2], v0[3]); w.z = cvt_pk_bf16(v1[0], v1[1]); w.w = cvt_pk_bf16(v1[2], v1[3]);
                    *(u32x4*)(rowp + bj * HALF) = w; }
                s += __shfl_xor(s, 16); s += __shfl_xor(s, 32);
                if (fq == 0) part[(size_t)row * 32 + u.pn * 4 + wc] = s; }
    }
};
struct EpiSwiglu {
    static constexpr bool PERM = true;
    bf16_t* O; int ldc; const float* rsq;
    __device__ __forceinline__ void operator()(const f32x4 (&acc)[2][2][4][2], const Unit& u, int wr, int wc, int fr, int fq) const {
        const int row0 = u.pm * BM + wr * 64 + fr, col0 = u.pn * HALF + wc * 32 + 8 * fq;
        float rrv[2][4];
#pragma unroll
        for (int ai = 0; ai < 2; ++ai)
#pragma unroll
            for (int m = 0; m < 4; ++m) rrv[ai][m] = rsq[row0 + ai * HALF + m * 16];
#pragma unroll
        for (int ai = 0; ai < 2; ++ai)
#pragma unroll
            for (int m = 0; m < 4; ++m) { const int row = row0 + ai * HALF + m * 16; bf16_t* rowp = O + (size_t)row * ldc + col0; const float rr = rrv[ai][m];
                float v[8];
#pragma unroll
                for (int n = 0; n < 2; ++n)
#pragma unroll
                    for (int j = 0; j < 4; ++j) { const float g = acc[ai][0][m][n][j] * rr, up = acc[ai][1][m][n][j] * rr; v[n * 4 + j] = g * fast_sigmoid(g) * up; }
                u32x4 w; w.x = cvt_pk_bf16(v[0], v[1]); w.y = cvt_pk_bf16(v[2], v[3]); w.z = cvt_pk_bf16(v[4], v[5]); w.w = cvt_pk_bf16(v[6], v[7]);
                *(u32x4*)rowp = w; }
    }
};
struct EpiPleGate {
    static constexpr bool PERM = true, FUSED = false;
    bf16_t* O; int ldc; const bf16_t* ple; float* part; const float* rsq;
    __device__ __forceinline__ void operator()(const f32x4 (&acc)[2][2][4][2], const Unit& u, int wr, int wc, int fr, int fq) const {
        const int row0 = u.pm * BM + wr * 64 + fr, col0 = u.pn * BM + wc * 32 + 8 * fq;
#pragma unroll
        for (int ai = 0; ai < 2; ++ai) {
            u32x4 plv[4][2]; float rrv[4];
#pragma unroll
            for (int m = 0; m < 4; ++m) { const int row = row0 + ai * HALF + m * 16; const size_t off = (size_t)row * ldc + col0; rrv[m] = rsq[row];
#pragma unroll
                for (int bj = 0; bj < 2; ++bj) plv[m][bj] = __builtin_nontemporal_load((const u32x4*)(ple + off + bj * HALF)); }
#pragma unroll
            for (int m = 0; m < 4; ++m) { const int row = row0 + ai * HALF + m * 16; const size_t off = (size_t)row * ldc + col0; float s = 0.f; const float rr = rrv[m];
#pragma unroll
                for (int bj = 0; bj < 2; ++bj) { const u32x4 pl = plv[m][bj];
                    const f32x4 a0 = acc[ai][bj][m][0] * rr, a1 = acc[ai][bj][m][1] * rr; float v[8];
                    v[0] = fast_sigmoid(a0[0]) * bf_lo(pl.x); v[1] = fast_sigmoid(a0[1]) * bf_hi(pl.x); v[2] = fast_sigmoid(a0[2]) * bf_lo(pl.y); v[3] = fast_sigmoid(a0[3]) * bf_hi(pl.y);
                    v[4] = fast_sigmoid(a1[0]) * bf_lo(pl.z); v[5] = fast_sigmoid(a1[1]) * bf_hi(pl.z); v[6] = fast_sigmoid(a1[2]) * bf_lo(pl.w); v[7] = fast_sigmoid(a1[3]) * bf_hi(pl.w);
#pragma unroll
                    for (int j = 0; j < 8; ++j) s += v[j] * v[j];
                    u32x4 w; w.x = cvt_pk_bf16(v[0], v[1]); w.y = cvt_pk_bf16(v[2], v[3]); w.z = cvt_pk_bf16(v[4], v[5]); w.w = cvt_pk_bf16(v[6], v[7]);
                    *(u32x4*)(O + off + bj * HALF) = w; }
                s += __shfl_xor(s, 16); s += __shfl_xor(s, 32);
                if (fq == 0) part[(size_t)row * 32 + u.pn * 4 + wc] = s; }
        }
    }
};

template <class Epi, class Sched>
__device__ __forceinline__ void gemm_phase(LAS unsigned char* lds, const Gemm g, const Sched& S, const Epi& E) {
    const int tid = threadIdx.x, wid = __builtin_amdgcn_readfirstlane(tid >> 6), lane = tid & 63, wr = wid >> 2, wc = wid & 3, fr = lane & 15, fq = lane >> 4;
    const int K = g.K, nt = K / BK;
    unsigned voffA[2], voffB[2];
#pragma unroll
    for (int i = 0; i < 2; ++i) { int R, C; stage_rc(tid * 16 + i * 8192, R, C); const int Rb = Epi::PERM ? ((R & ~31) + perm32(R & 31)) : R;
        voffA[i] = (unsigned)(R * K + C) * 2u; voffB[i] = (unsigned)(Rb * K + C) * 2u; }
    const size_t kstep = (size_t)(BK * 2);
    const size_t hstep = (size_t)HALF * K * 2;
    const size_t tstep = 2 * hstep;
    const unsigned ldsw = (unsigned)wid * 1024u;
    const int aoff = lds_byte(wr * 64 + fr, fq * 8), boff = lds_byte(wc * 32 + fr, fq * 8);
#define PG8_SA(b, h) (((b) * 2 + (h)) * HTB)
#define PG8_SB(b, h) ((4 + (b) * 2 + (h)) * HTB)
#define PG8_STAGE(bufoff, gbase, voff) do { _Pragma("unroll") for (int _i = 0; _i < 2; ++_i) \
        __builtin_amdgcn_global_load_lds((const unsigned*)((const char*)(gbase) + (voff)[_i]), (LAS unsigned*)(lds + (bufoff) + ldsw + _i * 8192), 16, 0, 0); } while (0)
#define PG8_LDA(dst, b, h) do { _Pragma("unroll") for (int m = 0; m < 4; ++m) _Pragma("unroll") for (int k = 0; k < 2; ++k) dst[m][k] = *(const LAS bf16x8*)(lds + PG8_SA(b, h) + aoff + m * 2048 + k * 1024); } while (0)
#define PG8_LDB(dst, b, h) do { _Pragma("unroll") for (int n = 0; n < 2; ++n) _Pragma("unroll") for (int k = 0; k < 2; ++k) dst[n][k] = *(const LAS bf16x8*)(lds + PG8_SB(b, h) + boff + n * 2048 + k * 1024); } while (0)
#define PG8_MMA(ai, bj, At, Bt) do { __builtin_amdgcn_s_setprio(1); _Pragma("unroll") for (int m = 0; m < 4; ++m) _Pragma("unroll") for (int n = 0; n < 2; ++n) _Pragma("unroll") for (int k = 0; k < 2; ++k) \
        acc[ai][bj][m][n] = __builtin_amdgcn_mfma_f32_16x16x32_bf16(Bt[n][k], At[m][k], acc[ai][bj][m][n], 0, 0, 0); __builtin_amdgcn_s_setprio(0); } while (0)
#define PG8_WAIT_V(n) asm volatile("s_waitcnt vmcnt(" #n ")" ::: "memory")
#define PG8_WAIT_L(n) asm volatile("s_waitcnt lgkmcnt(" #n ")" ::: "memory")
#define PG8_BAR __builtin_amdgcn_s_barrier()
#define PG8_SCHED __builtin_amdgcn_sched_barrier(0)
    Unit cur, nxt; int ui = 0;
    if (!S.next(0, cur)) return;
    f32x4 acc[2][2][4][2];
#pragma unroll
    for (int a = 0; a < 2; ++a)
#pragma unroll
        for (int b = 0; b < 2; ++b)
#pragma unroll
            for (int m = 0; m < 4; ++m)
#pragma unroll
                for (int n = 0; n < 2; ++n) acc[a][b][m][n] = (f32x4){0.f, 0.f, 0.f, 0.f};
    bf16x8 At[4][2], B0[2][2], B1[2][2];
    const char* cA = (const char*)g.A + (size_t)cur.pm * tstep; const char* cB = (const char*)g.Bt + (size_t)cur.pn * tstep;
    PG8_STAGE(PG8_SB(0, 0), cB, voffB); PG8_STAGE(PG8_SA(0, 0), cA, voffA); PG8_STAGE(PG8_SB(0, 1), cB + hstep, voffB); PG8_STAGE(PG8_SA(0, 1), cA + hstep, voffA);
    if (wr == 1) PG8_BAR;
    PG8_WAIT_V(4); PG8_BAR;
    PG8_STAGE(PG8_SB(1, 0), cB + kstep, voffB); PG8_STAGE(PG8_SA(1, 0), cA + kstep, voffA); PG8_STAGE(PG8_SB(1, 1), cB + hstep + kstep, voffB);
    PG8_WAIT_V(6); PG8_BAR;
    for (;;) {
        const bool has_next = S.next(ui + 1, nxt);
        const char* nA = has_next ? (const char*)g.A + (size_t)nxt.pm * tstep : cA; const char* nB = has_next ? (const char*)g.Bt + (size_t)nxt.pn * tstep : cB;
        for (int t = 0; t < nt; t += 2) {
            const bool last = (t == nt - 2);
            const char* a1 = cA + (size_t)(t + 1) * kstep;
            const char* a2 = last ? nA : cA + (size_t)(t + 2) * kstep; const char* b2 = last ? nB : cB + (size_t)(t + 2) * kstep;
            const char* a3 = a2 + kstep; const char* b3 = b2 + kstep;
            PG8_LDB(B0, 0, 0); PG8_SCHED; PG8_LDA(At, 0, 0); PG8_STAGE(PG8_SA(1, 1), a1 + hstep, voffA);
            PG8_WAIT_L(8); PG8_BAR; PG8_WAIT_L(0); PG8_MMA(0, 0, At, B0); PG8_BAR; PG8_SCHED;
            PG8_LDB(B1, 0, 1); PG8_STAGE(PG8_SB(0, 0), b2, voffB);
            PG8_BAR; PG8_WAIT_L(0); PG8_MMA(0, 1, At, B1); PG8_BAR;
            PG8_LDA(At, 0, 1); PG8_STAGE(PG8_SA(0, 0), a2, voffA);
            PG8_BAR; PG8_WAIT_L(0); PG8_MMA(1, 0, At, B0); PG8_BAR; PG8_SCHED;
            PG8_STAGE(PG8_SB(0, 1), b2 + hstep, voffB);
            PG8_WAIT_V(6); PG8_BAR; PG8_MMA(1, 1, At, B1); PG8_BAR;
            PG8_LDB(B0, 1, 0); PG8_SCHED; PG8_LDA(At, 1, 0); PG8_STAGE(PG8_SA(0, 1), a2 + hstep, voffA);
            PG8_WAIT_L(8); PG8_BAR; PG8_WAIT_L(0); PG8_MMA(0, 0, At, B0); PG8_BAR; PG8_SCHED;
            PG8_LDB(B1, 1, 1); PG8_STAGE(PG8_SB(1, 0), b3, voffB);
            PG8_BAR; PG8_WAIT_L(0); PG8_MMA(0, 1, At, B1); PG8_BAR;
            PG8_LDA(At, 1, 1); PG8_STAGE(PG8_SA(1, 0), a3, voffA);
            PG8_BAR; PG8_WAIT_L(0); PG8_MMA(1, 0, At, B0); PG8_BAR; PG8_SCHED;
            PG8_STAGE(PG8_SB(1, 1), b3 + hstep, voffB);
            PG8_WAIT_V(6); PG8_BAR; PG8_MMA(1, 1, At, B1); PG8_BAR;
        }
        E(acc, cur, wr, wc, fr, fq);
        if (!has_next) break;
#pragma unroll
        for (int a = 0; a < 2; ++a)
#pragma unroll
            for (int b = 0; b < 2; ++b)
#pragma unroll
                for (int m = 0; m < 4; ++m)
#pragma unroll
                    for (int n = 0; n < 2; ++n) acc[a][b][m][n] = (f32x4){0.f, 0.f, 0.f, 0.f};
        cur = nxt; cA = nA; cB = nB; ++ui;
    }
    PG8_WAIT_V(0);
    if (wr == 0) PG8_BAR;
    PG8_BAR;
#undef PG8_SA
#undef PG8_SB
#undef PG8_STAGE
#undef PG8_LDA
#undef PG8_LDB
#undef PG8_MMA
#undef PG8_WAIT_V
#undef PG8_WAIT_L
#undef PG8_BAR
#undef PG8_SCHED
}
}

__device__ __forceinline__ void p0_transpose_item(const float* W, int N, bf16_t* WT, int ldk, int k0, int n0, long dst_row0, LAS float* scr, int lane, const float* gk = nullptr) {
    float wv[32];
#pragma unroll
    for (int i = 0; i < 32; ++i) { const int kk = 2 * i + (lane >> 5); wv[i] = __builtin_nontemporal_load(W + (size_t)(k0 + kk) * N + n0 + (lane & 31)); }
#pragma unroll
    for (int i = 0; i < 32; ++i) { const int kk = 2 * i + (lane >> 5); scr[kk * 33 + (lane & 31)] = wv[i] * (gk ? gk[k0 + kk] : 1.0f); }
    if (false)
    for (int i = 0; i < 32; ++i) { const int kk = 2 * i + (lane >> 5); scr[kk * 33 + (lane & 31)] = __builtin_nontemporal_load(W + (size_t)(k0 + kk) * N + n0 + (lane & 31)) * (gk ? gk[k0 + kk] : 1.0f); }
    asm volatile("s_waitcnt lgkmcnt(0)" ::: "memory");
    const int c = lane & 7;
#pragma unroll
    for (int j = 0; j < 4; ++j) { const int n = (lane >> 3) + 8 * j; const LAS float* s = scr + (8 * c) * 33 + n;
        u32x4 o; o.x = cvt_pk_bf16(s[0 * 33], s[1 * 33]); o.y = cvt_pk_bf16(s[2 * 33], s[3 * 33]); o.z = cvt_pk_bf16(s[4 * 33], s[5 * 33]); o.w = cvt_pk_bf16(s[6 * 33], s[7 * 33]);
        *(u32x4*)(WT + (size_t)(dst_row0 + n) * ldk + k0 + 8 * c) = o; }
    asm volatile("s_waitcnt lgkmcnt(0)" ::: "memory");
}

__device__ __forceinline__ void weight_items(const Args& a, LAS unsigned char* lds, int wid, int lane, int it_lo, int it_hi, int first, int step) {
    unsigned char* ws = a.ws;
    LAS float* scr = (LAS float*)(lds + wid * 16384);
    constexpr int I_IN = 32 * 160, I_OUT = 32 * 64, I_G = 32 * 176, I_U = I_G, I_D = 88 * 64, I_PG = 32 * 64, I_PP = 4 * 64, I_RG = 32 * 8;
    constexpr int NITEMS = I_IN + I_OUT + I_G + I_U + I_D + I_PG + I_PP + I_RG;
    for (int it = it_lo + first; it < it_hi; it += step) {
        int r = it;
        if (r < I_IN) { const int kb = r / 160, nb = r % 160; p0_transpose_item(a.in[3], DIN, (bf16_t*)(ws + WS_WIN), DM, kb * 64, nb * 32, nb * 32, scr, lane); continue; } r -= I_IN;
        if (r < I_OUT) { const int kb = r / 64, nb = r % 64; p0_transpose_item(a.in[14], DM, (bf16_t*)(ws + WS_WOUT), DM, kb * 64, nb * 32, nb * 32, scr, lane); continue; } r -= I_OUT;
        if (r < I_G) { const int kb = r / 176, nb = r % 176, n0 = nb * 32; p0_transpose_item(a.in[17], DFF, (bf16_t*)(ws + WS_WGU), DM, kb * 64, n0, (n0 >> 7) * 256 + (n0 & 127), scr, lane, a.in[16]); continue; } r -= I_G;
        if (r < I_U) { const int kb = r / 176, nb = r % 176, n0 = nb * 32; p0_transpose_item(a.in[18], DFF, (bf16_t*)(ws + WS_WGU), DM, kb * 64, n0, (n0 >> 7) * 256 + 128 + (n0 & 127), scr, lane, a.in[16]); continue; } r -= I_U;
        if (r < I_D) { const int kb = r / 64, nb = r % 64; p0_transpose_item(a.in[19], DM, (bf16_t*)(ws + WS_WD), DFF, kb * 64, nb * 32, nb * 32, scr, lane); continue; } r -= I_D;
        if (r < I_PG) { const int kb = r / 64, nb = r % 64; p0_transpose_item(a.in[22], DM, (bf16_t*)(ws + WS_WPG), DM, kb * 64, nb * 32, nb * 32, scr, lane, a.in[21]); continue; } r -= I_PG;
        if (r < I_PP) { const int kb = r / 64, nb = r % 64; p0_transpose_item(a.in[23], DM, (bf16_t*)(ws + WS_WPP), DPLE, kb * 64, nb * 32, nb * 32, scr, lane); continue; } r -= I_PP;
        { const int mat = r >> 3, sub = r & 7, kb = sub >> 2, nb = sub & 3; const int zn = mat & 15, z = zn >> 3, n = zn & 7, ty = (mat >> 4) * 2 + z;
          const float* src = (mat < 16 ? a.in[7] : a.in[9]) + (size_t)zn * 16384;
          p0_transpose_item(src, 128, (bf16_t*)(ws + WS_WG), 128, kb * 64, nb * 32, n * 512 + ty * 128 + nb * 32, scr, lane); }
    }
}

__device__ __forceinline__ void p0_phase(const Args& a, LAS unsigned char* lds, int tid, int wid, int lane) {
    unsigned char* ws = a.ws;
    LAS float* scr = (LAS float*)(lds + wid * 16384);
    const int gw = blockIdx.x * 8 + wid, NGW = gridDim.x * 8;
    constexpr int I_IN = 32 * 160, I_LATE = 32 * 64 + 3 * (32 * 176) + 32 * 64, I_TAIL = 4 * 64 + 32 * 8;
    if (gridDim.x == 256) { weight_items(a, lds, wid, lane, 0, I_IN, gw, NGW); weight_items(a, lds, wid, lane, I_IN + I_LATE, I_IN + I_LATE + I_TAIL, gw, NGW); }
    else weight_items(a, lds, wid, lane, 0, I_IN + I_LATE + I_TAIL, gw, NGW);
    if (blockIdx.x == 0) { unsigned* bz = (unsigned*)(ws + WS_BAR); for (int i = tid; i < 3456; i += 512) __hip_atomic_store(bz + i, 0u, __ATOMIC_RELAXED, __HIP_MEMORY_SCOPE_AGENT); }
    const float* x = a.in[0]; const float* g = a.in[2]; bf16_t* XN = (bf16_t*)(ws + WS_XN);
    for (int m = gw; m < MTOK; m += NGW) {
        const f32x4* xr = (const f32x4*)(x + (size_t)m * DM);
        f32x4 v[8]; float s = 0.f;
#pragma unroll
        for (int j = 0; j < 8; ++j) { v[j] = __builtin_nontemporal_load(xr + j * 64 + lane); s += (v[j].x * v[j].x + v[j].y * v[j].y) + (v[j].z * v[j].z + v[j].w * v[j].w); }
        const float rs = rsqrtf(wave_sum(s) * (1.f / DM) + EPS);
        u32x2* o = (u32x2*)(XN + (size_t)m * DM);
#pragma unroll
        for (int j = 0; j < 8; ++j) { const f32x4 gv = ((const f32x4*)g)[j * 64 + lane]; u32x2 w; w.x = cvt_pk_bf16(v[j].x * rs * gv.x, v[j].y * rs * gv.y); w.y = cvt_pk_bf16(v[j].z * rs * gv.z, v[j].w * rs * gv.w); o[j * 64 + lane] = w; }
    }
    const f32x4* p4 = (const f32x4*)a.in[1]; u32x2* pb = (u32x2*)(ws + WS_PB);
    {
        const size_t tot = (size_t)MTOK * DPLE / 4, strd = (size_t)gridDim.x * 512;
        for (size_t i0 = (size_t)blockIdx.x * 512 + tid; i0 < tot; i0 += 8 * strd) { f32x4 v[8];
#pragma unroll
            for (int k = 0; k < 8; ++k) { const size_t i = i0 + k * strd; v[k] = (i < tot) ? __builtin_nontemporal_load(p4 + i) : (f32x4){0.f, 0.f, 0.f, 0.f}; }
#pragma unroll
            for (int k = 0; k < 8; ++k) { const size_t i = i0 + k * strd; if (i < tot) { u32x2 w; w.x = cvt_pk_bf16(v[k].x, v[k].y); w.y = cvt_pk_bf16(v[k].z, v[k].w); pb[i] = w; } } }
    }
}

__device__ __forceinline__ void attn_phase(const Args& a, LAS unsigned char* lds, int tid, int wid, int lane, int it_base, int it_step, int it_n, int hi_begin, int hi_end) {
    const bf16_t* U = (const bf16_t*)(a.ws + WS_U); bf16_t* A2 = (bf16_t*)(a.ws + WS_A2); float* patt = (float*)(a.ws + WS_PATT);
    LAS float* rp = (LAS float*)(lds + 65536);
    for (int i = tid; i < 8 * 15 * 31; i += 512) rp[i] = a.in[4][i];
    __syncthreads();
    const int qb = wid & 3, hh = wid >> 2, l15_0 = lane & 15, lq_0 = lane >> 4;
    int l15 = l15_0, lq = lq_0;
    const unsigned vbase = (unsigned)wid * 8192u;
    const unsigned traddr = vbase + (unsigned)((4 * lq + (l15 >> 2)) * 256 + (4 * (lane & 3)) * 2);
    const float LOG2E = 1.4426950408889634f, SC = 0.08838834764831845f * 1.4426950408889634f;
    for (int ii = 0; ii < it_n; ++ii) {
        const int it = it_base + ii * it_step;
        const int b = it >> 7, r = it & 127;
        const int rstart = min(max(r - 4, 0), 120);
        const int kc0 = min(max(16 * qb - 8, 0), 32);
        const int qcol = 16 * qb + l15, cstart = min(max(qcol - 8, 0), 48);
        const size_t tokq = (size_t)b * SEQ + r * 64 + qcol;
        for (int hi = hi_begin; hi < hi_end; ++hi) {
            l15 = l15_0; lq = lq_0; asm volatile("" : "+v"(l15), "+v"(lq));
            const int h = 2 * hi + hh;
            bf16x8 qf[4]; { const bf16_t* qp = U + tokq * DIN + h * 128 + lq * 8;
#pragma unroll
                for (int ks = 0; ks < 4; ++ks) qf[ks] = *(const bf16x8*)(qp + ks * 32); }
            f32x4 sT[16];
            bf16x8 kf[3][2][4];
#define LOADK(buf, Tg_) do { _Pragma("unroll") for (int tt = 0; tt < 2; ++tt) { const int T = (Tg_) * 2 + tt; \
                const bf16_t* kp = U + ((size_t)b * SEQ + (rstart + (T >> 1)) * 64 + kc0 + 16 * (T & 1) + l15) * DIN + 1024 + h * 128 + lq * 8; \
                _Pragma("unroll") for (int ks = 0; ks < 4; ++ks) kf[buf][tt][ks] = *(const bf16x8*)(kp + ks * 32); } } while (0)
            LOADK(0, 0); LOADK(1, 1);
#pragma unroll
            for (int Tg = 0; Tg < 8; ++Tg) {
                if (Tg < 6) LOADK((Tg + 2) % 3, Tg + 2);
                __builtin_amdgcn_sched_barrier(0);
#pragma unroll
                for (int tt = 0; tt < 2; ++tt) { f32x4 s_ = (f32x4){0.f, 0.f, 0.f, 0.f};
#pragma unroll
                    for (int ks = 0; ks < 4; ++ks) s_ = __builtin_amdgcn_mfma_f32_16x16x32_bf16(kf[Tg % 3][tt][ks], qf[ks], s_, 0, 0, 0);
                    sT[Tg * 2 + tt] = s_; }
                __builtin_amdgcn_sched_barrier(0);
            }
#undef LOADK
            float mx = -1e30f;
#pragma unroll
            for (int T = 0; T < 16; ++T) {
                const int dr = rstart + (T >> 1) - r + 7;
#pragma unroll
                for (int j = 0; j < 4; ++j) {
                    const int kc = kc0 + 16 * (T & 1) + 4 * lq + j; const bool valid = (kc >= cstart) && (kc < cstart + 16);
                    const int dc = min(max(kc - qcol + 15, 0), 30);
                    const float bias = rp[(h * 15 + dr) * 31 + dc];
                    const float t = valid ? (sT[T][j] * SC + bias * LOG2E) : -1e30f;
                    sT[T][j] = t; mx = fmaxf(mx, t);
                }
            }
            mx = fmaxf(mx, __shfl_xor(mx, 16)); mx = fmaxf(mx, __shfl_xor(mx, 32));
            float sum = 0.f;
#pragma unroll
            for (int T = 0; T < 16; ++T)
#pragma unroll
                for (int j = 0; j < 4; ++j) { const float p = __builtin_amdgcn_exp2f(sT[T][j] - mx); sT[T][j] = p; sum += p; }
            sum += __shfl_xor(sum, 16); sum += __shfl_xor(sum, 32);
            union PF { u32x4 u; bf16x8 v; }; PF pf[8];
#pragma unroll
            for (int kr = 0; kr < 8; ++kr) {
                pf[kr].u.x = cvt_pk_bf16(sT[2 * kr][0], sT[2 * kr][1]); pf[kr].u.y = cvt_pk_bf16(sT[2 * kr][2], sT[2 * kr][3]);
                pf[kr].u.z = cvt_pk_bf16(sT[2 * kr + 1][0], sT[2 * kr + 1][1]); pf[kr].u.w = cvt_pk_bf16(sT[2 * kr + 1][2], sT[2 * kr + 1][3]); }
            f32x4 oT[8];
#pragma unroll
            for (int dt = 0; dt < 8; ++dt) oT[dt] = (f32x4){0.f, 0.f, 0.f, 0.f};
            u32x4 vst[3][8];
#define LOADV(buf, kr_) do { const bf16_t* vp = U + ((size_t)b * SEQ + (rstart + (kr_)) * 64 + kc0) * DIN + 2048 + h * 128; \
                _Pragma("unroll") for (int jj = 0; jj < 8; ++jj) { const int c = jj * 64 + lane; vst[buf][jj] = *(const u32x4*)(vp + (size_t)(c >> 4) * DIN + (c & 15) * 8); } } while (0)
            LOADV(0, 0); LOADV(1, 1);
#pragma unroll
            for (int kr = 0; kr < 8; ++kr) {
#pragma unroll
                for (int jj = 0; jj < 8; ++jj) { const int c = jj * 64 + lane; *(LAS u32x4*)(lds + vbase + (c >> 4) * 256 + (c & 15) * 16) = vst[kr % 3][jj]; }
                if (kr < 6) { __builtin_amdgcn_sched_barrier(0); LOADV((kr + 2) % 3, kr + 2); __builtin_amdgcn_sched_barrier(0); }
                s16x4 t0, t1, t2, t3, t4, t5, t6, t7, t8, t9, t10, t11, t12, t13, t14, t15;
                asm volatile("s_waitcnt lgkmcnt(0)\n\t"
                             "ds_read_b64_tr_b16 %0, %16 offset:0\n\t"   "ds_read_b64_tr_b16 %1, %16 offset:4096\n\t"
                             "ds_read_b64_tr_b16 %2, %16 offset:32\n\t"  "ds_read_b64_tr_b16 %3, %16 offset:4128\n\t"
                             "ds_read_b64_tr_b16 %4, %16 offset:64\n\t"  "ds_read_b64_tr_b16 %5, %16 offset:4160\n\t"
                             "ds_read_b64_tr_b16 %6, %16 offset:96\n\t"  "ds_read_b64_tr_b16 %7, %16 offset:4192\n\t"
                             "ds_read_b64_tr_b16 %8, %16 offset:128\n\t" "ds_read_b64_tr_b16 %9, %16 offset:4224\n\t"
                             "ds_read_b64_tr_b16 %10, %16 offset:160\n\t" "ds_read_b64_tr_b16 %11, %16 offset:4256\n\t"
                             "ds_read_b64_tr_b16 %12, %16 offset:192\n\t" "ds_read_b64_tr_b16 %13, %16 offset:4288\n\t"
                             "ds_read_b64_tr_b16 %14, %16 offset:224\n\t" "ds_read_b64_tr_b16 %15, %16 offset:4320\n\t"
                             "s_waitcnt lgkmcnt(0)"
                             : "=&v"(t0), "=&v"(t1), "=&v"(t2), "=&v"(t3), "=&v"(t4), "=&v"(t5), "=&v"(t6), "=&v"(t7),
                               "=&v"(t8), "=&v"(t9), "=&v"(t10), "=&v"(t11), "=&v"(t12), "=&v"(t13), "=&v"(t14), "=&v"(t15)
                             : "v"(traddr) : "memory");
#define PV_MMA(dt, lo, hi) { bf16x8 vf; vf[0] = lo[0]; vf[1] = lo[1]; vf[2] = lo[2]; vf[3] = lo[3]; vf[4] = hi[0]; vf[5] = hi[1]; vf[6] = hi[2]; vf[7] = hi[3]; \
                    oT[dt] = __builtin_amdgcn_mfma_f32_16x16x32_bf16(vf, pf[kr].v, oT[dt], 0, 0, 0); }
                PV_MMA(0, t0, t1) PV_MMA(1, t2, t3) PV_MMA(2, t4, t5) PV_MMA(3, t6, t7) PV_MMA(4, t8, t9) PV_MMA(5, t10, t11) PV_MMA(6, t12, t13) PV_MMA(7, t14, t15)
#undef PV_MMA
            }
#undef LOADV
            const float inv = 1.0f / sum; float ss = 0.f;
            bf16_t* op = A2 + tokq * DM + h * 128 + 4 * lq;
#pragma unroll
            for (int dt = 0; dt < 8; ++dt) { const f32x4 o = oT[dt] * inv; ss += (o[0] * o[0] + o[1] * o[1]) + (o[2] * o[2] + o[3] * o[3]);
                u32x2 w; w.x = cvt_pk_bf16(o[0], o[1]); w.y = cvt_pk_bf16(o[2], o[3]); *(u32x2*)(op + 16 * dt) = w; }
            ss += __shfl_xor(ss, 16); ss += __shfl_xor(ss, 32);
            if (lq == 0) patt[tokq * 8 + h] = ss;
        }
    }
    __syncthreads();
}

__device__ __forceinline__ void attn2_phase(const Args& a, LAS unsigned char* lds, int tid, int wid, int lane, int it_base, int it_step, int it_n, int hi_begin, int hi_end) {
    const bf16_t* U = (const bf16_t*)(a.ws + WS_U); bf16_t* A2 = (bf16_t*)(a.ws + WS_A2); float* patt = (float*)(a.ws + WS_PATT);
    constexpr int SLAB = 2 * 64 * 272, RPB_OFF = 2 * SLAB;
    LAS float* rp = (LAS float*)(lds + RPB_OFF);
    for (int i = tid; i < 8 * 15 * 31; i += 512) rp[i] = a.in[4][i];
    __syncthreads();
    const int qb = wid & 3, hh = wid >> 2, l15_0 = lane & 15, lq_0 = lane >> 4;
    const int s_h = tid >> 8, s_col = (tid >> 2) & 63, s_q = tid & 3;
    const unsigned s_lds = (unsigned)(s_h * (64 * 272) + s_col * 272 + s_q * 64);
    const float LOG2E = 1.4426950408889634f, SC = 0.08838834764831845f * 1.4426950408889634f;
    for (int ii = 0; ii < it_n; ++ii) {
        const int it = it_base + ii * it_step;
        const int b = it >> 7, r = it & 127;
        const int rstart = min(max(r - 4, 0), 120);
        const int kc0 = min(max(16 * qb - 8, 0), 32);
        for (int hi = hi_begin; hi < hi_end; ++hi) {
            int l15 = l15_0, lq = lq_0; asm volatile("" : "+v"(l15), "+v"(lq));
            const int qcol = 16 * qb + l15, cstart = min(max(qcol - 8, 0), 48);
            const size_t tokq = (size_t)b * SEQ + r * 64 + qcol;
            const int h = 2 * hi + hh;
            bf16x8 qf[4]; { const bf16_t* qp = U + tokq * DIN + h * 128 + lq * 8;
#pragma unroll
                for (int ks = 0; ks < 4; ++ks) qf[ks] = __builtin_nontemporal_load((const bf16x8*)(qp + ks * 32)); }
            const bf16_t* sbase = U + ((size_t)b * SEQ + rstart * 64 + s_col) * DIN + 1024 + (2 * hi + s_h) * 128 + s_q * 32;
            u32x4 st[2][4];
#define LOADS(set, j_) do { const bf16_t* sp = sbase + (size_t)((j_) & 7) * 64 * DIN + ((j_) >> 3) * 1024; \
                _Pragma("unroll") for (int e = 0; e < 4; ++e) st[set][e] = *(const u32x4*)(sp + e * 8); } while (0)
#define WRITES(set, buf) do { _Pragma("unroll") for (int e = 0; e < 4; ++e) *(LAS u32x4*)(lds + (buf) * SLAB + s_lds + e * 16) = st[set][e]; } while (0)
            LOADS(0, 0); LOADS(1, 1);
            __syncthreads();
            WRITES(0, 0); LOADS(0, 2);
            f32x4 sT[16]; f32x4 oT[8]; union PF { u32x4 u; bf16x8 v; }; PF pf[8]; float sum = 0.f;
#pragma unroll
            for (int dt = 0; dt < 8; ++dt) oT[dt] = (f32x4){0.f, 0.f, 0.f, 0.f};
#pragma clang loop unroll(full)
            for (int j = 0; j < 16; ++j) {
                __syncthreads();
                if (j == 8) {
                    float mx = -1e30f;
#pragma unroll
                    for (int T = 0; T < 16; ++T) { const int dr = rstart + (T >> 1) - r + 7;
#pragma unroll
                        for (int jj = 0; jj < 4; ++jj) { const int kc = kc0 + 16 * (T & 1) + 4 * lq + jj; const bool valid = (kc >= cstart) && (kc < cstart + 16);
                            const int dc = min(max(kc - qcol + 15, 0), 30); const float bias = rp[(h * 15 + dr) * 31 + dc];
                            const float t = valid ? (sT[T][jj] * SC + bias * LOG2E) : -1e30f; sT[T][jj] = t; mx = fmaxf(mx, t); } }
                    mx = fmaxf(mx, __shfl_xor(mx, 16)); mx = fmaxf(mx, __shfl_xor(mx, 32));
#pragma unroll
                    for (int T = 0; T < 16; ++T)
#pragma unroll
                        for (int jj = 0; jj < 4; ++jj) { const float p = __builtin_amdgcn_exp2f(sT[T][jj] - mx); sT[T][jj] = p; sum += p; }
                    sum += __shfl_xor(sum, 16); sum += __shfl_xor(sum, 32);
#pragma unroll
                    for (int kr = 0; kr < 8; ++kr) {
                        pf[kr].u.x = cvt_pk_bf16(sT[2 * kr][0], sT[2 * kr][1]); pf[kr].u.y = cvt_pk_bf16(sT[2 * kr][2], sT[2 * kr][3]);
                        pf[kr].u.z = cvt_pk_bf16(sT[2 * kr + 1][0], sT[2 * kr + 1][1]); pf[kr].u.w = cvt_pk_bf16(sT[2 * kr + 1][2], sT[2 * kr + 1][3]); }
                }
                if (j < 8) {
#pragma unroll
                    for (int tt = 0; tt < 2; ++tt) { f32x4 s_ = (f32x4){0.f, 0.f, 0.f, 0.f};
#pragma unroll
                        for (int ks = 0; ks < 4; ++ks) { const bf16x8 kfr = *(const LAS bf16x8*)(lds + (j & 1) * SLAB + hh * (64 * 272) + (kc0 + 16 * tt + l15) * 272 + (ks * 32 + lq * 8) * 2);
                            s_ = __builtin_amdgcn_mfma_f32_16x16x32_bf16(kfr, qf[ks], s_, 0, 0, 0); }
                        sT[j * 2 + tt] = s_; }
                } else {
                    const unsigned traddr = (unsigned)((j & 1) * SLAB + hh * (64 * 272) + (kc0 + 4 * lq + (l15 >> 2)) * 272 + (4 * (lane & 3)) * 2);
                    s16x4 t0, t1, t2, t3, t4, t5, t6, t7, t8, t9, t10, t11, t12, t13, t14, t15;
                    asm volatile("s_waitcnt lgkmcnt(0)\n\t"
                                 "ds_read_b64_tr_b16 %0, %16 offset:0\n\t"   "ds_read_b64_tr_b16 %1, %16 offset:4352\n\t"
                                 "ds_read_b64_tr_b16 %2, %16 offset:32\n\t"  "ds_read_b64_tr_b16 %3, %16 offset:4384\n\t"
                                 "ds_read_b64_tr_b16 %4, %16 offset:64\n\t"  "ds_read_b64_tr_b16 %5, %16 offset:4416\n\t"
                                 "ds_read_b64_tr_b16 %6, %16 offset:96\n\t"  "ds_read_b64_tr_b16 %7, %16 offset:4448\n\t"
                                 "ds_read_b64_tr_b16 %8, %16 offset:128\n\t" "ds_read_b64_tr_b16 %9, %16 offset:4480\n\t"
                                 "ds_read_b64_tr_b16 %10, %16 offset:160\n\t" "ds_read_b64_tr_b16 %11, %16 offset:4512\n\t"
                                 "ds_read_b64_tr_b16 %12, %16 offset:192\n\t" "ds_read_b64_tr_b16 %13, %16 offset:4544\n\t"
                                 "ds_read_b64_tr_b16 %14, %16 offset:224\n\t" "ds_read_b64_tr_b16 %15, %16 offset:4576\n\t"
                                 "s_waitcnt lgkmcnt(0)"
                                 : "=&v"(t0), "=&v"(t1), "=&v"(t2), "=&v"(t3), "=&v"(t4), "=&v"(t5), "=&v"(t6), "=&v"(t7),
                                   "=&v"(t8), "=&v"(t9), "=&v"(t10), "=&v"(t11), "=&v"(t12), "=&v"(t13), "=&v"(t14), "=&v"(t15)
                                 : "v"(traddr) : "memory");
#define PV_MMA(dt, lo, hi_) { bf16x8 vf; vf[0] = lo[0]; vf[1] = lo[1]; vf[2] = lo[2]; vf[3] = lo[3]; vf[4] = hi_[0]; vf[5] = hi_[1]; vf[6] = hi_[2]; vf[7] = hi_[3]; \
                        oT[dt] = __builtin_amdgcn_mfma_f32_16x16x32_bf16(vf, pf[j - 8].v, oT[dt], 0, 0, 0); }
                    PV_MMA(0, t0, t1) PV_MMA(1, t2, t3) PV_MMA(2, t4, t5) PV_MMA(3, t6, t7) PV_MMA(4, t8, t9) PV_MMA(5, t10, t11) PV_MMA(6, t12, t13) PV_MMA(7, t14, t15)
#undef PV_MMA
                }
                if (j < 15) { WRITES((j + 1) & 1, (j + 1) & 1); if (j < 13) LOADS((j + 1) & 1, j + 3); }
            }
#undef LOADS
#undef WRITES
            const float inv = 1.0f / sum; float ss = 0.f;
            bf16_t* op = A2 + tokq * DM + h * 128 + 4 * lq;
#pragma unroll
            for (int dt = 0; dt < 8; ++dt) { const f32x4 o = oT[dt] * inv; ss += (o[0] * o[0] + o[1] * o[1]) + (o[2] * o[2] + o[3] * o[3]);
                u32x2 w; w.x = cvt_pk_bf16(o[0], o[1]); w.y = cvt_pk_bf16(o[2], o[3]); *(u32x2*)(op + 16 * dt) = w; }
            ss += __shfl_xor(ss, 16); ss += __shfl_xor(ss, 32);
            if (lq == 0) patt[tokq * 8 + h] = ss;
        }
    }
    __syncthreads();
}

__device__ __forceinline__ void attn_phase_naive(const Args& a, int wid, int lane) {
    const bf16_t* U = (const bf16_t*)(a.ws + WS_U); bf16_t* A2 = (bf16_t*)(a.ws + WS_A2); float* patt = (float*)(a.ws + WS_PATT);
    const float* rpb = a.in[4];
    const int gw = blockIdx.x * 8 + wid, NGW = gridDim.x * 8;
    for (int wi = gw; wi < MTOK * 8; wi += NGW) {
        const int h = wi & 7, tok = wi >> 3, b = tok >> 13, s = tok & 8191, r = s >> 6, qcol = s & 63;
        const int rstart = min(max(r - 4, 0), 120), cstart = min(max(qcol - 8, 0), 48);
        const unsigned qw = *(const unsigned*)(U + (size_t)tok * DIN + h * 128 + 2 * lane);
        const float q0 = bf_lo(qw) * 0.08838834764831845f, q1 = bf_hi(qw) * 0.08838834764831845f;
        float mx = -1e30f, l = 0.f, o0 = 0.f, o1 = 0.f;
        for (int kr = 0; kr < 8; ++kr)
            for (int kc = 0; kc < 16; ++kc) {
                const size_t kt = (size_t)b * SEQ + (rstart + kr) * 64 + cstart + kc;
                const unsigned kw = *(const unsigned*)(U + kt * DIN + 1024 + h * 128 + 2 * lane);
                const unsigned vw = *(const unsigned*)(U + kt * DIN + 2048 + h * 128 + 2 * lane);
                float d = wave_sum(q0 * bf_lo(kw) + q1 * bf_hi(kw));
                d += rpb[(h * 15 + (rstart + kr - r + 7)) * 31 + (cstart + kc - qcol + 15)];
                const float nm = fmaxf(mx, d), sc = __expf(mx - nm), p = __expf(d - nm);
                l = l * sc + p; o0 = o0 * sc + p * bf_lo(vw); o1 = o1 * sc + p * bf_hi(vw); mx = nm;
            }
        o0 /= l; o1 /= l;
        *(unsigned*)(A2 + (size_t)tok * DM + h * 128 + 2 * lane) = cvt_pk_bf16(o0, o1);
        const float ss = wave_sum(o0 * o0 + o1 * o1);
        if (lane == 0) patt[(size_t)tok * 8 + h] = ss;
    }
}

template <bool FINAL>
__device__ __forceinline__ void rglru_phase(const Args& a, LAS unsigned char* lds, int tid, int wid, int lane) {
    const bf16_t* U = (const bf16_t*)(a.ws + WS_U); bf16_t* A2 = (bf16_t*)(a.ws + WS_A2); float* prec = (float*)(a.ws + WS_PREC);
    float* sumr = (float*)(a.ws + WS_SUM); const bf16_t* WG = (const bf16_t*)(a.ws + WS_WG);
    const float* conv_w = a.in[5]; const float* conv_b = a.in[6]; const float* b_a = a.in[8]; const float* b_i = a.in[10]; const float* lam = a.in[11];
    constexpr int XC_OFF = 0, YG_OFF = 34816, REC_OFF = 69632, RS = 272;
    const int cgp0 = tid & 15, tq0 = tid >> 4, l150 = lane & 15, lq0 = lane >> 4;
    for (int it = blockIdx.x; it < 2048; it += gridDim.x) {
        int cgp = cgp0, tq = tq0, l15 = l150, lq = lq0;
        asm volatile("" : "+v"(cgp), "+v"(tq), "+v"(l15), "+v"(lq));
        const int n = it & 7, c = (it >> 3) & 63, b = it >> 9, t0 = c * 128;
        {
            const int chb = n * 128 + cgp * 8;
            float xin[7][8];
#pragma unroll
            for (int rr = 0; rr < 7; ++rr) { const int ts = t0 + 4 * tq - 2 + rr;
                u32x4 v = (u32x4){0u, 0u, 0u, 0u};
                if (ts >= 0 && ts < SEQ) v = *(const u32x4*)(U + ((size_t)b * SEQ + ts) * DIN + 3072 + chb);
                xin[rr][0] = bf_lo(v.x); xin[rr][1] = bf_hi(v.x); xin[rr][2] = bf_lo(v.y); xin[rr][3] = bf_hi(v.y); xin[rr][4] = bf_lo(v.z); xin[rr][5] = bf_hi(v.z); xin[rr][6] = bf_lo(v.w); xin[rr][7] = bf_hi(v.w); }
            float cw[4][8], cb[8];
#pragma unroll
            for (int j = 0; j < 4; ++j) { const f32x4 w0 = *(const f32x4*)(conv_w + j * DREC + chb), w1 = *(const f32x4*)(conv_w + j * DREC + chb + 4);
                cw[j][0] = w0.x; cw[j][1] = w0.y; cw[j][2] = w0.z; cw[j][3] = w0.w; cw[j][4] = w1.x; cw[j][5] = w1.y; cw[j][6] = w1.z; cw[j][7] = w1.w; }
            { const f32x4 w0 = *(const f32x4*)(conv_b + chb), w1 = *(const f32x4*)(conv_b + chb + 4); cb[0] = w0.x; cb[1] = w0.y; cb[2] = w0.z; cb[3] = w0.w; cb[4] = w1.x; cb[5] = w1.y; cb[6] = w1.z; cb[7] = w1.w; }
#pragma unroll
            for (int i = 0; i < 4; ++i) { float o[8];
#pragma unroll
                for (int e = 0; e < 8; ++e) o[e] = cb[e] + cw[0][e] * xin[i][e] + cw[1][e] * xin[i + 1][e] + cw[2][e] * xin[i + 2][e] + cw[3][e] * xin[i + 3][e];
                u32x4 w; w.x = cvt_pk_bf16(o[0], o[1]); w.y = cvt_pk_bf16(o[2], o[3]); w.z = cvt_pk_bf16(o[4], o[5]); w.w = cvt_pk_bf16(o[6], o[7]);
                *(LAS u32x4*)(lds + XC_OFF + (4 * tq + i) * RS + cgp * 16) = w; }
            if (FINAL) {
#pragma unroll
                for (int i = 0; i < 4; ++i) { const u32x4 v = *(const u32x4*)(U + ((size_t)b * SEQ + t0 + 4 * tq + i) * DIN + 4096 + chb); *(LAS u32x4*)(lds + YG_OFF + (4 * tq + i) * RS + cgp * 16) = v; }
            }
        }
        __syncthreads();
        const int chl = 16 * wid + l15, gch = n * 128 + chl;
        float cend[2], ptot[2];
        f32x4 hs[8];
#pragma unroll
        for (int dir = 0; dir < 2; ++dir) {
            f32x4 acc[2][8];
#pragma unroll
            for (int ty = 0; ty < 2; ++ty)
#pragma unroll
                for (int mt = 0; mt < 8; ++mt) acc[ty][mt] = (f32x4){0.f, 0.f, 0.f, 0.f};
#pragma unroll
            for (int ks = 0; ks < 4; ++ks) {
                bf16x8 af[8];
#pragma unroll
                for (int mt = 0; mt < 8; ++mt) af[mt] = *(const LAS bf16x8*)(lds + XC_OFF + (16 * mt + l15) * RS + (ks * 32 + lq * 8) * 2);
#pragma unroll
                for (int ty = 0; ty < 2; ++ty) { const bf16x8 wf = *(const bf16x8*)(WG + (size_t)(n * 512 + (ty * 2 + dir) * 128 + chl) * 128 + ks * 32 + lq * 8);
#pragma unroll
                    for (int mt = 0; mt < 8; ++mt) acc[ty][mt] = __builtin_amdgcn_mfma_f32_16x16x32_bf16(af[mt], wf, acc[ty][mt], 0, 0, 0); }
            }
            __builtin_amdgcn_sched_barrier(0);
            const float ba = b_a[dir * DREC + gch], bi = b_i[dir * DREC + gch];
            const float kf = 8.0f * log1pf(expf(-lam[dir * DREC + gch]));
#pragma unroll
            for (int mt = 0; mt < 8; ++mt) {
#pragma unroll
                for (int r = 0; r < 4; ++r) {
                    const int tt = 16 * mt + 4 * lq + r;
                    const float xcv = bf1(*(const LAS unsigned short*)(lds + XC_OFF + tt * RS + chl * 2));
                    const float rg = fast_sigmoid(acc[0][mt][r] + ba), ig = fast_sigmoid(acc[1][mt][r] + bi), av = __expf(-kf * rg);
                    acc[0][mt][r] = av; acc[1][mt][r] = sqrtf(fmaxf(1.0f - av * av, 0.f)) * ig * xcv;
                }
                __builtin_amdgcn_sched_barrier(0);
            }
            __builtin_amdgcn_sched_barrier(0);
            float cr = 0.f;
            if (FINAL) {
                float P = 1.f, H = 0.f;
                if (dir == 0) { const int lo = lq * 16, hi = min(lo + 16, c);
                    for (int cc = lo; cc < hi; ++cc) { const float* sp = sumr + ((size_t)((b * 64 + cc) * 2 + 0) * 2) * 1024 + gch; const float A = sp[0], Hc = sp[1024]; H = A * H + Hc; P *= A; }
#pragma unroll
                    for (int g = 0; g < 4; ++g) { const float Pg = __shfl(P, g * 16 + l15), Hg = __shfl(H, g * 16 + l15); cr = Pg * cr + Hg; } }
                else { const int lo = max(lq * 16, c + 1), hi = lq * 16 + 16;
                    for (int cc = hi - 1; cc >= lo; --cc) { const float* sp = sumr + ((size_t)((b * 64 + cc) * 2 + 1) * 2) * 1024 + gch; const float A = sp[0], Hc = sp[1024]; H = A * H + Hc; P *= A; }
#pragma unroll
                    for (int g = 3; g >= 0; --g) { const float Pg = __shfl(P, g * 16 + l15), Hg = __shfl(H, g * 16 + l15); cr = Pg * cr + Hg; } }
            }
            __builtin_amdgcn_sched_barrier(0);
            float pt = 1.f;
            if (dir == 0) {
#pragma unroll
                for (int mt = 0; mt < 8; ++mt) {
                    float H = 0.f, P = 1.f, hl[4], pl[4];
#pragma unroll
                    for (int r = 0; r < 4; ++r) { H = acc[0][mt][r] * H + acc[1][mt][r]; P *= acc[0][mt][r]; hl[r] = H; pl[r] = P; }
                    const float P0 = __shfl(P, l15), H0 = __shfl(H, l15), P1 = __shfl(P, 16 + l15), H1 = __shfl(H, 16 + l15), P2 = __shfl(P, 32 + l15), H2 = __shfl(H, 32 + l15), P3 = __shfl(P, 48 + l15), H3 = __shfl(H, 48 + l15);
                    const float c0 = cr, c1 = P0 * c0 + H0, c2 = P1 * c1 + H1, c3 = P2 * c2 + H2, c4 = P3 * c3 + H3;
                    if (FINAL) { const float mine = lq == 0 ? c0 : (lq == 1 ? c1 : (lq == 2 ? c2 : c3));
#pragma unroll
                        for (int r = 0; r < 4; ++r) hs[mt][r] = hl[r] + pl[r] * mine; }
                    else pt *= (P0 * P1) * (P2 * P3);
                    cr = c4;
                }
            } else {
#pragma unroll
                for (int mt = 7; mt >= 0; --mt) {
                    float H = 0.f, P = 1.f, hl[4], pl[4];
#pragma unroll
                    for (int r = 3; r >= 0; --r) { H = acc[0][mt][r] * H + acc[1][mt][r]; P *= acc[0][mt][r]; hl[r] = H; pl[r] = P; }
                    const float P0 = __shfl(P, l15), H0 = __shfl(H, l15), P1 = __shfl(P, 16 + l15), H1 = __shfl(H, 16 + l15), P2 = __shfl(P, 32 + l15), H2 = __shfl(H, 32 + l15), P3 = __shfl(P, 48 + l15), H3 = __shfl(H, 48 + l15);
                    const float c3 = cr, c2 = P3 * c3 + H3, c1 = P2 * c2 + H2, c0 = P1 * c1 + H1, cn = P0 * c0 + H0;
                    if (FINAL) { const float mine = lq == 0 ? c0 : (lq == 1 ? c1 : (lq == 2 ? c2 : c3));
#pragma unroll
                        for (int r = 0; r < 4; ++r) hs[mt][r] += hl[r] + pl[r] * mine; }
                    else pt *= (P0 * P1) * (P2 * P3);
                    cr = cn;
                }
            }
            cend[dir] = cr; ptot[dir] = pt;
            __builtin_amdgcn_sched_barrier(0);
        }
        if (!FINAL) {
            if (lq == 0) { float* sp = sumr + ((size_t)((b * 64 + c) * 2 + 0) * 2) * 1024 + gch; sp[0] = ptot[0]; sp[1024] = cend[0]; sp[2048] = ptot[1]; sp[3072] = cend[1]; }
            __syncthreads();
        } else {
#pragma unroll
            for (int mt = 0; mt < 8; ++mt) {
#pragma unroll
                for (int r = 0; r < 4; ++r) { const int tt = 16 * mt + 4 * lq + r;
                    const float y = bf1(*(const LAS unsigned short*)(lds + YG_OFF + tt * RS + chl * 2));
                    const float z = 0.7978845608028654f * (y + 0.044715f * y * y * y);
                    const float gl = y * fast_sigmoid(2.0f * z);
                    const float v = hs[mt][r] * gl;
                    *(LAS unsigned short*)(lds + REC_OFF + tt * RS + chl * 2) = (unsigned short)(cvt_pk_bf16(v, 0.f) & 0xffffu); }
                __builtin_amdgcn_sched_barrier(0);
            }
            __syncthreads();
            { const int tok = tid >> 2, qtr = tid & 3; float ss = 0.f;
              bf16_t* dst = A2 + ((size_t)b * SEQ + t0 + tok) * DM + DATT + n * 128 + qtr * 32;
#pragma unroll
              for (int j = 0; j < 4; ++j) { const u32x4 v = *(const LAS u32x4*)(lds + REC_OFF + tok * RS + qtr * 64 + j * 16);
                  const float e0 = bf_lo(v.x), e1 = bf_hi(v.x), e2 = bf_lo(v.y), e3 = bf_hi(v.y), e4 = bf_lo(v.z), e5 = bf_hi(v.z), e6 = bf_lo(v.w), e7 = bf_hi(v.w);
                  ss += (e0 * e0 + e1 * e1) + (e2 * e2 + e3 * e3) + (e4 * e4 + e5 * e5) + (e6 * e6 + e7 * e7);
                  *(u32x4*)(dst + j * 8) = v; }
              ss += __shfl_xor(ss, 1); ss += __shfl_xor(ss, 2);
              if (qtr == 0) prec[((size_t)b * SEQ + t0 + tok) * 8 + n] = ss; }
            __syncthreads();
        }
    }
}

template <bool FINAL>
__device__ __forceinline__ void scan2(const f32x4 (&A)[2], const f32x4 (&B)[2], int dir, float cin, int l15, int lq, float& cout, float& ptot, f32x4 (&hout)[2]) {
    float cr = cin, pt = 1.f;
#pragma unroll
    for (int k = 0; k < 2; ++k) {
        if (dir == 0) { const int mt = k;
            float H = 0.f, P = 1.f, hl[4], pl[4];
#pragma unroll
            for (int r = 0; r < 4; ++r) { H = A[mt][r] * H + B[mt][r]; P *= A[mt][r]; hl[r] = H; pl[r] = P; }
            const float P0 = __shfl(P, l15), H0 = __shfl(H, l15), P1 = __shfl(P, 16 + l15), H1 = __shfl(H, 16 + l15), P2 = __shfl(P, 32 + l15), H2 = __shfl(H, 32 + l15), P3 = __shfl(P, 48 + l15), H3 = __shfl(H, 48 + l15);
            const float c0 = cr, c1 = P0 * c0 + H0, c2 = P1 * c1 + H1, c3 = P2 * c2 + H2, c4 = P3 * c3 + H3;
            if (FINAL) { const float mine = lq == 0 ? c0 : (lq == 1 ? c1 : (lq == 2 ? c2 : c3));
#pragma unroll
                for (int r = 0; r < 4; ++r) hout[mt][r] = hl[r] + pl[r] * mine; }
            else pt *= (P0 * P1) * (P2 * P3);
            cr = c4;
        } else { const int mt = 1 - k;
            float H = 0.f, P = 1.f, hl[4], pl[4];
#pragma unroll
            for (int r = 3; r >= 0; --r) { H = A[mt][r] * H + B[mt][r]; P *= A[mt][r]; hl[r] = H; pl[r] = P; }
            const float P0 = __shfl(P, l15), H0 = __shfl(H, l15), P1 = __shfl(P, 16 + l15), H1 = __shfl(H, 16 + l15), P2 = __shfl(P, 32 + l15), H2 = __shfl(H, 32 + l15), P3 = __shfl(P, 48 + l15), H3 = __shfl(H, 48 + l15);
            const float c3 = cr, c2 = P3 * c3 + H3, c1 = P2 * c2 + H2, c0 = P1 * c1 + H1, cn = P0 * c0 + H0;
            if (FINAL) { const float mine = lq == 0 ? c0 : (lq == 1 ? c1 : (lq == 2 ? c2 : c3));
#pragma unroll
                for (int r = 0; r < 4; ++r) hout[mt][r] = hl[r] + pl[r] * mine; }
            else pt *= (P0 * P1) * (P2 * P3);
            cr = cn;
        }
    }
    cout = cr; ptot = pt;
}

__device__ __forceinline__ void rglru_stream_phase(const Args& a, LAS unsigned char* lds, int tid, int wid, int lane) {
    const bf16_t* U = (const bf16_t*)(a.ws + WS_U); bf16_t* A2 = (bf16_t*)(a.ws + WS_A2); bf16_t* HBW = (bf16_t*)(a.ws + WS_Y); const bf16_t* WG = (const bf16_t*)(a.ws + WS_WG);
    const float* conv_w = a.in[5]; const float* conv_b = a.in[6]; const float* b_a = a.in[8]; const float* b_i = a.in[10]; const float* lam = a.in[11];
    constexpr int XC_OFF = 0, RS = 272, TOT_OFF = 34816;
    LAS float* TOT = (LAS float*)(lds + TOT_OFF);
    const int l15 = lane & 15, lq = lane >> 4, cgp = tid & 15, tq = tid >> 4, ct = wid & 1, g = wid >> 1;
    for (int s0 = blockIdx.x; s0 < 256; s0 += gridDim.x) {
        const int s = (gridDim.x == 256) ? ((s0 & 7) * 32 + (s0 >> 3)) : s0;
        const int q = s & 3, dir = (s >> 2) & 1, n = (s >> 3) & 7, b = s >> 6;
        const int chl = q * 32 + ct * 16 + l15, gch = n * 128 + chl;
        const float ba = b_a[dir * DREC + gch], bi = b_i[dir * DREC + gch], kf = 8.0f * log1pf(expf(-lam[dir * DREC + gch]));
        bf16x8 wf[2][4];
#pragma unroll
        for (int ty = 0; ty < 2; ++ty)
#pragma unroll
            for (int ks = 0; ks < 4; ++ks) wf[ty][ks] = *(const bf16x8*)(WG + (size_t)(n * 512 + (ty * 2 + dir) * 128 + chl) * 128 + ks * 32 + lq * 8);
        const int chb = n * 128 + cgp * 8;
        float cw[4][8], cb[8];
#pragma unroll
        for (int j = 0; j < 4; ++j) { const f32x4 w0 = *(const f32x4*)(conv_w + j * DREC + chb), w1 = *(const f32x4*)(conv_w + j * DREC + chb + 4);
            cw[j][0] = w0.x; cw[j][1] = w0.y; cw[j][2] = w0.z; cw[j][3] = w0.w; cw[j][4] = w1.x; cw[j][5] = w1.y; cw[j][6] = w1.z; cw[j][7] = w1.w; }
        { const f32x4 w0 = *(const f32x4*)(conv_b + chb), w1 = *(const f32x4*)(conv_b + chb + 4); cb[0] = w0.x; cb[1] = w0.y; cb[2] = w0.z; cb[3] = w0.w; cb[4] = w1.x; cb[5] = w1.y; cb[6] = w1.z; cb[7] = w1.w; }
        const bf16_t* xbase = U + (size_t)b * SEQ * DIN + 3072 + chb;
        bf16_t* hdst = dir ? (HBW + (size_t)b * SEQ * DREC + gch) : (A2 + (size_t)b * SEQ * DM + DATT + gch);
        const int hld = dir ? DREC : DM;
        float carry = 0.f;
        u32x4 raw[7];
        { const int t0 = (dir ? 63 : 0) * 128;
#pragma unroll
          for (int rr = 0; rr < 7; ++rr) { const int ts = t0 + 4 * tq - 2 + rr; raw[rr] = (u32x4){0u, 0u, 0u, 0u}; if (ts >= 0 && ts < SEQ) raw[rr] = *(const u32x4*)(xbase + (size_t)ts * DIN); } }
        for (int step = 0; step < 64; ++step) {
            const int c = dir ? 63 - step : step, t0 = c * 128;
            {
                float xin[7][8];
#pragma unroll
                for (int rr = 0; rr < 7; ++rr) { const u32x4 v = raw[rr];
                    xin[rr][0] = bf_lo(v.x); xin[rr][1] = bf_hi(v.x); xin[rr][2] = bf_lo(v.y); xin[rr][3] = bf_hi(v.y); xin[rr][4] = bf_lo(v.z); xin[rr][5] = bf_hi(v.z); xin[rr][6] = bf_lo(v.w); xin[rr][7] = bf_hi(v.w); }
#pragma unroll
                for (int i = 0; i < 4; ++i) { float o[8];
#pragma unroll
                    for (int e = 0; e < 8; ++e) o[e] = cb[e] + cw[0][e] * xin[i][e] + cw[1][e] * xin[i + 1][e] + cw[2][e] * xin[i + 2][e] + cw[3][e] * xin[i + 3][e];
                    u32x4 w; w.x = cvt_pk_bf16(o[0], o[1]); w.y = cvt_pk_bf16(o[2], o[3]); w.z = cvt_pk_bf16(o[4], o[5]); w.w = cvt_pk_bf16(o[6], o[7]);
                    *(LAS u32x4*)(lds + XC_OFF + (4 * tq + i) * RS + cgp * 16) = w; }
            }
            if (step < 63) { const int t1 = (dir ? c - 1 : c + 1) * 128;
#pragma unroll
                for (int rr = 0; rr < 7; ++rr) { const int ts = t1 + 4 * tq - 2 + rr; raw[rr] = (u32x4){0u, 0u, 0u, 0u}; if (ts >= 0 && ts < SEQ) raw[rr] = *(const u32x4*)(xbase + (size_t)ts * DIN); } }
            __syncthreads();
            f32x4 A[2], B[2];
#pragma unroll
            for (int mt = 0; mt < 2; ++mt) { A[mt] = (f32x4){0.f, 0.f, 0.f, 0.f}; B[mt] = (f32x4){0.f, 0.f, 0.f, 0.f}; }
#pragma unroll
            for (int ks = 0; ks < 4; ++ks)
#pragma unroll
                for (int mt = 0; mt < 2; ++mt) { const bf16x8 af = *(const LAS bf16x8*)(lds + XC_OFF + (32 * g + 16 * mt + l15) * RS + (ks * 32 + lq * 8) * 2);
                    A[mt] = __builtin_amdgcn_mfma_f32_16x16x32_bf16(af, wf[0][ks], A[mt], 0, 0, 0); B[mt] = __builtin_amdgcn_mfma_f32_16x16x32_bf16(af, wf[1][ks], B[mt], 0, 0, 0); }
#pragma unroll
            for (int mt = 0; mt < 2; ++mt)
#pragma unroll
                for (int r = 0; r < 4; ++r) { const int tt = 32 * g + 16 * mt + 4 * lq + r;
                    const float xcv = bf1(*(const LAS unsigned short*)(lds + XC_OFF + tt * RS + (cgp * 0 + q * 32 + ct * 16 + l15) * 2));
                    const float rg = fast_sigmoid(A[mt][r] + ba), ig = fast_sigmoid(B[mt][r] + bi), av = __expf(-kf * rg);
                    A[mt][r] = av; B[mt][r] = sqrtf(fmaxf(1.0f - av * av, 0.f)) * ig * xcv; }
            float hl[2][4], pl[2][4], PG[2][4], HG[2][4];
#pragma unroll
            for (int mt = 0; mt < 2; ++mt) { float H = 0.f, P = 1.f;
                if (dir == 0) {
#pragma unroll
                    for (int r = 0; r < 4; ++r) { H = A[mt][r] * H + B[mt][r]; P *= A[mt][r]; hl[mt][r] = H; pl[mt][r] = P; } }
                else {
#pragma unroll
                    for (int r = 3; r >= 0; --r) { H = A[mt][r] * H + B[mt][r]; P *= A[mt][r]; hl[mt][r] = H; pl[mt][r] = P; } }
#pragma unroll
                for (int gq = 0; gq < 4; ++gq) { PG[mt][gq] = __shfl(P, gq * 16 + l15); HG[mt][gq] = __shfl(H, gq * 16 + l15); } }
            float pseg = 1.f, hseg = 0.f;
            if (dir == 0) {
#pragma unroll
                for (int k = 0; k < 8; ++k) { const int mt = k >> 2, gq = k & 3; hseg = PG[mt][gq] * hseg + HG[mt][gq]; pseg *= PG[mt][gq]; } }
            else {
#pragma unroll
                for (int k = 0; k < 8; ++k) { const int mt = 1 - (k >> 2), gq = 3 - (k & 3); hseg = PG[mt][gq] * hseg + HG[mt][gq]; pseg *= PG[mt][gq]; } }
            if (lq == 0) { TOT[((ct * 4 + g) * 16 + l15) * 2] = pseg; TOT[((ct * 4 + g) * 16 + l15) * 2 + 1] = hseg; }
            __syncthreads();
            float cin = carry, wgc = carry; const int pos = dir ? 3 - g : g;
#pragma unroll
            for (int k = 0; k < 4; ++k) { const int gg = dir ? 3 - k : k; const float P = TOT[((ct * 4 + gg) * 16 + l15) * 2], H = TOT[((ct * 4 + gg) * 16 + l15) * 2 + 1];
                if (k < pos) cin = P * cin + H; wgc = P * wgc + H; }
            carry = wgc;
            f32x4 hout[2]; float cr = cin;
            if (dir == 0) {
#pragma unroll
                for (int k = 0; k < 8; ++k) { const int mt = k >> 2, gq = k & 3;
                    if (gq == lq) {
#pragma unroll
                        for (int r = 0; r < 4; ++r) hout[mt][r] = hl[mt][r] + pl[mt][r] * cr; }
                    cr = PG[mt][gq] * cr + HG[mt][gq]; } }
            else {
#pragma unroll
                for (int k = 0; k < 8; ++k) { const int mt = 1 - (k >> 2), gq = 3 - (k & 3);
                    if (gq == lq) {
#pragma unroll
                        for (int r = 0; r < 4; ++r) hout[mt][r] = hl[mt][r] + pl[mt][r] * cr; }
                    cr = PG[mt][gq] * cr + HG[mt][gq]; } }
#pragma unroll
            for (int mt = 0; mt < 2; ++mt)
#pragma unroll
                for (int r = 0; r < 4; ++r) { const int tt = 32 * g + 16 * mt + 4 * lq + r;
                    hdst[(size_t)(t0 + tt) * hld] = (unsigned short)(cvt_pk_bf16(hout[mt][r], 0.f) & 0xffffu); }
        }
        __syncthreads();
    }
}

__device__ __forceinline__ void rglru_stream2_phase(const Args& a, LAS unsigned char* lds, int tid, int wid, int lane, int s_first, int s_step) {
    const bf16_t* U = (const bf16_t*)(a.ws + WS_U); bf16_t* A2 = (bf16_t*)(a.ws + WS_A2); bf16_t* HBW = (bf16_t*)(a.ws + WS_Y); const bf16_t* WG = (const bf16_t*)(a.ws + WS_WG);
    const float* conv_w = a.in[5]; const float* conv_b = a.in[6]; const float* b_a = a.in[8]; const float* b_i = a.in[10]; const float* lam = a.in[11];
    constexpr int XC_OFF = 0, RS = 272, TOT_OFF = 34816;
    LAS float* TOT = (LAS float*)(lds + TOT_OFF);
    const int l15 = lane & 15, lq = lane >> 4, cgp = tid & 15, tq = tid >> 4, cth = wid & 1, g = wid >> 1;
    for (int s = s_first; s < 128; s += s_step) {
        const int hq = s & 1, dir = (s >> 1) & 1, n = (s >> 2) & 7, b = s >> 5;
        int chl[2]; float ba[2], bi[2], kf[2]; bf16x8 wf[2][2][4]; bf16_t* hdst[2];
#pragma unroll
        for (int cc = 0; cc < 2; ++cc) { chl[cc] = hq * 64 + (cth * 2 + cc) * 16 + l15; const int gch = n * 128 + chl[cc];
            ba[cc] = -1.4426950408889634f * b_a[dir * DREC + gch]; bi[cc] = -1.4426950408889634f * b_i[dir * DREC + gch]; kf[cc] = -1.4426950408889634f * 8.0f * log1pf(expf(-lam[dir * DREC + gch]));
#pragma unroll
            for (int ty = 0; ty < 2; ++ty)
#pragma unroll
                for (int ks = 0; ks < 4; ++ks) wf[cc][ty][ks] = *(const bf16x8*)(WG + (size_t)(n * 512 + (ty * 2 + dir) * 128 + chl[cc]) * 128 + ks * 32 + lq * 8);
            hdst[cc] = dir ? (HBW + (size_t)b * SEQ * DREC + gch) : (A2 + (size_t)b * SEQ * DM + DATT + gch); }
        const int hld = dir ? DREC : DM;
        const int chb = n * 128 + cgp * 8;
        float cw[4][8], cb[8];
#pragma unroll
        for (int j = 0; j < 4; ++j) { const f32x4 w0 = *(const f32x4*)(conv_w + j * DREC + chb), w1 = *(const f32x4*)(conv_w + j * DREC + chb + 4);
            cw[j][0] = w0.x; cw[j][1] = w0.y; cw[j][2] = w0.z; cw[j][3] = w0.w; cw[j][4] = w1.x; cw[j][5] = w1.y; cw[j][6] = w1.z; cw[j][7] = w1.w; }
        { const f32x4 w0 = *(const f32x4*)(conv_b + chb), w1 = *(const f32x4*)(conv_b + chb + 4); cb[0] = w0.x; cb[1] = w0.y; cb[2] = w0.z; cb[3] = w0.w; cb[4] = w1.x; cb[5] = w1.y; cb[6] = w1.z; cb[7] = w1.w; }
        const bf16_t* xbase = U + (size_t)b * SEQ * DIN + 3072 + chb;
        float carry[2] = {0.f, 0.f};
        u32x4 raw[7];
        { const int t0 = (dir ? 63 : 0) * 128;
#pragma unroll
          for (int rr = 0; rr < 7; ++rr) { const int ts = t0 + 4 * tq - 2 + rr; raw[rr] = (u32x4){0u, 0u, 0u, 0u}; if (ts >= 0 && ts < SEQ) raw[rr] = *(const u32x4*)(xbase + (size_t)ts * DIN); } }
        for (int step = 0; step < 64; ++step) {
            const int c = dir ? 63 - step : step, t0 = c * 128;
            {
                float xin[7][8];
#pragma unroll
                for (int rr = 0; rr < 7; ++rr) { const u32x4 v = raw[rr];
                    xin[rr][0] = bf_lo(v.x); xin[rr][1] = bf_hi(v.x); xin[rr][2] = bf_lo(v.y); xin[rr][3] = bf_hi(v.y); xin[rr][4] = bf_lo(v.z); xin[rr][5] = bf_hi(v.z); xin[rr][6] = bf_lo(v.w); xin[rr][7] = bf_hi(v.w); }
#pragma unroll
                for (int i = 0; i < 4; ++i) { float o[8];
#pragma unroll
                    for (int e = 0; e < 8; ++e) o[e] = cb[e] + cw[0][e] * xin[i][e] + cw[1][e] * xin[i + 1][e] + cw[2][e] * xin[i + 2][e] + cw[3][e] * xin[i + 3][e];
                    u32x4 w; w.x = cvt_pk_bf16(o[0], o[1]); w.y = cvt_pk_bf16(o[2], o[3]); w.z = cvt_pk_bf16(o[4], o[5]); w.w = cvt_pk_bf16(o[6], o[7]);
                    *(LAS u32x4*)(lds + XC_OFF + (4 * tq + i) * RS + cgp * 16) = w; }
            }
            if (step < 63) { const int t1 = (dir ? c - 1 : c + 1) * 128;
#pragma unroll
                for (int rr = 0; rr < 7; ++rr) { const int ts = t1 + 4 * tq - 2 + rr; raw[rr] = (u32x4){0u, 0u, 0u, 0u}; if (ts >= 0 && ts < SEQ) raw[rr] = *(const u32x4*)(xbase + (size_t)ts * DIN); } }
            __syncthreads();
            f32x4 A[2][2], B[2][2];
#pragma unroll
            for (int cc = 0; cc < 2; ++cc)
#pragma unroll
                for (int mt = 0; mt < 2; ++mt) { A[cc][mt] = (f32x4){0.f, 0.f, 0.f, 0.f}; B[cc][mt] = (f32x4){0.f, 0.f, 0.f, 0.f}; }
#pragma unroll
            for (int ks = 0; ks < 4; ++ks)
#pragma unroll
                for (int mt = 0; mt < 2; ++mt) { const bf16x8 af = *(const LAS bf16x8*)(lds + XC_OFF + (32 * g + 16 * mt + l15) * RS + (ks * 32 + lq * 8) * 2);
#pragma unroll
                    for (int cc = 0; cc < 2; ++cc) { A[cc][mt] = __builtin_amdgcn_mfma_f32_16x16x32_bf16(af, wf[cc][0][ks], A[cc][mt], 0, 0, 0); B[cc][mt] = __builtin_amdgcn_mfma_f32_16x16x32_bf16(af, wf[cc][1][ks], B[cc][mt], 0, 0, 0); } }
#pragma unroll
            for (int cc = 0; cc < 2; ++cc)
#pragma unroll
                for (int mt = 0; mt < 2; ++mt)
#pragma unroll
                    for (int r = 0; r < 4; ++r) { const int tt = 32 * g + 16 * mt + 4 * lq + r;
                        const float xcv = bf1(*(const LAS unsigned short*)(lds + XC_OFF + tt * RS + chl[cc] * 2));
                        const float rg = __builtin_amdgcn_rcpf(1.0f + __builtin_amdgcn_exp2f(__builtin_fmaf(A[cc][mt][r], -1.4426950408889634f, ba[cc])));
                        const float ig = __builtin_amdgcn_rcpf(1.0f + __builtin_amdgcn_exp2f(__builtin_fmaf(B[cc][mt][r], -1.4426950408889634f, bi[cc])));
                        const float av = __builtin_amdgcn_exp2f(kf[cc] * rg);
                        A[cc][mt][r] = av; B[cc][mt][r] = __builtin_amdgcn_sqrtf(fmaxf(__builtin_fmaf(-av, av, 1.0f), 0.f)) * ig * xcv; }
            float PG[2][2][4], HG[2][2][4];
#pragma unroll
            for (int cc = 0; cc < 2; ++cc) {
#pragma unroll
                for (int mt = 0; mt < 2; ++mt) { float H = 0.f, P = 1.f;
                    if (dir == 0) {
#pragma unroll
                        for (int r = 0; r < 4; ++r) { H = A[cc][mt][r] * H + B[cc][mt][r]; P *= A[cc][mt][r]; } }
                    else {
#pragma unroll
                        for (int r = 3; r >= 0; --r) { H = A[cc][mt][r] * H + B[cc][mt][r]; P *= A[cc][mt][r]; } }
#pragma unroll
                    for (int gq = 0; gq < 4; ++gq) { PG[cc][mt][gq] = __shfl(P, gq * 16 + l15); HG[cc][mt][gq] = __shfl(H, gq * 16 + l15); } }
                float pseg = 1.f, hseg = 0.f;
                if (dir == 0) {
#pragma unroll
                    for (int k = 0; k < 8; ++k) { const int mt = k >> 2, gq = k & 3; hseg = PG[cc][mt][gq] * hseg + HG[cc][mt][gq]; pseg *= PG[cc][mt][gq]; } }
                else {
#pragma unroll
                    for (int k = 0; k < 8; ++k) { const int mt = 1 - (k >> 2), gq = 3 - (k & 3); hseg = PG[cc][mt][gq] * hseg + HG[cc][mt][gq]; pseg *= PG[cc][mt][gq]; } }
                if (lq == 0) { const int ti = (((cth * 2 + cc) * 4 + g) * 16 + l15) * 2; TOT[ti] = pseg; TOT[ti + 1] = hseg; }
            }
            __syncthreads();
#pragma unroll
            for (int cc = 0; cc < 2; ++cc) {
                float cin = carry[cc], wgc = carry[cc]; const int pos = dir ? 3 - g : g;
#pragma unroll
                for (int k = 0; k < 4; ++k) { const int gg = dir ? 3 - k : k; const int ti = (((cth * 2 + cc) * 4 + gg) * 16 + l15) * 2; const float P = TOT[ti], H = TOT[ti + 1];
                    if (k < pos) cin = P * cin + H; wgc = P * wgc + H; }
                carry[cc] = wgc;
                float mycr[2] = {0.f, 0.f}; float cr = cin;
                if (dir == 0) {
#pragma unroll
                    for (int k = 0; k < 8; ++k) { const int mt = k >> 2, gq = k & 3; mycr[mt] = (gq == lq) ? cr : mycr[mt]; cr = PG[cc][mt][gq] * cr + HG[cc][mt][gq]; } }
                else {
#pragma unroll
                    for (int k = 0; k < 8; ++k) { const int mt = 1 - (k >> 2), gq = 3 - (k & 3); mycr[mt] = (gq == lq) ? cr : mycr[mt]; cr = PG[cc][mt][gq] * cr + HG[cc][mt][gq]; } }
#pragma unroll
                for (int mt = 0; mt < 2; ++mt) { float H = mycr[mt]; float ho[4];
                    if (dir == 0) {
#pragma unroll
                        for (int r = 0; r < 4; ++r) { H = A[cc][mt][r] * H + B[cc][mt][r]; ho[r] = H; } }
                    else {
#pragma unroll
                        for (int r = 3; r >= 0; --r) { H = A[cc][mt][r] * H + B[cc][mt][r]; ho[r] = H; } }
#pragma unroll
                    for (int r = 0; r < 4; ++r) { const int tt = 32 * g + 16 * mt + 4 * lq + r;
                        hdst[cc][(size_t)(t0 + tt) * hld] = (unsigned short)(cvt_pk_bf16(ho[r], 0.f) & 0xffffu); } }
            }
        }
        __syncthreads();
    }
}

__device__ __forceinline__ void fixup_phase(const Args& a, int wid, int lane) {
    bf16_t* A2 = (bf16_t*)(a.ws + WS_A2); const float* patt = (const float*)(a.ws + WS_PATT); const bf16_t* HBW = (const bf16_t*)(a.ws + WS_Y); const bf16_t* U = (const bf16_t*)(a.ws + WS_U);
    const float* ga = a.in[12]; const float* gr = a.in[13];
    const int gw = blockIdx.x * 8 + wid, NGW = gridDim.x * 8;
    f32x4 gA[2][2], gR[2][2];
#pragma unroll
    for (int j = 0; j < 2; ++j) { const int ci = j * 64 + lane; gA[j][0] = *(const f32x4*)(ga + ci * 8); gA[j][1] = *(const f32x4*)(ga + ci * 8 + 4); gR[j][0] = *(const f32x4*)(gr + ci * 8); gR[j][1] = *(const f32x4*)(gr + ci * 8 + 4); }
    for (int m = gw; m < MTOK; m += NGW) {
        float pv = (lane < 8) ? patt[(size_t)m * 8 + lane] : 0.f;
        pv += __shfl_xor(pv, 1); pv += __shfl_xor(pv, 2); pv += __shfl_xor(pv, 4);
        const float ssa = __shfl(pv, 0);
        const float rsa = rsqrtf(ssa * (1.f / DATT) + EPS);
        u32x4* row = (u32x4*)(A2 + (size_t)m * DM);
        float rec[2][8]; float ssr = 0.f;
#pragma unroll
        for (int j = 0; j < 2; ++j) { const int ci = j * 64 + lane;
            const u32x4 hf = row[128 + ci], hb = __builtin_nontemporal_load((const u32x4*)(HBW + (size_t)m * DREC + ci * 8)), yg = __builtin_nontemporal_load((const u32x4*)(U + (size_t)m * DIN + 4096 + ci * 8));
            const float hs[8] = {bf_lo(hf.x) + bf_lo(hb.x), bf_hi(hf.x) + bf_hi(hb.x), bf_lo(hf.y) + bf_lo(hb.y), bf_hi(hf.y) + bf_hi(hb.y), bf_lo(hf.z) + bf_lo(hb.z), bf_hi(hf.z) + bf_hi(hb.z), bf_lo(hf.w) + bf_lo(hb.w), bf_hi(hf.w) + bf_hi(hb.w)};
            const float ys[8] = {bf_lo(yg.x), bf_hi(yg.x), bf_lo(yg.y), bf_hi(yg.y), bf_lo(yg.z), bf_hi(yg.z), bf_lo(yg.w), bf_hi(yg.w)};
#pragma unroll
            for (int e = 0; e < 8; ++e) { const float y = ys[e], z = 0.7978845608028654f * (y + 0.044715f * y * y * y); const float v = hs[e] * y * fast_sigmoid(2.0f * z); rec[j][e] = v; ssr += v * v; } }
        const float rsr = rsqrtf(wave_sum(ssr) * (1.f / DREC) + EPS);
#pragma unroll
        for (int j = 0; j < 2; ++j) { const int ci = j * 64 + lane; const u32x4 v = row[ci];
            const f32x4 g0 = gA[j][0], g1 = gA[j][1];
            u32x4 w; w.x = cvt_pk_bf16(bf_lo(v.x) * rsa * g0.x, bf_hi(v.x) * rsa * g0.y); w.y = cvt_pk_bf16(bf_lo(v.y) * rsa * g0.z, bf_hi(v.y) * rsa * g0.w);
            w.z = cvt_pk_bf16(bf_lo(v.z) * rsa * g1.x, bf_hi(v.z) * rsa * g1.y); w.w = cvt_pk_bf16(bf_lo(v.w) * rsa * g1.z, bf_hi(v.w) * rsa * g1.w);
            row[ci] = w; }
#pragma unroll
        for (int j = 0; j < 2; ++j) { const int ci = j * 64 + lane;
            const f32x4 g0 = gR[j][0], g1 = gR[j][1];
            u32x4 w; w.x = cvt_pk_bf16(rec[j][0] * rsr * g0.x, rec[j][1] * rsr * g0.y); w.y = cvt_pk_bf16(rec[j][2] * rsr * g0.z, rec[j][3] * rsr * g0.w);
            w.z = cvt_pk_bf16(rec[j][4] * rsr * g1.x, rec[j][5] * rsr * g1.y); w.w = cvt_pk_bf16(rec[j][6] * rsr * g1.z, rec[j][7] * rsr * g1.w);
            row[128 + ci] = w; }
    }
}

template <int MODE>
__device__ __forceinline__ void epass_phase(const Args& a, const float* g_post, float* rsq, int wid, int lane) {
    const bf16_t* Y = (const bf16_t*)(a.ws + WS_Y); const float* part = (const float*)(a.ws + WS_PART); bf16_t* HB = (bf16_t*)(a.ws + WS_XN); float* out = a.out; const float* x = a.in[0];
    const int gw = blockIdx.x * 8 + wid, NGW = gridDim.x * 8;
    f32x4 g[4][2];
#pragma unroll
    for (int j = 0; j < 4; ++j) { g[j][0] = ((const f32x4*)g_post)[(j * 64 + lane) * 2]; g[j][1] = ((const f32x4*)g_post)[(j * 64 + lane) * 2 + 1]; }
    for (int m0 = gw; m0 < MTOK; m0 += 2 * NGW) {
        int mr[2]; mr[0] = m0; mr[1] = (m0 + NGW < MTOK) ? m0 + NGW : m0;
        float pv[2]; u32x4 yv[2][4]; f32x4 h[2][4][2]; u32x4 hw[2][4];
#pragma unroll
        for (int rr = 0; rr < 2; ++rr) { const int m = mr[rr];
            pv[rr] = part[(size_t)m * 32 + (lane & 31)];
            const u32x4* yr = (const u32x4*)(Y + (size_t)m * DM);
#pragma unroll
            for (int j = 0; j < 4; ++j) yv[rr][j] = __builtin_nontemporal_load(yr + j * 64 + lane);
            if (MODE == 0) {
#pragma unroll
                for (int j = 0; j < 4; ++j) { h[rr][j][0] = __builtin_nontemporal_load((const f32x4*)(x + (size_t)m * DM) + (j * 64 + lane) * 2); h[rr][j][1] = __builtin_nontemporal_load((const f32x4*)(x + (size_t)m * DM) + (j * 64 + lane) * 2 + 1); }
            } else { const u32x4* hb = (const u32x4*)(HB + (size_t)m * DM);
#pragma unroll
                for (int j = 0; j < 4; ++j) hw[rr][j] = hb[j * 64 + lane]; } }
#pragma unroll
        for (int rr = 0; rr < 2; ++rr) { const int m = mr[rr];
            if (MODE != 0) {
#pragma unroll
                for (int j = 0; j < 4; ++j) { const u32x4 w = hw[rr][j];
                    h[rr][j][0] = (f32x4){bf_lo(w.x), bf_hi(w.x), bf_lo(w.y), bf_hi(w.y)}; h[rr][j][1] = (f32x4){bf_lo(w.z), bf_hi(w.z), bf_lo(w.w), bf_hi(w.w)}; } }
            float p = pv[rr];
#pragma unroll
            for (int o = 1; o < 32; o <<= 1) p += __shfl_xor(p, o);
            const float rs = rsqrtf(p * (1.f / DM) + EPS);
            float s2 = 0.f;
#pragma unroll
            for (int j = 0; j < 4; ++j) { const u32x4 yw = yv[rr][j]; const f32x4 y0 = (f32x4){bf_lo(yw.x), bf_hi(yw.x), bf_lo(yw.y), bf_hi(yw.y)}, y1 = (f32x4){bf_lo(yw.z), bf_hi(yw.z), bf_lo(yw.w), bf_hi(yw.w)};
                const f32x4 a0 = h[rr][j][0] + y0 * g[j][0] * rs, a1 = h[rr][j][1] + y1 * g[j][1] * rs; h[rr][j][0] = a0; h[rr][j][1] = a1;
                s2 += (a0.x * a0.x + a0.y * a0.y) + (a0.z * a0.z + a0.w * a0.w) + (a1.x * a1.x + a1.y * a1.y) + (a1.z * a1.z + a1.w * a1.w); }
            if (MODE == 2) { f32x4* orow = (f32x4*)(out + (size_t)m * DM);
#pragma unroll
                for (int j = 0; j < 4; ++j) { __builtin_nontemporal_store(h[rr][j][0], orow + (j * 64 + lane) * 2); __builtin_nontemporal_store(h[rr][j][1], orow + (j * 64 + lane) * 2 + 1); } }
            else { u32x4* hb = (u32x4*)(HB + (size_t)m * DM);
#pragma unroll
                for (int j = 0; j < 4; ++j) { u32x4 w; w.x = cvt_pk_bf16(h[rr][j][0].x, h[rr][j][0].y); w.y = cvt_pk_bf16(h[rr][j][0].z, h[rr][j][0].w); w.z = cvt_pk_bf16(h[rr][j][1].x, h[rr][j][1].y); w.w = cvt_pk_bf16(h[rr][j][1].z, h[rr][j][1].w); hb[j * 64 + lane] = w; }
                const float rs2 = rsqrtf(wave_sum(s2) * (1.f / DM) + EPS);
                if (lane == 0) rsq[m] = rs2; }
        }
    }
}

__device__ __forceinline__ void grid_barrier(unsigned* bar, unsigned target) {
    asm volatile("s_waitcnt vmcnt(0)" ::: "memory");
    __syncthreads();
    if (threadIdx.x == 0) {
        __builtin_amdgcn_fence(__ATOMIC_RELEASE, "agent");
        asm volatile("s_waitcnt vmcnt(0)" ::: "memory");
        __hip_atomic_fetch_add(bar, 1u, __ATOMIC_RELAXED, __HIP_MEMORY_SCOPE_AGENT);
        const unsigned long long t0 = __builtin_amdgcn_s_memrealtime();
        while (__hip_atomic_load(bar, __ATOMIC_RELAXED, __HIP_MEMORY_SCOPE_AGENT) < target) {
            if (__builtin_amdgcn_s_memrealtime() - t0 > 5000000ull) break;
            __builtin_amdgcn_s_sleep(1); }
        __builtin_amdgcn_fence(__ATOMIC_ACQUIRE, "agent");
        asm volatile("s_waitcnt vmcnt(0)" ::: "memory");
    }
    __syncthreads();
}

#define XB_TMO      128
#define XB_XCNT(j)  (256  + 64 * (j))
#define XB_XSUB(j)  (1280 + 64 * (j))
#define XB_XGEN(j)  (2304 + 64 * (j))
#define XB_TOP      3328
#define XB_TOPGEN   3392
#define XCD_BAR_WORDS 3456
#define XB_SPIN_CAP (1u << 18)
__device__ __forceinline__ unsigned xb_ld(unsigned* p)              { return __hip_atomic_load(p, __ATOMIC_RELAXED, __HIP_MEMORY_SCOPE_AGENT); }
__device__ __forceinline__ unsigned xb_add(unsigned* p, unsigned v) { return __hip_atomic_fetch_add(p, v, __ATOMIC_RELAXED, __HIP_MEMORY_SCOPE_AGENT); }
__device__ __forceinline__ unsigned xb_xcc_id() { return (unsigned)__builtin_amdgcn_s_getreg((3 << 11) | 20) & 0xFu; }
#define XB_SPIN(cond, bar) do { unsigned _sp = 0; while (cond) { __builtin_amdgcn_s_sleep(1); \
    if ((++_sp & 255u) == 0u) { if (xb_ld(&(bar)[XB_TMO])) break; if (_sp > XB_SPIN_CAP) { atomicAdd(&(bar)[XB_TMO], 1u); break; } } } } while (0)
struct XcdBarrier { unsigned* bar; unsigned x; volatile LAS unsigned* st; };
__device__ __forceinline__ void xcd_barrier_complete(unsigned* bar, unsigned x, unsigned& nloc, unsigned& nx) {
    const unsigned G = gridDim.x * gridDim.y * gridDim.z;
    unsigned sum, cnt, mine, sp = 0u;
    for (;;) {
        sum = 0u; cnt = 0u; mine = 0u;
#pragma unroll
        for (unsigned j = 0; j < 16; ++j) { const unsigned c = xb_ld(&bar[XB_XCNT(j)]); sum += c; cnt += (c > 0u) ? 1u : 0u; mine = (j == x) ? c : mine; }
        if (sum == G) break;
        __builtin_amdgcn_s_sleep(1);
        if ((++sp & 255u) == 0u) { if (xb_ld(&bar[XB_TMO])) break; if (sp > XB_SPIN_CAP) { atomicAdd(&bar[XB_TMO], 1u); break; } }
    }
    nloc = mine > 0u ? mine : 1u; nx = cnt > 0u ? cnt : 1u;
}
__device__ __forceinline__ void xcd_barrier(const XcdBarrier& b) {
    asm volatile("s_waitcnt vmcnt(0)" ::: "memory");
    __syncthreads();
    if (threadIdx.x == 0) {
        unsigned* bar = b.bar;
        __builtin_amdgcn_s_waitcnt(0);
        unsigned nloc = b.st[0], nx = b.st[1];
        if (nloc == 0u) { xcd_barrier_complete(bar, b.x, nloc, nx); b.st[0] = nloc; b.st[1] = nx; }
        const unsigned old = xb_add(&bar[XB_XSUB(b.x)], 1u);
        const unsigned gen = old / nloc;
        if (old + 1u == (gen + 1u) * nloc) {
            __builtin_amdgcn_fence(__ATOMIC_RELEASE, "agent");
            asm volatile("s_waitcnt vmcnt(0)" ::: "memory");
            const unsigned og = xb_add(&bar[XB_TOP], 1u);
            const unsigned tg = og / nx;
            if (og + 1u == (tg + 1u) * nx) xb_add(&bar[XB_TOPGEN], 1u);
            else XB_SPIN(xb_ld(&bar[XB_TOPGEN]) == tg, bar);
            __builtin_amdgcn_fence(__ATOMIC_ACQUIRE, "agent");
            xb_add(&bar[XB_XGEN(b.x)], 1u);
            asm volatile("s_waitcnt vmcnt(0)" ::: "memory");
        } else {
            XB_SPIN(xb_ld(&bar[XB_XGEN(b.x)]) == gen, bar);
            __builtin_amdgcn_fence(__ATOMIC_ACQUIRE, "agent");
            asm volatile("s_waitcnt vmcnt(0)" ::: "memory");
        }
    }
    __syncthreads();
}

__global__ void __launch_bounds__(512) fwd_kernel(Args a) {
    extern __shared__ __attribute__((aligned(16))) unsigned char lds_raw[];
    LAS unsigned char* lds = (LAS unsigned char*)lds_raw;
    const int tid = threadIdx.x, wid = __builtin_amdgcn_readfirstlane(tid >> 6), lane = tid & 63;
    unsigned char* ws = a.ws;
    const int lo = a.ph_lo, hi = a.ph_hi;
#define IN(k) (lo <= (k) && (k) < hi && PH_ON(k))
    volatile LAS unsigned* xst = (volatile LAS unsigned*)(lds + LDS_BYTES - 16);
    if (tid == 0) { xst[0] = 0u; xst[1] = 0u; }
    __syncthreads();
    XcdBarrier xbar; xbar.bar = (unsigned*)(ws + WS_BAR); xbar.x = xb_xcc_id(); xbar.st = xst;
#define SEAM(k) do { if (lo <= (k) && (k) + 1 < hi) { if ((k) == 0) { cg::this_grid().sync(); if (tid == 0) (void)xb_add(&xbar.bar[XB_XCNT(xbar.x)], 1u); } else xcd_barrier(xbar); } } while (0)
#define PHASE(k, ...) do { if (IN(k)) { __VA_ARGS__ } if (NREP(k) > 1) { if (IN(k)) { __VA_ARGS__ } } } while (0)
    PHASE(0, p0_phase(a, lds, tid, wid, lane););
    SEAM(0);
    PHASE(1,
        for (int gi = 0; gi < 2; ++gi) {
            pg8::Gemm g{(const bf16_t*)(ws + (gi ? WS_PB : WS_XN)), (const bf16_t*)(ws + (gi ? WS_WPP : WS_WIN)), MTOK, gi ? DM : DIN, gi ? DPLE : DM}; pg8::StaticOrder S; S.init(MTOK, gi ? DM : DIN, gridDim.x, blockIdx.x);
            pg8::EpiStore E{(bf16_t*)(ws + (gi ? WS_PLE : WS_U)), gi ? DM : DIN}; pg8::gemm_phase(lds, g, S, E); }
    );
    SEAM(1);
    PHASE(2,
        if (gridDim.x == 256) {
            const int c = blockIdx.x, x = c & 7;
            if (c < 128) { rglru_stream2_phase(a, lds, tid, wid, lane, x * 16 + (c >> 3), 1 << 20); attn2_phase(a, lds, tid, wid, lane, x * 64 + 48 + (c >> 3), 16, 1, 2, 4); }
            else { attn2_phase(a, lds, tid, wid, lane, x * 64 + ((c - 128) >> 3), 16, 3, 0, 4); attn2_phase(a, lds, tid, wid, lane, x * 64 + 48 + ((c - 128) >> 3), 16, 1, 0, 2);
                   weight_items(a, lds, wid, lane, 32 * 160, 32 * 160 + 32 * 64 + 3 * (32 * 176) + 32 * 64, (c - 128) * 8 + wid, 1024); __syncthreads(); }
        } else {
            attn2_phase(a, lds, tid, wid, lane, blockIdx.x, gridDim.x, (512 - (int)blockIdx.x + (int)gridDim.x - 1) / (int)gridDim.x, 0, 4);
            rglru_stream2_phase(a, lds, tid, wid, lane, blockIdx.x, gridDim.x);
        }
    );
    SEAM(2);
    PHASE(4, fixup_phase(a, wid, lane););
    SEAM(4);
    PHASE(5, pg8::Gemm g{(const bf16_t*)(ws + WS_A2), (const bf16_t*)(ws + WS_WOUT), MTOK, DM, DM}; pg8::StaticOrder S; S.init(MTOK, DM, gridDim.x, blockIdx.x);
        pg8::EpiStoreSS E{(bf16_t*)(ws + WS_Y), DM, (float*)(ws + WS_PART)}; pg8::gemm_phase(lds, g, S, E););
    SEAM(5);
    PHASE(6, epass_phase<0>(a, a.in[15], (float*)(ws + WS_RSQ), wid, lane););
    SEAM(6);
    PHASE(7, pg8::Gemm g{(const bf16_t*)(ws + WS_XN), (const bf16_t*)(ws + WS_WGU), MTOK, 2 * DFF, DM}; pg8::StaticOrder S; S.init(MTOK, 2 * DFF, gridDim.x, blockIdx.x);
        pg8::EpiSwiglu E{(bf16_t*)(ws + WS_ACT), DFF, (const float*)(ws + WS_RSQ)}; pg8::gemm_phase(lds, g, S, E););
    SEAM(7);
    PHASE(8, pg8::Gemm g{(const bf16_t*)(ws + WS_ACT), (const bf16_t*)(ws + WS_WD), MTOK, DM, DFF}; pg8::StaticOrder S; S.init(MTOK, DM, gridDim.x, blockIdx.x);
        pg8::EpiStoreSS E{(bf16_t*)(ws + WS_Y), DM, (float*)(ws + WS_PART)}; pg8::gemm_phase(lds, g, S, E););
    SEAM(8);
    PHASE(9, epass_phase<1>(a, a.in[20], (float*)(ws + WS_RSQ) + MTOK, wid, lane););
    SEAM(9);
    PHASE(10, pg8::Gemm g{(const bf16_t*)(ws + WS_XN), (const bf16_t*)(ws + WS_WPG), MTOK, DM, DM}; pg8::StaticOrder S; S.init(MTOK, DM, gridDim.x, blockIdx.x);
        pg8::EpiPleGate E{(bf16_t*)(ws + WS_Y), DM, (const bf16_t*)(ws + WS_PLE), (float*)(ws + WS_PART), (const float*)(ws + WS_RSQ) + MTOK}; pg8::gemm_phase(lds, g, S, E););
    SEAM(10);
    PHASE(11, epass_phase<2>(a, a.in[24], nullptr, wid, lane););
#undef IN
#undef SEAM
#undef PHASE
}

extern "C" void kernel_launch(void* const* d_in, const int* in_sizes, int n_in, void* d_out, int out_size, void* d_ws, size_t ws_size, hipStream_t stream) {
    static int grid = 0;
    if (grid == 0) {
        int dev = 0, cus = 0;
        if (hipGetDevice(&dev) != hipSuccess || hipDeviceGetAttribute(&cus, hipDeviceAttributeMultiprocessorCount, dev) != hipSuccess) { fprintf(stderr, "device query failed\n"); grid = -1; return; }
        if (hipFuncSetAttribute((const void*)fwd_kernel, hipFuncAttributeMaxDynamicSharedMemorySize, LDS_BYTES) != hipSuccess) { fprintf(stderr, "hipFuncSetAttribute failed\n"); grid = -1; return; }
        int per_cu = 0;
        if (hipOccupancyMaxActiveBlocksPerMultiprocessor(&per_cu, (const void*)fwd_kernel, 512, LDS_BYTES) != hipSuccess || per_cu < 1) { fprintf(stderr, "occupancy query: %d\n", per_cu); per_cu = 1; }
        (void)hipGetLastError();
        grid = cus;
        if (ws_size < 968 * MiB) fprintf(stderr, "workspace too small: %zu\n", ws_size);
    }
    if (grid < 0) return;
    Args a{};
    for (int i = 0; i < 25; ++i) a.in[i] = (const float*)d_in[i];
    a.out = (float*)d_out; a.ws = (unsigned char*)d_ws;
#if MK_ONE_LAUNCH
    a.ph_lo = 0; a.ph_hi = NPH;
    void* args[] = {&a};
    hipError_t e = hipLaunchCooperativeKernel((const void*)fwd_kernel, dim3(grid), dim3(512), args, LDS_BYTES, stream);
    if (e != hipSuccess) fprintf(stderr, "cooperative launch failed: %s (grid %d)\n", hipGetErrorString(e), grid);
#else
    for (int ph = 0; ph < NPH; ++ph) { a.ph_lo = ph; a.ph_hi = ph + 1; hipLaunchKernelGGL(fwd_kernel, dim3(grid), dim3(512), LDS_BYTES, stream, a); }
#endif
}
```
